# Optimizing an MI355X kernel written in HIP

```python
import jax, jax.numpy as jnp
from jax import lax
import numpy as np

D_MODEL = 1024
BATCH = 2
SEQ = 8192
DEPTH = 2

RET_HEADS = 4
RET_DV = D_MODEL // (2 * RET_HEADS)
RET_DK = RET_DV // 2
RET_CHUNK = 128
ROPE_BASE = 10000.0
LRU_WIDTH = D_MODEL // 2
LRU_BLOCKS = 4
LRU_BW = LRU_WIDTH // LRU_BLOCKS
LRU_CONV = 4
LRU_C = 8.0
HG_HEADS = 8
HG_DK = D_MODEL // HG_HEADS
HG_DV = D_MODEL // HG_HEADS
HG_CHUNK = 32
N_EXPERTS = 16
N_GROUPS = 4
EXPERTS_PER_GROUP = N_EXPERTS // N_GROUPS
TOP_K = 2
D_EXPERT = 512
MOE_BLOCK = 128
DN_ALPHA = (2.0 * DEPTH) ** 0.25
DN_BETA = (8.0 * DEPTH) ** -0.25
N_EVEN = (DEPTH + 1) // 2
N_ODD = DEPTH // 2
LN_EPS = 1e-5
RMS_EPS = 1e-6
EVEN_SPLITS = (RET_HEADS * RET_DK,
               2 * RET_HEADS * RET_DK,
               2 * RET_HEADS * RET_DK + RET_HEADS * RET_DV,
               2 * RET_HEADS * RET_DK + 2 * RET_HEADS * RET_DV,
               2 * RET_HEADS * RET_DK + 2 * RET_HEADS * RET_DV + LRU_WIDTH)
EVEN_IN = 2 * RET_HEADS * RET_DK + 2 * RET_HEADS * RET_DV + 2 * LRU_WIDTH
EVEN_OUT = RET_HEADS * RET_DV + LRU_WIDTH
ODD_IN = 5 * D_MODEL

kernel_name = 'hybrid_retention_rglru_hgrn2_grouped_moe_encoder'


def _layer_norm(x, w, b):
    xf = x.astype(jnp.float32)
    mu = jnp.mean(xf, axis=-1, keepdims=True)
    var = jnp.mean(jnp.square(xf - mu), axis=-1, keepdims=True)
    return ((xf - mu) * lax.rsqrt(var + LN_EPS) * w + b).astype(x.dtype)


def _head_norm(x):
    mu = jnp.mean(x, axis=-1, keepdims=True)
    var = jnp.mean(jnp.square(x - mu), axis=-1, keepdims=True)
    return (x - mu) * lax.rsqrt(var + LN_EPS)


def _rms_norm(x, w):
    return x * lax.rsqrt(jnp.mean(jnp.square(x), axis=-1, keepdims=True) + RMS_EPS) * w.astype(jnp.float32)


def _rotary(x, pos):
    d = x.shape[-1]
    inv_freq = ROPE_BASE ** (-jnp.arange(0, d, 2, dtype=jnp.float32) / d)
    ang = pos.astype(jnp.float32)[:, None] * inv_freq[None, :]
    cos = jnp.cos(ang)[None, :, None, :]
    sin = jnp.sin(ang)[None, :, None, :]
    x1, x2 = x[..., 0::2], x[..., 1::2]
    return jnp.stack([x1 * cos - x2 * sin, x1 * sin + x2 * cos], axis=-1).reshape(x.shape)


def _retention_bidir(q, k, v):
    B, S, H, dk = q.shape
    dv = v.shape[-1]
    C = RET_CHUNK
    N = S // C
    log_gamma = jnp.log1p(-(2.0 ** (-5.0 - jnp.arange(H, dtype=jnp.float32))))
    qc = (q * dk ** -0.5).reshape(B, N, C, H, dk)
    kc = k.reshape(B, N, C, H, dk)
    vc = v.reshape(B, N, C, H, dv)
    idx = jnp.arange(C, dtype=jnp.float32)
    d_intra = jnp.exp(log_gamma[:, None, None] * jnp.abs(idx[:, None] - idx[None, :]))
    scores = jnp.einsum('bnihd,bnjhd->bnhij', qc, kc) * d_intra
    o = jnp.einsum('bnhij,bnjhe->bnihe', scores, vc)
    q_dec_f = jnp.exp(log_gamma[None, :] * (idx[:, None] + 1.0))
    k_dec_f = jnp.exp(log_gamma[None, :] * (C - 1.0 - idx[:, None]))
    q_dec_b = jnp.exp(log_gamma[None, :] * (C - idx[:, None]))
    k_dec_b = jnp.exp(log_gamma[None, :] * idx[:, None])
    chunk_dec = jnp.exp(log_gamma * C)[None, :, None, None]
    kv_f = jnp.einsum('bnjhd,jh,bnjhe->nbhde', kc, k_dec_f, vc)
    kv_b = jnp.einsum('bnjhd,jh,bnjhe->nbhde', kc, k_dec_b, vc)

    def step(state, kv):
        return state * chunk_dec + kv, state

    init = jnp.zeros((B, H, dk, dv), jnp.float32)
    _, st_f = lax.scan(step, init, kv_f)
    _, st_b = lax.scan(step, init, kv_b, reverse=True)
    o = (o + jnp.einsum('bnihd,ih,nbhde->bnihe', qc, q_dec_f, st_f)
           + jnp.einsum('bnihd,ih,nbhde->bnihe', qc, q_dec_b, st_b))
    return o.reshape(B, S, H, dv)


def _rglru_bidir(x, conv_w, conv_b, gate_w, gate_b, lam):
    B, S, W = x.shape
    lo = LRU_CONV // 2
    hi = LRU_CONV - 1 - lo
    xc = lax.conv_general_dilated(x, conv_w.astype(jnp.float32)[:, None, :], window_strides=(1,),
                                  padding=[(lo, hi)], dimension_numbers=('NWC', 'WIO', 'NWC'),
                                  feature_group_count=W) + conv_b.astype(jnp.float32)
    xb = xc.reshape(B, S, LRU_BLOCKS, LRU_BW)
    gates = jax.nn.sigmoid(jnp.einsum('bsnc,zgncd->zgbsnd', xb, gate_w.astype(jnp.float32))
                           + gate_b.astype(jnp.float32)[:, :, None, None])
    gates = gates.reshape(2, 2, B, S, W)
    r, i = gates[:, 0], gates[:, 1]
    log_a = -LRU_C * r * jax.nn.softplus(-lam.astype(jnp.float32))[:, None, None, :]
    a = jnp.exp(log_a)
    b = jnp.sqrt(-jnp.expm1(2.0 * log_a)) * (i * xc[None])

    def comb(left, right):
        a1, b1 = left
        a2, b2 = right
        return a1 * a2, a2 * b1 + b2

    _, h_f = lax.associative_scan(comb, (a[0], b[0]), axis=1)
    _, h_b = lax.associative_scan(comb, (a[1], b[1]), axis=1, reverse=True)
    return h_f + h_b


def _gla_chunks(q, k, v, log_f):
    B, S, H, dk = q.shape
    dv = v.shape[-1]
    C = HG_CHUNK
    N = S // C

    def to_chunks(t):
        return t.reshape(B, N, C, H, t.shape[-1]).transpose(1, 0, 3, 2, 4)

    causal = jnp.tril(jnp.ones((C, C), dtype=bool))[:, :, None]

    def step(state, inp):
        qc, kc, vc, gc = inp
        b = jnp.cumsum(gc, axis=2)
        diff = b[:, :, :, None, :] - b[:, :, None, :, :]
        decay = jnp.exp(jnp.where(causal, diff, -jnp.inf))
        attn = jnp.einsum('bhid,bhjd,bhijd->bhij', qc, kc, decay)
        o = (jnp.einsum('bhij,bhje->bhie', attn, vc)
             + jnp.einsum('bhid,bhde->bhie', qc * jnp.exp(b), state))
        b_last = b[:, :, -1]
        new_state = (state * jnp.exp(b_last)[..., None]
                     + jnp.einsum('bhjd,bhje->bhde', kc * jnp.exp(b_last[:, :, None, :] - b), vc))
        return new_state, o

    init = jnp.zeros((B, H, dk, dv), jnp.float32)
    _, o = lax.scan(step, init, (to_chunks(q), to_chunks(k), to_chunks(v), to_chunks(log_f)))
    return o.transpose(1, 0, 3, 2, 4).reshape(B, S, H, dv)


def _even_mixer(h, w_in, w_out, conv_w, conv_b, gate_w, gate_b, lam):
    B, S, _ = h.shape
    proj = (h @ w_in).astype(jnp.float32)
    q, k, v, g, xr, gr = jnp.split(proj, list(EVEN_SPLITS), axis=-1)
    pos = jnp.arange(S)
    q = _rotary(q.reshape(B, S, RET_HEADS, RET_DK), pos)
    k = _rotary(k.reshape(B, S, RET_HEADS, RET_DK), pos)
    v = v.reshape(B, S, RET_HEADS, RET_DV)
    ret = _head_norm(_retention_bidir(q, k, v)).reshape(B, S, RET_HEADS * RET_DV)
    ret_out = jax.nn.silu(g) * ret
    lru_out = _rglru_bidir(xr, conv_w, conv_b, gate_w, gate_b, lam) * jax.nn.gelu(gr)
    return jnp.concatenate([ret_out, lru_out], axis=-1).astype(h.dtype) @ w_out


def _odd_mixer(h, w_in, w_out, lower_bounds, norm_w, layer):
    B, S, _ = h.shape
    proj = (h @ w_in).astype(jnp.float32)
    q, v, z_f, z_b, g = jnp.split(proj, 5, axis=-1)
    lb_all = jnp.cumsum(jax.nn.softmax(lower_bounds.astype(jnp.float32), axis=0), axis=0)
    lb = lb_all[layer] - lb_all[0]

    def heads(t):
        return t.reshape(B, S, HG_HEADS, -1)

    def forget(z):
        log_f = jnp.logaddexp(jnp.log(lb), jnp.log1p(-lb) + jax.nn.log_sigmoid(z))
        key = (1.0 - lb) * jax.nn.sigmoid(-z)
        return heads(log_f), heads(key)

    qh = heads(jax.nn.silu(q)) * HG_DK ** -0.5
    vh = heads(v)
    lf_f, k_f = forget(z_f)
    lf_b, k_b = forget(z_b)
    o_f = _gla_chunks(qh, k_f, vh, lf_f)
    flip = lambda t: jnp.flip(t, axis=1)
    o_b = flip(_gla_chunks(flip(qh), flip(k_b), flip(vh), flip(lf_b)))
    o = _rms_norm((o_f + o_b).reshape(B, S, HG_HEADS * HG_DV), norm_w) * jax.nn.silu(g)
    return o.astype(h.dtype) @ w_out


def _moe(h, router_w, w_gate, w_up, w_down):
    B, S, D = h.shape
    T = B * S
    x = h.reshape(T, D)
    probs = jax.nn.softmax((x @ router_w).astype(jnp.float32), axis=-1)
    top_v, top_i = lax.top_k(probs.reshape(T, N_GROUPS, EXPERTS_PER_GROUP), TOP_K)
    g_sel = jnp.argmax(jnp.sum(top_v, axis=-1), axis=-1)
    tok = jnp.arange(T, dtype=jnp.int32)
    vals = top_v[tok, g_sel]
    eidx = top_i[tok, g_sel] + g_sel[:, None].astype(jnp.int32) * EXPERTS_PER_GROUP
    gates = vals / jnp.sum(vals, axis=-1, keepdims=True)
    A = T * TOP_K
    flat_e = eidx.reshape(A).astype(jnp.int32)
    flat_tok = jnp.repeat(tok, TOP_K)
    flat_g = gates.reshape(A)
    order = jnp.argsort(flat_e)
    se = flat_e[order]
    counts = jnp.bincount(flat_e, length=N_EXPERTS).astype(jnp.int32)
    padded = (counts + MOE_BLOCK - 1) // MOE_BLOCK * MOE_BLOCK
    start = jnp.cumsum(counts) - counts
    ends_p = jnp.cumsum(padded)
    pstart = ends_p - padded
    dest = pstart[se] + jnp.arange(A, dtype=jnp.int32) - start[se]
    P = (A + MOE_BLOCK - 1) // MOE_BLOCK * MOE_BLOCK + N_EXPERTS * MOE_BLOCK
    nb = P // MOE_BLOCK
    buf_tok = jnp.zeros((P,), jnp.int32).at[dest].set(flat_tok[order])
    buf_gate = jnp.zeros((P,), jnp.float32).at[dest].set(flat_g[order])
    block_start = jnp.arange(nb, dtype=jnp.int32) * MOE_BLOCK
    block_e = jnp.minimum(jnp.searchsorted(ends_p, block_start, side='right'), N_EXPERTS - 1)
    xb = x[buf_tok].reshape(nb, MOE_BLOCK, D)

    def expert_block(args):
        xblk, e = args
        hid = jax.nn.silu(xblk @ w_gate[e]) * (xblk @ w_up[e])
        return hid @ w_down[e]

    yb = lax.map(expert_block, (xb, block_e)).reshape(P, D)
    y = jnp.zeros((T, D), h.dtype).at[buf_tok].add(yb * buf_gate[:, None].astype(yb.dtype))
    return y.reshape(B, S, D)


def setup_inputs(seed: int = 0) -> dict:
    key = jax.random.key(seed)
    ks = jax.random.split(key, 18)
    f32 = jnp.float32

    def nrm(k, shape, scale):
        return jax.random.normal(k, shape, f32) * scale

    x = nrm(ks[0], (BATCH, SEQ, D_MODEL), 1.0)
    w_in_even = nrm(ks[1], (N_EVEN, D_MODEL, EVEN_IN), D_MODEL ** -0.5)
    w_out_even = nrm(ks[2], (N_EVEN, EVEN_OUT, D_MODEL), EVEN_OUT ** -0.5 * DN_BETA)
    lru_conv_w = nrm(ks[3], (N_EVEN, LRU_CONV, LRU_WIDTH), LRU_CONV ** -0.5)
    lru_conv_b = nrm(ks[4], (N_EVEN, LRU_WIDTH), 0.01)
    lru_gate_w = nrm(ks[5], (N_EVEN, 2, 2, LRU_BLOCKS, LRU_BW, LRU_BW), LRU_BW ** -0.5)
    lru_gate_b = nrm(ks[6], (N_EVEN, 2, 2, LRU_BLOCKS, LRU_BW), 0.01)
    u = jax.random.uniform(ks[7], (N_EVEN, 2, LRU_WIDTH), f32, 0.9, 0.999)
    a = u ** (1.0 / LRU_C)
    lru_lambda = jnp.log(a) - jnp.log1p(-a)
    w_in_odd = nrm(ks[8], (N_ODD, D_MODEL, ODD_IN), D_MODEL ** -0.5)
    w_out_odd = nrm(ks[9], (N_ODD, HG_HEADS * HG_DV, D_MODEL), (HG_HEADS * HG_DV) ** -0.5 * DN_BETA)
    hg_lower_bounds = nrm(ks[10], (DEPTH, HG_HEADS * HG_DK), 0.5)
    hg_norm_w = 1.0 + nrm(ks[11], (N_ODD, HG_HEADS * HG_DV), 0.02)
    ln_w = 1.0 + nrm(ks[12], (DEPTH, 2, D_MODEL), 0.02)
    ln_b = nrm(ks[13], (DEPTH, 2, D_MODEL), 0.02)
    router_w = nrm(ks[14], (D_MODEL, N_EXPERTS), D_MODEL ** -0.5)
    moe_w_gate = nrm(ks[15], (DEPTH, N_EXPERTS, D_MODEL, D_EXPERT), D_MODEL ** -0.5)
    moe_w_up = nrm(ks[16], (DEPTH, N_EXPERTS, D_MODEL, D_EXPERT), D_MODEL ** -0.5)
    moe_w_down = nrm(ks[17], (DEPTH, N_EXPERTS, D_EXPERT, D_MODEL), D_EXPERT ** -0.5 * DN_BETA)
    return {'x': x, 'w_in_even': w_in_even, 'w_out_even': w_out_even,
            'lru_conv_w': lru_conv_w, 'lru_conv_b': lru_conv_b,
            'lru_gate_w': lru_gate_w, 'lru_gate_b': lru_gate_b, 'lru_lambda': lru_lambda,
            'w_in_odd': w_in_odd, 'w_out_odd': w_out_odd,
            'hg_lower_bounds': hg_lower_bounds, 'hg_norm_w': hg_norm_w,
            'ln_w': ln_w, 'ln_b': ln_b, 'router_w': router_w,
            'moe_w_gate': moe_w_gate, 'moe_w_up': moe_w_up, 'moe_w_down': moe_w_down}


def reference(x, w_in_even, w_out_even, lru_conv_w, lru_conv_b, lru_gate_w, lru_gate_b,
              lru_lambda, w_in_odd, w_out_odd, hg_lower_bounds, hg_norm_w, ln_w, ln_b,
              router_w, moe_w_gate, moe_w_up, moe_w_down):
    h = x
    for layer in range(DEPTH):
        j = layer // 2
        if layer % 2 == 0:
            y = _even_mixer(h, w_in_even[j], w_out_even[j], lru_conv_w[j], lru_conv_b[j],
                            lru_gate_w[j], lru_gate_b[j], lru_lambda[j])
        else:
            y = _odd_mixer(h, w_in_odd[j], w_out_odd[j], hg_lower_bounds, hg_norm_w[j], layer)
        h = _layer_norm(DN_ALPHA * h + y, ln_w[layer, 0], ln_b[layer, 0])
        y = _moe(h, router_w, moe_w_gate[layer], moe_w_up[layer], moe_w_down[layer])
        h = _layer_norm(DN_ALPHA * h + y, ln_w[layer, 1], ln_b[layer, 1])
    return h
```

```cpp
#include <hip/hip_runtime.h>
#include <cstdio>
#include <cstdint>

namespace pg8 {
#define PG8_LAS __attribute__((address_space(3)))
typedef unsigned short bf16_t;
typedef short bf16x8 __attribute__((ext_vector_type(8)));
typedef float f32x4 __attribute__((ext_vector_type(4)));
typedef unsigned u32x4 __attribute__((ext_vector_type(4)));
constexpr int BM = 256, BK = 64, HALF = 128, HTB = HALF * BK * 2  , STAGE_BYTES = 8 * HTB, NXCD = 8, WGM = 8;

__host__ __device__ __forceinline__ int lds_byte(int r, int c) { const int st = (r >> 4) * 2 + (c >> 5), rr = r & 15, cc = c & 31, ob = rr * 64 + cc * 2; return st * 1024 + (ob ^ (((ob >> 9) & 1) << 5)); }
__host__ __device__ __forceinline__ void stage_rc(int b, int& R, int& C) { const int st = b / 1024, sb = b % 1024, swz = sb ^ (((sb >> 9) & 1) << 5); R = (st >> 1) * 16 + swz / 64; C = (st & 1) * 32 + (swz % 64) / 2; }
__host__ __device__ __forceinline__ int perm32(int rho) { const int n = rho >> 4, i = rho & 15; return 8 * (i >> 2) + 4 * n + (i & 3); }

struct Unit { int pm, pn; size_t aoff, boff; };
struct Gemm { const bf16_t* A; const bf16_t* Bt; int M, N, K; };

struct StaticOrder {
    int nM, nN, nwg, G, c; size_t tstep;
    __host__ __device__ void init(int M, int N, int K, int G_, int c_) { nM = M / BM; nN = N / BM; nwg = nM * nN; G = G_; c = c_; tstep = (size_t)BM * K * 2; }
    __host__ __device__ bool next(int i, Unit& u) const {
        const long L = (long)i * G + c; if (L >= nwg) return false;
        int wgid = (int)L; { const int q = nwg / NXCD, r = nwg % NXCD, xcd = wgid % NXCD, off = wgid / NXCD; wgid = (xcd < r ? xcd * (q + 1) : r * (q + 1) + (xcd - r) * q) + off; }
        const int nig = WGM * nN, gid = wgid / nig, fm = gid * WGM, gsz = (nM - fm) < WGM ? (nM - fm) : WGM;
        u.pm = fm + ((wgid % nig) % gsz); u.pn = (wgid % nig) / gsz; u.aoff = (size_t)u.pm * tstep; u.boff = (size_t)u.pn * tstep; return true;
    }
    __device__ __forceinline__ void a_ready(const Unit&) const {}
    __device__ __forceinline__ void done(const Unit&) const {}
};
struct GroupedOrder {
    const int* tile_e; int ntiles, nN, G, c; size_t tstep, estride;
    __device__ bool next(int i, Unit& u) const {
        const long L = (long)i * G + c; if (L >= (long)ntiles * nN) return false;
        u.pm = (int)(L / nN); u.pn = (int)(L % nN);
        const int e = __builtin_amdgcn_readfirstlane(tile_e[u.pm]);
        u.aoff = (size_t)u.pm * tstep; u.boff = (size_t)e * estride + (size_t)u.pn * tstep; return true;
    }
    __device__ __forceinline__ void a_ready(const Unit&) const {}
    __device__ __forceinline__ void done(const Unit&) const {}
};

__device__ __forceinline__ unsigned cvt_pk_bf16(float lo, float hi) { unsigned r; asm volatile("v_cvt_pk_bf16_f32 %0, %1, %2" : "=v"(r) : "v"(lo), "v"(hi)); return r; }

template <class Epi, class Sched, bool ALIGN_EPI = false, bool SP2 = false>
__device__ __forceinline__ void gemm_phase(PG8_LAS unsigned char* lds, const Gemm g, const Sched& S, const Epi& E) {
    const int tid = threadIdx.x, wid = __builtin_amdgcn_readfirstlane(tid >> 6), lane = tid & 63, wr = wid >> 2, wc = wid & 3, fr = lane & 15, fq = lane >> 4;
    const int K = g.K, nt = K / BK;
    unsigned voffA[2], voffB[2];
#pragma unroll
    for (int i = 0; i < 2; ++i) { int R, C; stage_rc(tid * 16 + i * 8192, R, C); const int Rb = Epi::PERM ? ((R & ~31) + perm32(R & 31)) : R;
        voffA[i] = (unsigned)(R * K + C) * 2u; voffB[i] = (unsigned)(Rb * K + C) * 2u; }
    const size_t kstep = (size_t)(BK * 2);
    const size_t hstep = (size_t)HALF * K * 2;
    const unsigned ldsw = (unsigned)wid * 1024u;
    const int aoff = lds_byte(wr * 64 + fr, fq * 8), boff = lds_byte(wc * 32 + fr, fq * 8);
#define PG8_SA(b, h) (((b) * 2 + (h)) * HTB)
#define PG8_SB(b, h) ((4 + (b) * 2 + (h)) * HTB)
#define PG8_STAGE(bufoff, gbase, voff) do { _Pragma("unroll") for (int _i = 0; _i < 2; ++_i) \
        __builtin_amdgcn_global_load_lds((const unsigned*)((const char*)(gbase) + (voff)[_i]), (PG8_LAS unsigned*)(lds + (bufoff) + ldsw + _i * 8192), 16, 0, 0); } while (0)
#define PG8_LDA(dst, b, h) do { _Pragma("unroll") for (int m = 0; m < 4; ++m) _Pragma("unroll") for (int k = 0; k < 2; ++k) dst[m][k] = *(const PG8_LAS bf16x8*)(lds + PG8_SA(b, h) + aoff + m * 2048 + k * 1024); } while (0)
#define PG8_LDB(dst, b, h) do { _Pragma("unroll") for (int n = 0; n < 2; ++n) _Pragma("unroll") for (int k = 0; k < 2; ++k) dst[n][k] = *(const PG8_LAS bf16x8*)(lds + PG8_SB(b, h) + boff + n * 2048 + k * 1024); } while (0)
#define PG8_MMA(ai, bj, At, Bt) do { __builtin_amdgcn_s_setprio(1); _Pragma("unroll") for (int m = 0; m < 4; ++m) _Pragma("unroll") for (int n = 0; n < 2; ++n) _Pragma("unroll") for (int k = 0; k < 2; ++k) \
        acc[ai][bj][m][n] = __builtin_amdgcn_mfma_f32_16x16x32_bf16(Bt[n][k], At[m][k], acc[ai][bj][m][n], 0, 0, 0); __builtin_amdgcn_s_setprio(0); } while (0)
#define PG8_WAIT_V(n) asm volatile("s_waitcnt vmcnt(" #n ")" ::: "memory")
#define PG8_WAIT_L(n) asm volatile("s_waitcnt lgkmcnt(" #n ")" ::: "memory")
#define PG8_BAR __builtin_amdgcn_s_barrier()
#define PG8_SCHED __builtin_amdgcn_sched_barrier(0)
    Unit cur, nxt; int ui = 0;
    if (!S.next(0, cur)) return;
    f32x4 acc[2][2][4][2];
#pragma unroll
    for (int a = 0; a < 2; ++a)
#pragma unroll
        for (int b = 0; b < 2; ++b)
#pragma unroll
            for (int m = 0; m < 4; ++m)
#pragma unroll
                for (int n = 0; n < 2; ++n) acc[a][b][m][n] = (f32x4){0.f, 0.f, 0.f, 0.f};
    bf16x8 At[4][2], B0[2][2], B1[2][2];
    const char* cA = (const char*)g.A + cur.aoff; const char* cB = (const char*)g.Bt + cur.boff;
    S.a_ready(cur);
    if constexpr (SP2) {
        PG8_STAGE(PG8_SB(0, 0), cB, voffB); PG8_STAGE(PG8_SB(0, 1), cB + hstep, voffB); PG8_STAGE(PG8_SA(0, 0), cA, voffA); PG8_STAGE(PG8_SA(0, 1), cA + hstep, voffA);
        if (wr == 1) PG8_BAR;
        PG8_WAIT_V(2); PG8_BAR;
        PG8_STAGE(PG8_SB(1, 0), cB + kstep, voffB); PG8_STAGE(PG8_SA(1, 0), cA + kstep, voffA); PG8_STAGE(PG8_SB(1, 1), cB + hstep + kstep, voffB);
        PG8_WAIT_V(6); PG8_BAR;
    } else {
        PG8_STAGE(PG8_SB(0, 0), cB, voffB); PG8_STAGE(PG8_SA(0, 0), cA, voffA); PG8_STAGE(PG8_SB(0, 1), cB + hstep, voffB); PG8_STAGE(PG8_SA(0, 1), cA + hstep, voffA);
        if (wr == 1) PG8_BAR;
        PG8_WAIT_V(4); PG8_BAR;
        PG8_STAGE(PG8_SB(1, 0), cB + kstep, voffB); PG8_STAGE(PG8_SA(1, 0), cA + kstep, voffA); PG8_STAGE(PG8_SB(1, 1), cB + hstep + kstep, voffB);
        PG8_WAIT_V(6); PG8_BAR;
    }
    for (;;) {
        const bool has_next = S.next(ui + 1, nxt);
        const char* nA = has_next ? (const char*)g.A + nxt.aoff : cA; const char* nB = has_next ? (const char*)g.Bt + nxt.boff : cB;
        for (int t = 0; t < nt; t += 2) {
            const bool last = (t == nt - 2);
            const char* a1 = cA + (size_t)(t + 1) * kstep;
            const char* a2 = last ? nA : cA + (size_t)(t + 2) * kstep; const char* b2 = last ? nB : cB + (size_t)(t + 2) * kstep;
            const char* a3 = a2 + kstep; const char* b3 = b2 + kstep;
            if (last && has_next) S.a_ready(nxt);
            if constexpr (SP2) {
            PG8_LDB(B0, 0, 0); PG8_LDB(B1, 0, 1); PG8_SCHED; PG8_LDA(At, 0, 0); PG8_STAGE(PG8_SA(1, 1), a1 + hstep, voffA);
            PG8_WAIT_V(8); PG8_WAIT_L(0); PG8_BAR; PG8_MMA(0, 0, At, B0); PG8_MMA(0, 1, At, B1); PG8_BAR; PG8_SCHED;
            PG8_LDA(At, 0, 1); PG8_STAGE(PG8_SB(0, 0), b2, voffB); PG8_STAGE(PG8_SB(0, 1), b2 + hstep, voffB); PG8_STAGE(PG8_SA(0, 0), a2, voffA);
            PG8_WAIT_V(8); PG8_WAIT_L(0); PG8_BAR; PG8_MMA(1, 0, At, B0); PG8_MMA(1, 1, At, B1); PG8_BAR; PG8_SCHED;
            PG8_LDB(B0, 1, 0); PG8_LDB(B1, 1, 1); PG8_SCHED; PG8_LDA(At, 1, 0); PG8_STAGE(PG8_SA(0, 1), a2 + hstep, voffA);
            PG8_WAIT_V(8); PG8_WAIT_L(0); PG8_BAR; PG8_MMA(0, 0, At, B0); PG8_MMA(0, 1, At, B1); PG8_BAR; PG8_SCHED;
            PG8_LDA(At, 1, 1); PG8_STAGE(PG8_SB(1, 0), b3, voffB); PG8_STAGE(PG8_SB(1, 1), b3 + hstep, voffB); PG8_STAGE(PG8_SA(1, 0), a3, voffA);
            PG8_WAIT_V(8); PG8_WAIT_L(0); PG8_BAR; PG8_MMA(1, 0, At, B0); PG8_MMA(1, 1, At, B1); PG8_BAR; PG8_SCHED;
            } else {
            PG8_LDB(B0, 0, 0); PG8_SCHED; PG8_LDA(At, 0, 0); PG8_STAGE(PG8_SA(1, 1), a1 + hstep, voffA);
            PG8_WAIT_L(8); PG8_BAR; PG8_WAIT_L(0); PG8_MMA(0, 0, At, B0); PG8_BAR; PG8_SCHED;
            PG8_LDB(B1, 0, 1); PG8_STAGE(PG8_SB(0, 0), b2, voffB);
            PG8_BAR; PG8_WAIT_L(0); PG8_MMA(0, 1, At, B1); PG8_BAR;
            PG8_LDA(At, 0, 1); PG8_STAGE(PG8_SA(0, 0), a2, voffA);
            PG8_BAR; PG8_WAIT_L(0); PG8_MMA(1, 0, At, B0); PG8_BAR; PG8_SCHED;
            PG8_STAGE(PG8_SB(0, 1), b2 + hstep, voffB);
            PG8_WAIT_V(6); PG8_BAR; PG8_MMA(1, 1, At, B1); PG8_BAR;
            PG8_LDB(B0, 1, 0); PG8_SCHED; PG8_LDA(At, 1, 0); PG8_STAGE(PG8_SA(0, 1), a2 + hstep, voffA);
            PG8_WAIT_L(8); PG8_BAR; PG8_WAIT_L(0); PG8_MMA(0, 0, At, B0); PG8_BAR; PG8_SCHED;
            PG8_LDB(B1, 1, 1); PG8_STAGE(PG8_SB(1, 0), b3, voffB);
            PG8_BAR; PG8_WAIT_L(0); PG8_MMA(0, 1, At, B1); PG8_BAR;
            PG8_LDA(At, 1, 1); PG8_STAGE(PG8_SA(1, 0), a3, voffA);
            PG8_BAR; PG8_WAIT_L(0); PG8_MMA(1, 0, At, B0); PG8_BAR; PG8_SCHED;
            PG8_STAGE(PG8_SB(1, 1), b3 + hstep, voffB);
            PG8_WAIT_V(6); PG8_BAR; PG8_MMA(1, 1, At, B1); PG8_BAR;
            }
        }
        if constexpr (ALIGN_EPI) { if (wr == 0) PG8_BAR; }
        if constexpr (!Epi::AFTER_DRAIN) { E(acc, cur, wr, wc, fr, fq); S.done(cur); }
        if (!has_next) break;
#pragma unroll
        for (int a = 0; a < 2; ++a)
#pragma unroll
            for (int b = 0; b < 2; ++b)
#pragma unroll
                for (int m = 0; m < 4; ++m)
#pragma unroll
                    for (int n = 0; n < 2; ++n) acc[a][b][m][n] = (f32x4){0.f, 0.f, 0.f, 0.f};
        cur = nxt; cA = nA; cB = nB; ++ui;
        if constexpr (ALIGN_EPI) { if (wr == 1) PG8_BAR; }
    }
    PG8_WAIT_V(0);
    if constexpr (!ALIGN_EPI) { if (wr == 0) PG8_BAR; }
    PG8_BAR;
    if constexpr (Epi::AFTER_DRAIN) { E.fused(acc, cur, wr, wc, fr, fq, lds, wid, lane); S.done(cur); }
#undef PG8_SA
#undef PG8_SB
#undef PG8_STAGE
#undef PG8_LDA
#undef PG8_LDB
#undef PG8_MMA
#undef PG8_WAIT_V
#undef PG8_WAIT_L
#undef PG8_BAR
#undef PG8_SCHED
}
}

using pg8::bf16_t; using pg8::bf16x8; using pg8::f32x4; using pg8::u32x4; using pg8::Unit;
typedef float f32x2 __attribute__((ext_vector_type(2)));
typedef unsigned u32x2 __attribute__((ext_vector_type(2)));
#define LAS __attribute__((address_space(3)))

constexpr int NB = 2, SEQ = 8192, T = NB * SEQ, D = 1024;
constexpr int EVEN_IN = 2560, ODD_IN = 5120;
constexpr int NEXP = 16, DEXP = 512;
constexpr int PMAX = 36864;
constexpr int MAXTILES = PMAX / 256;
constexpr float DN_ALPHA = 1.41421356237f;
constexpr float LN_EPS = 1e-5f, RMS_EPS = 1e-6f;

constexpr size_t MiB = 1u << 20;
constexpr size_t WS_CTL = 0, CTL_BYTES = 1 * MiB;
constexpr size_t WS_ROPE = 1 * MiB;
constexpr size_t WS_LBV = 3 * MiB;
constexpr size_t WS_WINE = 4 * MiB;
constexpr size_t WS_WOUTE = 9 * MiB;
constexpr size_t WS_WINO = 11 * MiB;
constexpr size_t WS_WOUTO = 21 * MiB;
constexpr size_t WS_LGT = 23 * MiB;
constexpr size_t WS_HB = 24 * MiB;
constexpr size_t WS_PROJ = 56 * MiB;
constexpr size_t WS_XS = WS_PROJ;
constexpr size_t WS_HID = WS_PROJ + 72 * MiB;
constexpr size_t WS_SCR = WS_PROJ + 80 * MiB;
constexpr size_t WS_WGU = 216 * MiB;
constexpr size_t WS_WD = 248 * MiB;
constexpr size_t WS_TOK = 264 * MiB;
constexpr size_t WS_END = 266 * MiB;
constexpr int CW_COUNTS = 1024;
constexpr int CW_CURSOR = 1024 + 64;
constexpr int CW_NTILES = 1024 + 128;
constexpr int CW_TILEE = 2048;
constexpr size_t TOK_E = 0, TOK_G = 128 * 1024, TOK_SLOT = 256 * 1024, TOK_BH = 384 * 1024;

struct Params {
    const float* x; const float* w_in_even; const float* w_out_even; const float* conv_w; const float* conv_b; const float* gate_w; const float* gate_b; const float* lam;
    const float* w_in_odd; const float* w_out_odd; const float* lower_bounds; const float* norm_w; const float* ln_w; const float* ln_b; const float* router_w;
    const float* moe_gate; const float* moe_up; const float* moe_down;
    float* out; unsigned char* ws;
};

__device__ __forceinline__ float bf2f(unsigned b) { return __uint_as_float(b << 16); }
__device__ __forceinline__ float bflo(unsigned u) { return __uint_as_float(u << 16); }
__device__ __forceinline__ float bfhi(unsigned u) { return __uint_as_float(u & 0xffff0000u); }
__device__ __forceinline__ unsigned f2bf(float f) { unsigned u = __float_as_uint(f); return (u + 0x7fffu + ((u >> 16) & 1u)) >> 16; }
__device__ __forceinline__ unsigned pk2(float lo, float hi) { return f2bf(lo) | (f2bf(hi) << 16); }
__device__ __forceinline__ float sigm(float x) { return 1.f / (1.f + __expf(-x)); }
__device__ __forceinline__ float silu(float x) { return x / (1.f + __expf(-x)); }
__device__ __forceinline__ float gelu_tanh(float x) { const float u = 0.7978845608028654f * (x + 0.044715f * x * x * x); return 0.5f * x * (1.f + tanhf(u)); }
__device__ __forceinline__ float wave_sum(float v) {
#pragma unroll
    for (int o = 1; o < 64; o <<= 1) v += __shfl_xor(v, o);
    return v;
}
#define LDS_WAIT() asm volatile("s_waitcnt lgkmcnt(0)" ::: "memory")

__device__ __forceinline__ void store8bf(bf16_t* p, const f32x4& v0, const f32x4& v1) {
    u32x4 w; w.x = pg8::cvt_pk_bf16(v0[0], v0[1]); w.y = pg8::cvt_pk_bf16(v0[2], v0[3]); w.z = pg8::cvt_pk_bf16(v1[0], v1[1]); w.w = pg8::cvt_pk_bf16(v1[2], v1[3]);
    *(u32x4*)p = w;
}
struct EpiInproj0 {
    static constexpr bool PERM = true, AFTER_DRAIN = false;
    bf16_t* O; const float* rope;
    __device__ __forceinline__ void operator()(const f32x4 (&acc)[2][2][4][2], const Unit& u, int wr, int wc, int fr, int fq) const {
        const int row0 = u.pm * 256 + wr * 64 + fr, colt = u.pn * 256 + wc * 32 + 8 * fq;
#pragma unroll
        for (int ai = 0; ai < 2; ++ai)
#pragma unroll
            for (int m = 0; m < 4; ++m) {
                const int row = row0 + ai * 128 + m * 16; const int pos = row & (SEQ - 1);
#pragma unroll
                for (int bj = 0; bj < 2; ++bj) {
                    const int col = colt + bj * 128;
                    f32x4 v0 = acc[ai][bj][m][0], v1 = acc[ai][bj][m][1];
                    if (u.pn < 2) {
                        const float sc = (col < 256) ? 0.125f : 1.0f;
                        const f32x4* rp = (const f32x4*)(rope + ((size_t)pos * 32 + ((col & 63) >> 1)) * 2);
                        const f32x4 c0 = rp[0], c1 = rp[1];
                        f32x4 r0, r1;
                        r0[0] = (v0[0] * c0[0] - v0[1] * c0[1]) * sc; r0[1] = (v0[0] * c0[1] + v0[1] * c0[0]) * sc;
                        r0[2] = (v0[2] * c0[2] - v0[3] * c0[3]) * sc; r0[3] = (v0[2] * c0[3] + v0[3] * c0[2]) * sc;
                        r1[0] = (v1[0] * c1[0] - v1[1] * c1[1]) * sc; r1[1] = (v1[0] * c1[1] + v1[1] * c1[0]) * sc;
                        r1[2] = (v1[2] * c1[2] - v1[3] * c1[3]) * sc; r1[3] = (v1[2] * c1[3] + v1[3] * c1[2]) * sc;
                        v0 = r0; v1 = r1;
                    }
                    store8bf(O + (size_t)row * EVEN_IN + col, v0, v1);
                }
            }
    }
};
struct EpiInproj1 {
    static constexpr bool PERM = true, AFTER_DRAIN = false;
    bf16_t* O; const float* lbv;
    __device__ __forceinline__ void operator()(const f32x4 (&acc)[2][2][4][2], const Unit& u, int wr, int wc, int fr, int fq) const {
        const int row0 = u.pm * 256 + wr * 64 + fr, colt = u.pn * 256 + wc * 32 + 8 * fq;
        const int seg = u.pn >> 2;
#pragma unroll
        for (int bj = 0; bj < 2; ++bj) {
            const int col = colt + bj * 128;
            f32x4 lb0 = {0.f, 0.f, 0.f, 0.f}, lb1 = {0.f, 0.f, 0.f, 0.f};
            if (seg == 2 || seg == 3) { lb0 = *(const f32x4*)(lbv + (col & 1023)); lb1 = *(const f32x4*)(lbv + (col & 1023) + 4); }
#pragma unroll
            for (int ai = 0; ai < 2; ++ai)
#pragma unroll
                for (int m = 0; m < 4; ++m) {
                    const int row = row0 + ai * 128 + m * 16;
                    f32x4 v0 = acc[ai][bj][m][0], v1 = acc[ai][bj][m][1];
                    if (seg == 0) {
#pragma unroll
                        for (int j = 0; j < 4; ++j) { v0[j] = silu(v0[j]) * 0.08838834764831845f; v1[j] = silu(v1[j]) * 0.08838834764831845f; }
                    } else if (seg == 2 || seg == 3) {
#pragma unroll
                        for (int j = 0; j < 4; ++j) { v0[j] = __logf(lb0[j] + (1.f - lb0[j]) * sigm(v0[j])); v1[j] = __logf(lb1[j] + (1.f - lb1[j]) * sigm(v1[j])); }
                    }
                    store8bf(O + (size_t)row * ODD_IN + col, v0, v1);
                }
        }
    }
};
struct EpiResid {
    static constexpr bool PERM = false, AFTER_DRAIN = false;
    const float* res; float* out;
    __device__ __forceinline__ void operator()(const f32x4 (&acc)[2][2][4][2], const Unit& u, int wr, int wc, int fr, int fq) const {
        const int row0 = u.pm * 256 + wr * 64 + fr, col0 = u.pn * 256 + wc * 32 + 4 * fq;
#pragma unroll
        for (int ai = 0; ai < 2; ++ai)
#pragma unroll
            for (int m = 0; m < 4; ++m) {
                const size_t off = (size_t)(row0 + ai * 128 + m * 16) * D + col0;
#pragma unroll
                for (int bj = 0; bj < 2; ++bj)
#pragma unroll
                    for (int n = 0; n < 2; ++n) { const f32x4 r = *(const f32x4*)(res + off + bj * 128 + n * 16); *(f32x4*)(out + off + bj * 128 + n * 16) = r * DN_ALPHA + acc[ai][bj][m][n]; }
            }
    }
};
struct EpiGateUp {
    static constexpr bool PERM = true, AFTER_DRAIN = false;
    bf16_t* O;
    __device__ __forceinline__ void operator()(const f32x4 (&acc)[2][2][4][2], const Unit& u, int wr, int wc, int fr, int fq) const {
        const int row0 = u.pm * 256 + wr * 64 + fr, col = u.pn * 128 + wc * 32 + 8 * fq;
#pragma unroll
        for (int ai = 0; ai < 2; ++ai)
#pragma unroll
            for (int m = 0; m < 4; ++m) {
                const int row = row0 + ai * 128 + m * 16;
                f32x4 v0, v1;
#pragma unroll
                for (int j = 0; j < 4; ++j) { v0[j] = silu(acc[ai][0][m][0][j]) * acc[ai][1][m][0][j]; v1[j] = silu(acc[ai][0][m][1][j]) * acc[ai][1][m][1][j]; }
                store8bf(O + (size_t)row * DEXP + col, v0, v1);
            }
    }
};
struct EpiBf16 {
    static constexpr bool PERM = true, AFTER_DRAIN = false;
    bf16_t* O; int ldc;
    __device__ __forceinline__ void operator()(const f32x4 (&acc)[2][2][4][2], const Unit& u, int wr, int wc, int fr, int fq) const {
        const int row0 = u.pm * 256 + wr * 64 + fr, colt = u.pn * 256 + wc * 32 + 8 * fq;
#pragma unroll
        for (int ai = 0; ai < 2; ++ai)
#pragma unroll
            for (int m = 0; m < 4; ++m) {
                const int row = row0 + ai * 128 + m * 16;
#pragma unroll
                for (int bj = 0; bj < 2; ++bj) store8bf(O + (size_t)row * ldc + colt + bj * 128, acc[ai][bj][m][0], acc[ai][bj][m][1]);
            }
    }
};

__device__ __forceinline__ void transpose_item(const float* W, int N, bf16_t* WT, int K, int k0, int n0, int drow0, LAS float* scr, int lane) {
#pragma unroll 8
    for (int i = 0; i < 32; ++i) { const int kk = 2 * i + (lane >> 5); scr[kk * 33 + (lane & 31)] = W[(size_t)(k0 + kk) * N + n0 + (lane & 31)]; }
    LDS_WAIT();
    const int c = lane & 7;
#pragma unroll
    for (int j = 0; j < 4; ++j) { const int n = (lane >> 3) + 8 * j; const LAS float* s = scr + (8 * c) * 33 + n;
        u32x4 o; o.x = pk2(s[0 * 33], s[1 * 33]); o.y = pk2(s[2 * 33], s[3 * 33]); o.z = pk2(s[4 * 33], s[5 * 33]); o.w = pk2(s[6 * 33], s[7 * 33]);
        *(u32x4*)(WT + (size_t)(drow0 + n) * K + k0 + 8 * c) = o; }
    LDS_WAIT();
}
__device__ __forceinline__ void transpose_dense(const float* W, int K, int N, bf16_t* WT, int item, LAS float* scr, int lane) {
    const int nblk = N / 32, kb = item / nblk, nb = item % nblk;
    transpose_item(W, N, WT, K, 64 * kb, 32 * nb, 32 * nb, scr, lane);
}
__device__ __forceinline__ void prologue_static(const Params& p, LAS float* scr, int gw, int ngw, int lane) {
    unsigned char* ws = p.ws;
    constexpr int I_WINE = 16 * 80, I_WOUTE = 16 * 32, I_WINO = 16 * 160, I_WOUTO = 16 * 32, I_LG = 16 * 8;
    constexpr int NITEMS = I_WINE + I_WOUTE + I_WINO + I_WOUTO + I_LG;
    for (int it = gw; it < NITEMS; it += ngw) {
        int r = it;
        if (r < I_WINE) { transpose_dense(p.w_in_even, 1024, EVEN_IN, (bf16_t*)(ws + WS_WINE), r, scr, lane); continue; } r -= I_WINE;
        if (r < I_WOUTE) { transpose_dense(p.w_out_even, 1024, 1024, (bf16_t*)(ws + WS_WOUTE), r, scr, lane); continue; } r -= I_WOUTE;
        if (r < I_WINO) { transpose_dense(p.w_in_odd, 1024, ODD_IN, (bf16_t*)(ws + WS_WINO), r, scr, lane); continue; } r -= I_WINO;
        if (r < I_WOUTO) { transpose_dense(p.w_out_odd, 1024, 1024, (bf16_t*)(ws + WS_WOUTO), r, scr, lane); continue; } r -= I_WOUTO;
        { const int mat = r >> 3, sub = r & 7;
          transpose_dense(p.gate_w + (size_t)mat * 128 * 128, 128, 128, (bf16_t*)(ws + WS_LGT) + (size_t)mat * 128 * 128, sub, scr, lane); }
    }
    { const size_t n8 = (size_t)T * D / 8; bf16_t* xb = (bf16_t*)(ws + WS_HB);
      for (size_t i = (size_t)gw * 64 + lane; i < n8; i += (size_t)ngw * 64) {
          const f32x4 a = *(const f32x4*)(p.x + i * 8), b = *(const f32x4*)(p.x + i * 8 + 4);
          u32x4 o; o.x = pk2(a[0], a[1]); o.y = pk2(a[2], a[3]); o.z = pk2(b[0], b[1]); o.w = pk2(b[2], b[3]);
          *(u32x4*)(xb + i * 8) = o; } }
    { float* rope = (float*)(ws + WS_ROPE);
      for (int i = gw * 64 + lane; i < SEQ * 32; i += ngw * 64) {
          const int pos = i >> 5, fi = i & 31;
          const double inv = pow(10000.0, -(double)(2 * fi) / 64.0); const double ang = (double)pos * inv;
          rope[2 * i] = (float)cos(ang); rope[2 * i + 1] = (float)sin(ang); }
      float* lbv = (float*)(ws + WS_LBV);
      for (int i = gw * 64 + lane; i < 1024; i += ngw * 64) { const float l0 = p.lower_bounds[i], l1 = p.lower_bounds[1024 + i]; lbv[i] = 1.f / (1.f + expf(l0 - l1)); } }
}
__device__ __forceinline__ void prologue_moe(const Params& p, int layer, LAS float* scr, int gw, int ngw, int lane) {
    unsigned char* ws = p.ws;
    constexpr int I_GU = 16 * 16, I_D = 8 * 32;
    constexpr int NITEMS = NEXP * (2 * I_GU + I_D);
    for (int it = gw; it < NITEMS; it += ngw) {
        const int e = it / (2 * I_GU + I_D); int r = it % (2 * I_GU + I_D);
        if (r < 2 * I_GU) { const int sel = r / I_GU; r %= I_GU; const int kb = r / 16, nb = r % 16, n0 = 32 * nb;
            const float* W = (sel ? p.moe_up : p.moe_gate) + ((size_t)layer * NEXP + e) * 1024 * 512;
            transpose_item(W, 512, (bf16_t*)(ws + WS_WGU) + (size_t)e * 1024 * 1024, 1024, 64 * kb, n0, 256 * (n0 >> 7) + 128 * sel + (n0 & 127), scr, lane);
        } else { r -= 2 * I_GU;
            const float* W = p.moe_down + ((size_t)layer * NEXP + e) * 512 * 1024;
            transpose_dense(W, 512, 1024, (bf16_t*)(ws + WS_WD) + (size_t)e * 1024 * 512, r, scr, lane); }
    }
}

__device__ __forceinline__ void ln_rows_store(const f32x4 (&v)[4], const float* lw, const float* lb, float* orow, bf16_t* brow, int lane, f32x4 (&h)[4]) {
    float s = 0.f;
#pragma unroll
    for (int j = 0; j < 4; ++j) s += (v[j][0] + v[j][1]) + (v[j][2] + v[j][3]);
    const float mean = wave_sum(s) * (1.f / D); float s2 = 0.f;
#pragma unroll
    for (int j = 0; j < 4; ++j) { const f32x4 d = v[j] - mean; s2 += (d[0] * d[0] + d[1] * d[1]) + (d[2] * d[2] + d[3] * d[3]); }
    const float rstd = 1.f / sqrtf(wave_sum(s2) * (1.f / D) + LN_EPS);
#pragma unroll
    for (int j = 0; j < 4; ++j) { const int c = 4 * lane + 256 * j; const f32x4 w = *(const f32x4*)(lw + c), b = *(const f32x4*)(lb + c);
        h[j] = (v[j] - mean) * rstd * w + b;
        *(f32x4*)(orow + c) = h[j];
        u32x2 o; o.x = pk2(h[j][0], h[j][1]); o.y = pk2(h[j][2], h[j][3]); *(u32x2*)(brow + c) = o; }
}
__device__ __forceinline__ void ln_router_row(const Params& p, int layer, int row, int lane, LAS int* hist) {
    unsigned char* ws = p.ws; float* res = p.out + (size_t)row * D; bf16_t* hb = (bf16_t*)(ws + WS_HB) + (size_t)row * D;
    f32x4 v[4], h[4];
#pragma unroll
    for (int j = 0; j < 4; ++j) v[j] = *(const f32x4*)(res + 4 * lane + 256 * j);
    ln_rows_store(v, p.ln_w + (size_t)(layer * 2 + 0) * D, p.ln_b + (size_t)(layer * 2 + 0) * D, res, hb, lane, h);
    float lg[16];
#pragma unroll
    for (int e = 0; e < 16; ++e) lg[e] = 0.f;
#pragma unroll
    for (int j = 0; j < 4; ++j)
#pragma unroll
        for (int i = 0; i < 4; ++i) { const float* rw = p.router_w + (size_t)(4 * lane + 256 * j + i) * 16; const float hv = h[j][i];
#pragma unroll
            for (int q = 0; q < 4; ++q) { const f32x4 w = *(const f32x4*)(rw + 4 * q); lg[4 * q] += hv * w[0]; lg[4 * q + 1] += hv * w[1]; lg[4 * q + 2] += hv * w[2]; lg[4 * q + 3] += hv * w[3]; } }
#pragma unroll
    for (int e = 0; e < 16; ++e) lg[e] = wave_sum(lg[e]);
    float mx = lg[0];
#pragma unroll
    for (int e = 1; e < 16; ++e) mx = fmaxf(mx, lg[e]);
    float pr[16], sum = 0.f;
#pragma unroll
    for (int e = 0; e < 16; ++e) { pr[e] = expf(lg[e] - mx); sum += pr[e]; }
    const float inv = 1.f / sum;
#pragma unroll
    for (int e = 0; e < 16; ++e) pr[e] *= inv;
    float best = -1.f; int be0 = 0, be1 = 1; float bv0 = 0.f, bv1 = 0.f;
#pragma unroll
    for (int g = 0; g < 4; ++g) {
        int i1 = 0; float v1 = pr[4 * g];
#pragma unroll
        for (int i = 1; i < 4; ++i) if (pr[4 * g + i] > v1) { v1 = pr[4 * g + i]; i1 = i; }
        int i2 = -1; float v2 = -1.f;
#pragma unroll
        for (int i = 0; i < 4; ++i) if (i != i1 && pr[4 * g + i] > v2) { v2 = pr[4 * g + i]; i2 = i; }
        const float sc = v1 + v2;
        if (sc > best) { best = sc; be0 = 4 * g + i1; be1 = 4 * g + i2; bv0 = v1; bv1 = v2; }
    }
    if (lane == 0) {
        int* te = (int*)(ws + WS_TOK + TOK_E); float* tg = (float*)(ws + WS_TOK + TOK_G);
        te[2 * row] = be0; te[2 * row + 1] = be1; const float gs = 1.f / (bv0 + bv1); tg[2 * row] = bv0 * gs; tg[2 * row + 1] = bv1 * gs;
        atomicAdd((int*)&hist[be0], 1); atomicAdd((int*)&hist[be1], 1);
    }
}
__device__ __forceinline__ void combine_ln_row(const Params& p, int layer, int row, int lane) {
    unsigned char* ws = p.ws; float* res = p.out + (size_t)row * D; bf16_t* hb = (bf16_t*)(ws + WS_HB) + (size_t)row * D;
    const int* tsl = (const int*)(ws + WS_TOK + TOK_SLOT); const float* tg = (const float*)(ws + WS_TOK + TOK_G);
    const int s0 = tsl[2 * row], s1 = tsl[2 * row + 1]; const float g0 = tg[2 * row], g1 = tg[2 * row + 1];
    const bf16_t* y0 = (const bf16_t*)(ws + WS_XS) + (size_t)s0 * D; const bf16_t* y1 = (const bf16_t*)(ws + WS_XS) + (size_t)s1 * D;
    f32x4 v[4], h[4];
#pragma unroll
    for (int j = 0; j < 4; ++j) { const int c = 4 * lane + 256 * j; const f32x4 r = *(const f32x4*)(res + c);
        const u32x2 a = *(const u32x2*)(y0 + c), b = *(const u32x2*)(y1 + c);
        v[j][0] = DN_ALPHA * r[0] + g0 * bflo(a.x) + g1 * bflo(b.x); v[j][1] = DN_ALPHA * r[1] + g0 * bfhi(a.x) + g1 * bfhi(b.x);
        v[j][2] = DN_ALPHA * r[2] + g0 * bflo(a.y) + g1 * bflo(b.y); v[j][3] = DN_ALPHA * r[3] + g0 * bfhi(a.y) + g1 * bfhi(b.y); }
    ln_rows_store(v, p.ln_w + (size_t)(layer * 2 + 1) * D, p.ln_b + (size_t)(layer * 2 + 1) * D, res, hb, lane, h);
}

constexpr int GEMM_LDS = 131072;
#define GEMM_KERNEL_PROLOGUE extern __shared__ __attribute__((aligned(16))) unsigned char shm[]; PG8_LAS unsigned char* lds = (PG8_LAS unsigned char*)shm;

__global__ void __launch_bounds__(512, 2) k_prologue(Params p) {
    GEMM_KERNEL_PROLOGUE
    const int wave = threadIdx.x >> 6, lane = threadIdx.x & 63;
    prologue_static(p, (LAS float*)(lds + wave * 16384), blockIdx.x * 8 + wave, gridDim.x * 8, lane);
}
__global__ void __launch_bounds__(512, 2) k_prologue_moe(Params p, int layer) {
    GEMM_KERNEL_PROLOGUE
    const int wave = threadIdx.x >> 6, lane = threadIdx.x & 63;
    prologue_moe(p, layer, (LAS float*)(lds + wave * 16384), blockIdx.x * 8 + wave, gridDim.x * 8, lane);
}
__global__ void __launch_bounds__(512, 2) k_inproj0(Params p) {
    GEMM_KERNEL_PROLOGUE
    pg8::Gemm g{(const bf16_t*)(p.ws + WS_HB), (const bf16_t*)(p.ws + WS_WINE), T, EVEN_IN, D};
    pg8::StaticOrder S; S.init(T, EVEN_IN, D, gridDim.x, blockIdx.x);
    EpiInproj0 E{(bf16_t*)(p.ws + WS_PROJ), (const float*)(p.ws + WS_ROPE)};
    pg8::gemm_phase<EpiInproj0, pg8::StaticOrder, true, true>(lds, g, S, E);
}
__global__ void __launch_bounds__(512, 2) k_inproj1(Params p) {
    GEMM_KERNEL_PROLOGUE
    pg8::Gemm g{(const bf16_t*)(p.ws + WS_HB), (const bf16_t*)(p.ws + WS_WINO), T, ODD_IN, D};
    pg8::StaticOrder S; S.init(T, ODD_IN, D, gridDim.x, blockIdx.x);
    EpiInproj1 E{(bf16_t*)(p.ws + WS_PROJ), (const float*)(p.ws + WS_LBV)};
    pg8::gemm_phase<EpiInproj1, pg8::StaticOrder, true, true>(lds, g, S, E);
}
__global__ void __launch_bounds__(512, 2) k_outproj(Params p, int layer) {
    GEMM_KERNEL_PROLOGUE
    pg8::Gemm g{(const bf16_t*)(p.ws + WS_HB), (const bf16_t*)(p.ws + (layer ? WS_WOUTO : WS_WOUTE)), T, D, D};
    pg8::StaticOrder S; S.init(T, D, D, gridDim.x, blockIdx.x);
    EpiResid E{layer ? (const float*)p.out : p.x, p.out};
    pg8::gemm_phase<EpiResid, pg8::StaticOrder, true, true>(lds, g, S, E);
}
__global__ void __launch_bounds__(512, 2) k_moe_gateup(Params p, int layer) {
    GEMM_KERNEL_PROLOGUE
    const unsigned* ctl = (const unsigned*)(p.ws + WS_CTL);
    pg8::Gemm g{(const bf16_t*)(p.ws + WS_XS), (const bf16_t*)(p.ws + WS_WGU), PMAX, 1024, D};
    pg8::GroupedOrder S; S.tile_e = (const int*)(ctl + CW_TILEE + 256 * layer); S.ntiles = __builtin_amdgcn_readfirstlane((int)ctl[CW_NTILES + layer]); S.nN = 4; S.G = gridDim.x; S.c = blockIdx.x;
    S.tstep = (size_t)256 * D * 2; S.estride = (size_t)1024 * 1024 * 2;
    EpiGateUp E{(bf16_t*)(p.ws + WS_HID)};
    pg8::gemm_phase<EpiGateUp, pg8::GroupedOrder, true, true>(lds, g, S, E);
}
__global__ void __launch_bounds__(512, 2) k_moe_down(Params p, int layer) {
    GEMM_KERNEL_PROLOGUE
    const unsigned* ctl = (const unsigned*)(p.ws + WS_CTL);
    pg8::Gemm g{(const bf16_t*)(p.ws + WS_HID), (const bf16_t*)(p.ws + WS_WD), PMAX, 1024, DEXP};
    pg8::GroupedOrder S; S.tile_e = (const int*)(ctl + CW_TILEE + 256 * layer); S.ntiles = __builtin_amdgcn_readfirstlane((int)ctl[CW_NTILES + layer]); S.nN = 4; S.G = gridDim.x; S.c = blockIdx.x;
    S.tstep = (size_t)256 * DEXP * 2; S.estride = (size_t)1024 * DEXP * 2;
    EpiBf16 E{(bf16_t*)(p.ws + WS_XS), D};
    pg8::gemm_phase<EpiBf16, pg8::GroupedOrder, true, true>(lds, g, S, E);
}

__global__ void __launch_bounds__(128) k_ret_naive(Params p) {
    const int dir = blockIdx.x & 1, bh = blockIdx.x >> 1, b = bh >> 2, h = bh & 3, e = threadIdx.x;
    const bf16_t* proj = (const bf16_t*)(p.ws + WS_PROJ);
    float* O = (float*)(p.ws + WS_SCR) + (size_t)dir * T * 512;
    const float gamma = 1.f - exp2f(-5.f - (float)h);
    float S[64];
#pragma unroll
    for (int d = 0; d < 64; ++d) S[d] = 0.f;
    for (int step = 0; step < SEQ; ++step) {
        const int t = dir ? SEQ - 1 - step : step; const size_t row = (size_t)b * SEQ + t;
        const bf16_t* pr = proj + row * EVEN_IN;
        const float v = bf2f(pr[512 + h * 128 + e]);
        float o = 0.f;
#pragma unroll
        for (int c = 0; c < 8; ++c) {
            const u32x4 qq = *(const u32x4*)(pr + h * 64 + 8 * c), kk = *(const u32x4*)(pr + 256 + h * 64 + 8 * c);
            const unsigned qa[4] = {qq.x, qq.y, qq.z, qq.w}, ka[4] = {kk.x, kk.y, kk.z, kk.w};
#pragma unroll
            for (int j = 0; j < 4; ++j) {
                const float q0 = bflo(qa[j]), q1 = bfhi(qa[j]), k0 = bflo(ka[j]), k1 = bfhi(ka[j]);
                const int d = 8 * c + 2 * j;
                if (dir == 0) { S[d] = gamma * S[d] + k0 * v; o += q0 * S[d]; S[d + 1] = gamma * S[d + 1] + k1 * v; o += q1 * S[d + 1]; }
                else { const float s0 = gamma * S[d], s1 = gamma * S[d + 1]; o += q0 * s0 + q1 * s1; S[d] = s0 + k0 * v; S[d + 1] = s1 + k1 * v; }
            }
        }
        O[row * 512 + h * 128 + e] = o;
    }
}
__global__ void __launch_bounds__(512) k_ret_norm(Params p) {
    const int gwv = blockIdx.x * 8 + (threadIdx.x >> 6), lane = threadIdx.x & 63;
    const int row = gwv >> 2, h = gwv & 3;
    const float* Of = (const float*)(p.ws + WS_SCR); const float* Ob = Of + (size_t)T * 512;
    const bf16_t* proj = (const bf16_t*)(p.ws + WS_PROJ); bf16_t* mix = (bf16_t*)(p.ws + WS_HB);
    const size_t o = (size_t)row * 512 + h * 128 + 2 * lane;
    const float a0 = Of[o] + Ob[o], a1 = Of[o + 1] + Ob[o + 1];
    const float mean = wave_sum(a0 + a1) * (1.f / 128.f); const float d0 = a0 - mean, d1 = a1 - mean;
    const float rstd = 1.f / sqrtf(wave_sum(d0 * d0 + d1 * d1) * (1.f / 128.f) + LN_EPS);
    const unsigned gg = *(const unsigned*)(proj + (size_t)row * EVEN_IN + 1024 + h * 128 + 2 * lane);
    *(unsigned*)(mix + (size_t)row * D + h * 128 + 2 * lane) = pk2(d0 * rstd * silu(bflo(gg)), d1 * rstd * silu(bfhi(gg)));
}
__global__ void __launch_bounds__(512) k_lru_ab(Params p) {
    __shared__ float xc_s[8][512];
    const int w = threadIdx.x, t0 = blockIdx.x * 8;
    const bf16_t* proj = (const bf16_t*)(p.ws + WS_PROJ);
    float* LA = (float*)(p.ws + WS_SCR); float* BV = LA + (size_t)2 * T * 512;
    for (int tt = 0; tt < 8; ++tt) { const int t = t0 + tt, s = t & (SEQ - 1); float a = p.conv_b[w];
#pragma unroll
        for (int j = 0; j < 4; ++j) { const int ss = s + j - 2; if (ss >= 0 && ss < SEQ) a += p.conv_w[j * 512 + w] * bf2f(proj[(size_t)(t + j - 2) * EVEN_IN + 1536 + w]); }
        xc_s[tt][w] = a; }
    __syncthreads();
    const int n = w >> 7, d = w & 127;
    float g[4][8];
#pragma unroll
    for (int zg = 0; zg < 4; ++zg)
#pragma unroll
        for (int tt = 0; tt < 8; ++tt) g[zg][tt] = 0.f;
    for (int c = 0; c < 128; ++c) {
        float wv[4];
#pragma unroll
        for (int zg = 0; zg < 4; ++zg) wv[zg] = p.gate_w[((size_t)(zg * 4 + n) * 128 + c) * 128 + d];
#pragma unroll
        for (int tt = 0; tt < 8; ++tt) { const float xv = xc_s[tt][n * 128 + c];
#pragma unroll
            for (int zg = 0; zg < 4; ++zg) g[zg][tt] += xv * wv[zg]; }
    }
#pragma unroll
    for (int z = 0; z < 2; ++z) {
        const float sp = log1pf(expf(-p.lam[z * 512 + w]));
        const float br = p.gate_b[((z * 2 + 0) * 4 + n) * 128 + d], bi = p.gate_b[((z * 2 + 1) * 4 + n) * 128 + d];
#pragma unroll
        for (int tt = 0; tt < 8; ++tt) {
            const float r = 1.f / (1.f + expf(-(g[z * 2][tt] + br))), ig = 1.f / (1.f + expf(-(g[z * 2 + 1][tt] + bi)));
            const float la = -8.f * r * sp;
            const size_t idx = ((size_t)z * T + t0 + tt) * 512 + w;
            LA[idx] = la; BV[idx] = sqrtf(-expm1f(2.f * la)) * ig * xc_s[tt][w];
        }
    }
}
__global__ void __launch_bounds__(64) k_lru_scan(Params p) {
    const int gid = blockIdx.x * 64 + threadIdx.x, w = gid & 511, z = (gid >> 9) & 1, b = gid >> 10;
    const float* LA = (const float*)(p.ws + WS_SCR); float* BV = (float*)(p.ws + WS_SCR) + (size_t)2 * T * 512;
    float h = 0.f;
    for (int step = 0; step < SEQ; step += 8) {
        float la[8], bv[8]; size_t idx[8];
#pragma unroll
        for (int i = 0; i < 8; ++i) { const int t = z ? SEQ - 1 - (step + i) : step + i; idx[i] = ((size_t)z * T + (size_t)b * SEQ + t) * 512 + w; la[i] = LA[idx[i]]; bv[i] = BV[idx[i]]; }
#pragma unroll
        for (int i = 0; i < 8; ++i) { h = expf(la[i]) * h + bv[i]; BV[idx[i]] = h; }
    }
}
__global__ void __launch_bounds__(512) k_lru_out(Params p) {
    const int row = blockIdx.x, w = threadIdx.x;
    const float* HS = (const float*)(p.ws + WS_SCR) + (size_t)2 * T * 512;
    const bf16_t* proj = (const bf16_t*)(p.ws + WS_PROJ); bf16_t* mix = (bf16_t*)(p.ws + WS_HB);
    const float hs = HS[(size_t)row * 512 + w] + HS[((size_t)T + row) * 512 + w];
    const float gr = bf2f(proj[(size_t)row * EVEN_IN + 2048 + w]);
    mix[(size_t)row * D + 512 + w] = (bf16_t)f2bf(hs * gelu_tanh(gr));
}
__global__ void __launch_bounds__(128) k_gla_naive(Params p) {
    __shared__ float fs[2][128], qs[2][128];
    const int dir = blockIdx.x & 1, bh = blockIdx.x >> 1, b = bh >> 3, h = bh & 7, e = threadIdx.x;
    bf16_t* proj = (bf16_t*)(p.ws + WS_PROJ);
    float S[128];
#pragma unroll
    for (int d = 0; d < 128; ++d) S[d] = 0.f;
    for (int step = 0; step < SEQ; ++step) {
        const int t = dir ? SEQ - 1 - step : step; bf16_t* pr = proj + ((size_t)b * SEQ + t) * ODD_IN;
        const int buf = step & 1;
        fs[buf][e] = __expf(bf2f(pr[2048 + dir * 1024 + h * 128 + e])); qs[buf][e] = bf2f(pr[h * 128 + e]);
        const float v = bf2f(pr[1024 + h * 128 + e]);
        __syncthreads();
        float o = 0.f;
#pragma unroll
        for (int d = 0; d < 128; ++d) { const float f = fs[buf][d]; S[d] = f * S[d] + (1.f - f) * v; o += qs[buf][d] * S[d]; }
        pr[2048 + dir * 1024 + h * 128 + e] = (bf16_t)f2bf(o);
    }
}
__global__ void __launch_bounds__(512) k_hg_norm(Params p) {
    const int row = blockIdx.x * 8 + (threadIdx.x >> 6), lane = threadIdx.x & 63;
    const bf16_t* pr = (const bf16_t*)(p.ws + WS_PROJ) + (size_t)row * ODD_IN; bf16_t* mix = (bf16_t*)(p.ws + WS_HB) + (size_t)row * D;
    f32x4 o[4]; float ss = 0.f;
#pragma unroll
    for (int j = 0; j < 4; ++j) { const int c = 4 * lane + 256 * j; const u32x2 a = *(const u32x2*)(pr + 2048 + c), bb = *(const u32x2*)(pr + 3072 + c);
        o[j][0] = bflo(a.x) + bflo(bb.x); o[j][1] = bfhi(a.x) + bfhi(bb.x); o[j][2] = bflo(a.y) + bflo(bb.y); o[j][3] = bfhi(a.y) + bfhi(bb.y);
        ss += (o[j][0] * o[j][0] + o[j][1] * o[j][1]) + (o[j][2] * o[j][2] + o[j][3] * o[j][3]); }
    const float rstd = 1.f / sqrtf(wave_sum(ss) * (1.f / D) + RMS_EPS);
#pragma unroll
    for (int j = 0; j < 4; ++j) { const int c = 4 * lane + 256 * j; const f32x4 nw = *(const f32x4*)(p.norm_w + c); const u32x2 gg = *(const u32x2*)(pr + 4096 + c);
        u32x2 w; w.x = pk2(o[j][0] * rstd * nw[0] * silu(bflo(gg.x)), o[j][1] * rstd * nw[1] * silu(bfhi(gg.x)));
        w.y = pk2(o[j][2] * rstd * nw[2] * silu(bflo(gg.y)), o[j][3] * rstd * nw[3] * silu(bfhi(gg.y)));
        *(u32x2*)(mix + c) = w; }
}
__global__ void __launch_bounds__(512) k_ln_router(Params p, int layer) {
    __shared__ int hist[16];
    if (threadIdx.x < 16) hist[threadIdx.x] = 0;
    __syncthreads();
    const int wave = threadIdx.x >> 6, lane = threadIdx.x & 63;
    for (int i = 0; i < 8; ++i) ln_router_row(p, layer, blockIdx.x * 64 + wave * 8 + i, lane, (LAS int*)hist);
    __syncthreads();
    if (threadIdx.x < 16) ((int*)(p.ws + WS_TOK + TOK_BH))[(layer * 256 + blockIdx.x) * 16 + threadIdx.x] = hist[threadIdx.x];
}
__global__ void __launch_bounds__(512) k_slots(Params p, int layer) {
    __shared__ int tot[16], pre[16], base[16], lslot[128], le[128];
    unsigned char* ws = p.ws; int* ctl = (int*)(ws + WS_CTL);
    const int tid = threadIdx.x, t0 = blockIdx.x * 64;
    const int* bh = (const int*)(ws + WS_TOK + TOK_BH) + layer * 256 * 16;
    if (tid < 16) { int a = 0, b = 0; for (int k = 0; k < 256; ++k) { const int v = bh[k * 16 + tid]; a += v; if (k < (int)blockIdx.x) b += v; } tot[tid] = a; pre[tid] = b; }
    const int* te = (const int*)(ws + WS_TOK + TOK_E);
    if (tid < 128) le[tid] = te[2 * t0 + tid];
    __syncthreads();
    if (tid == 0) { int acc = 0; for (int e = 0; e < 16; ++e) { base[e] = acc; acc += (tot[e] + 255) / 256 * 256; }
        if (blockIdx.x == 0) { int k = 0; for (int e = 0; e < 16; ++e) { const int nt = (tot[e] + 255) / 256; for (int i = 0; i < nt; ++i) ctl[CW_TILEE + 256 * layer + k++] = e; } ctl[CW_NTILES + layer] = k; } }
    __syncthreads();
    if (tid < 128) { const int e = le[tid]; int rank = 0; for (int a = 0; a < tid; ++a) rank += (le[a] == e) ? 1 : 0;
        const int s = base[e] + pre[e] + rank; lslot[tid] = s; ((int*)(ws + WS_TOK + TOK_SLOT))[2 * t0 + tid] = s; }
    __syncthreads();
    const int wave = tid >> 6, lane = tid & 63;
    const bf16_t* hb = (const bf16_t*)(ws + WS_HB); bf16_t* xs = (bf16_t*)(ws + WS_XS);
    for (int i = 0; i < 8; ++i) { const int tl = wave * 8 + i; const size_t row = t0 + tl;
        const u32x4 a = *(const u32x4*)(hb + row * D + 8 * lane), b2 = *(const u32x4*)(hb + row * D + 512 + 8 * lane);
#pragma unroll
        for (int k = 0; k < 2; ++k) { bf16_t* dst = xs + (size_t)lslot[2 * tl + k] * D; *(u32x4*)(dst + 8 * lane) = a; *(u32x4*)(dst + 512 + 8 * lane) = b2; } }
}
__global__ void __launch_bounds__(512) k_combine_ln(Params p, int layer) {
    const int wave = threadIdx.x >> 6, lane = threadIdx.x & 63;
    for (int i = 0; i < 8; ++i) combine_ln_row(p, layer, blockIdx.x * 64 + wave * 8 + i, lane);
}

extern "C" void kernel_launch(void* const* d_in, const int* in_sizes, int n_in, void* d_out, int out_size, void* d_ws, size_t ws_size, hipStream_t stream) {
    static int grid = 0;
    if (grid == 0) {
        if (n_in != 18 || in_sizes[0] != T * D || out_size != T * D || ws_size < WS_END) { fprintf(stderr, "kernel_launch: unexpected shapes (n_in %d, in0 %d, out %d, ws %zu)\n", n_in, n_in > 0 ? in_sizes[0] : -1, out_size, ws_size); grid = -1; return; }
        int dev = 0, cus = 0; hipGetDevice(&dev); hipDeviceGetAttribute(&cus, hipDeviceAttributeMultiprocessorCount, dev);
        hipFuncSetAttribute((const void*)k_prologue, hipFuncAttributeMaxDynamicSharedMemorySize, GEMM_LDS);
        hipFuncSetAttribute((const void*)k_prologue_moe, hipFuncAttributeMaxDynamicSharedMemorySize, GEMM_LDS);
        hipFuncSetAttribute((const void*)k_inproj0, hipFuncAttributeMaxDynamicSharedMemorySize, GEMM_LDS);
        hipFuncSetAttribute((const void*)k_inproj1, hipFuncAttributeMaxDynamicSharedMemorySize, GEMM_LDS);
        hipFuncSetAttribute((const void*)k_outproj, hipFuncAttributeMaxDynamicSharedMemorySize, GEMM_LDS);
        hipFuncSetAttribute((const void*)k_moe_gateup, hipFuncAttributeMaxDynamicSharedMemorySize, GEMM_LDS);
        hipFuncSetAttribute((const void*)k_moe_down, hipFuncAttributeMaxDynamicSharedMemorySize, GEMM_LDS);
        (void)hipGetLastError();
        grid = cus > 0 ? cus : 256;
    }
    if (grid < 0) return;
    Params p{};
    p.x = (const float*)d_in[0]; p.w_in_even = (const float*)d_in[1]; p.w_out_even = (const float*)d_in[2]; p.conv_w = (const float*)d_in[3]; p.conv_b = (const float*)d_in[4];
    p.gate_w = (const float*)d_in[5]; p.gate_b = (const float*)d_in[6]; p.lam = (const float*)d_in[7]; p.w_in_odd = (const float*)d_in[8]; p.w_out_odd = (const float*)d_in[9];
    p.lower_bounds = (const float*)d_in[10]; p.norm_w = (const float*)d_in[11]; p.ln_w = (const float*)d_in[12]; p.ln_b = (const float*)d_in[13]; p.router_w = (const float*)d_in[14];
    p.moe_gate = (const float*)d_in[15]; p.moe_up = (const float*)d_in[16]; p.moe_down = (const float*)d_in[17];
    p.out = (float*)d_out; p.ws = (unsigned char*)d_ws;
    hipMemsetAsync((char*)d_ws + WS_CTL, 0, CTL_BYTES, stream);
    const dim3 G(grid), B512(512);
    k_prologue<<<G, B512, GEMM_LDS, stream>>>(p);
    k_inproj0<<<G, B512, GEMM_LDS, stream>>>(p);
    k_ret_naive<<<16, 128, 0, stream>>>(p);
    k_ret_norm<<<T * 4 / 8, 512, 0, stream>>>(p);
    k_lru_ab<<<T / 8, 512, 0, stream>>>(p);
    k_lru_scan<<<32, 64, 0, stream>>>(p);
    k_lru_out<<<T, 512, 0, stream>>>(p);
    k_outproj<<<G, B512, GEMM_LDS, stream>>>(p, 0);
    for (int layer = 0; layer < 2; ++layer) {
        if (layer == 1) {
            k_inproj1<<<G, B512, GEMM_LDS, stream>>>(p);
            k_gla_naive<<<32, 128, 0, stream>>>(p);
            k_hg_norm<<<T / 8, 512, 0, stream>>>(p);
            k_outproj<<<G, B512, GEMM_LDS, stream>>>(p, 1);
        }
        k_prologue_moe<<<G, B512, GEMM_LDS, stream>>>(p, layer);
        k_ln_router<<<T / 64, 512, 0, stream>>>(p, layer);
        k_slots<<<T / 64, 512, 0, stream>>>(p, layer);
        k_moe_gateup<<<G, B512, GEMM_LDS, stream>>>(p, layer);
        k_moe_down<<<G, B512, GEMM_LDS, stream>>>(p, layer);
        k_combine_ln<<<T / 64, 512, 0, stream>>>(p, layer);
    }
}
```

```cpp
#include <hip/hip_runtime.h>
#include <cstdio>
#include <cstdint>

namespace pg8 {
#define PG8_LAS __attribute__((address_space(3)))
typedef unsigned short bf16_t;
typedef short bf16x8 __attribute__((ext_vector_type(8)));
typedef float f32x4 __attribute__((ext_vector_type(4)));
typedef unsigned u32x4 __attribute__((ext_vector_type(4)));
constexpr int BM = 256, BK = 64, HALF = 128, HTB = HALF * BK * 2  , STAGE_BYTES = 8 * HTB, NXCD = 8, WGM = 8;

__host__ __device__ __forceinline__ int lds_byte(int r, int c) { const int st = (r >> 4) * 2 + (c >> 5), rr = r & 15, cc = c & 31, ob = rr * 64 + cc * 2; return st * 1024 + (ob ^ (((ob >> 9) & 1) << 5)); }
__host__ __device__ __forceinline__ void stage_rc(int b, int& R, int& C) { const int st = b / 1024, sb = b % 1024, swz = sb ^ (((sb >> 9) & 1) << 5); R = (st >> 1) * 16 + swz / 64; C = (st & 1) * 32 + (swz % 64) / 2; }
__host__ __device__ __forceinline__ int perm32(int rho) { const int n = rho >> 4, i = rho & 15; return 8 * (i >> 2) + 4 * n + (i & 3); }

struct Unit { int pm, pn, brow; };
struct Gemm { const bf16_t* A; const bf16_t* Bt; int M, N, K; };

struct StaticOrder {
    int nM, nN, nwg, G, c;
    __host__ __device__ void init(int M, int N, int K, int G_, int c_) { nM = M / BM; nN = N / BM; nwg = nM * nN; G = G_; c = c_; }
    __host__ __device__ bool next(int i, Unit& u) const {
        const long L = (long)i * G + c; if (L >= nwg) return false;
        int wgid = (int)L; { const int q = nwg / NXCD, r = nwg % NXCD, xcd = wgid % NXCD, off = wgid / NXCD; wgid = (xcd < r ? xcd * (q + 1) : r * (q + 1) + (xcd - r) * q) + off; }
        const int nig = WGM * nN, gid = wgid / nig, fm = gid * WGM, gsz = (nM - fm) < WGM ? (nM - fm) : WGM;
        u.pm = fm + ((wgid % nig) % gsz); u.pn = (wgid % nig) / gsz; u.brow = u.pn; return true;
    }
    __device__ __forceinline__ void a_ready(const Unit&) const {}
    __device__ __forceinline__ void done(const Unit&) const {}
};
struct GroupedOrder {
    const int* tile_e; int ntiles, nN, G, c;
    __device__ bool next(int i, Unit& u) const {
        const int L = i * G + c; if (L >= ntiles * nN) return false;
        u.pm = L / nN; u.pn = L % nN;
        u.brow = __builtin_amdgcn_readfirstlane(tile_e[u.pm]) * nN + u.pn; return true;
    }
    __device__ __forceinline__ void a_ready(const Unit&) const {}
    __device__ __forceinline__ void done(const Unit&) const {}
};

__device__ __forceinline__ unsigned cvt_pk_bf16(float lo, float hi) { unsigned r; asm volatile("v_cvt_pk_bf16_f32 %0, %1, %2" : "=v"(r) : "v"(lo), "v"(hi)); return r; }

template <class Epi, class Sched, bool ALIGN_EPI = false, bool SP2 = false>
__device__ __forceinline__ void gemm_phase(PG8_LAS unsigned char* lds, const Gemm g, const Sched& S, const Epi& E) {
    int tid_ = threadIdx.x; asm volatile("" : "+v"(tid_));
    const int tid = tid_, wid = __builtin_amdgcn_readfirstlane(tid >> 6), lane = tid & 63, wr = wid >> 2, wc = wid & 3, fr = lane & 15, fq = lane >> 4;
    const int K = g.K, nt = K / BK;
    unsigned voffA[2], voffB[2];
#pragma unroll
    for (int i = 0; i < 2; ++i) { int R, C; stage_rc(tid * 16 + i * 8192, R, C); const int Rb = Epi::PERM ? ((R & ~31) + perm32(R & 31)) : R;
        voffA[i] = (unsigned)(R * K + C) * 2u; voffB[i] = (unsigned)(Rb * K + C) * 2u; }
    const size_t kstep = (size_t)(BK * 2);
    const size_t hstep = (size_t)HALF * K * 2;
    const unsigned ldsw = (unsigned)wid * 1024u;
    const int aoff = lds_byte(wr * 64 + fr, fq * 8), boff = lds_byte(wc * 32 + fr, fq * 8);
#define PG8_SA(b, h) (((b) * 2 + (h)) * HTB)
#define PG8_SB(b, h) ((4 + (b) * 2 + (h)) * HTB)
#define PG8_STAGE(bufoff, gbase, voff) do { _Pragma("unroll") for (int _i = 0; _i < 2; ++_i) \
        __builtin_amdgcn_global_load_lds((const unsigned*)((const char*)(gbase) + (voff)[_i]), (PG8_LAS unsigned*)(lds + (bufoff) + ldsw + _i * 8192), 16, 0, 0); } while (0)
#define PG8_LDA(dst, b, h) do { _Pragma("unroll") for (int m = 0; m < 4; ++m) _Pragma("unroll") for (int k = 0; k < 2; ++k) dst[m][k] = *(const PG8_LAS bf16x8*)(lds + PG8_SA(b, h) + aoff + m * 2048 + k * 1024); } while (0)
#define PG8_LDB(dst, b, h) do { _Pragma("unroll") for (int n = 0; n < 2; ++n) _Pragma("unroll") for (int k = 0; k < 2; ++k) dst[n][k] = *(const PG8_LAS bf16x8*)(lds + PG8_SB(b, h) + boff + n * 2048 + k * 1024); } while (0)
#define PG8_MMA(ai, bj, At, Bt) do { __builtin_amdgcn_s_setprio(1); _Pragma("unroll") for (int m = 0; m < 4; ++m) _Pragma("unroll") for (int n = 0; n < 2; ++n) _Pragma("unroll") for (int k = 0; k < 2; ++k) \
        acc[ai][bj][m][n] = __builtin_amdgcn_mfma_f32_16x16x32_bf16(Bt[n][k], At[m][k], acc[ai][bj][m][n], 0, 0, 0); __builtin_amdgcn_s_setprio(0); } while (0)
#define PG8_WAIT_V(n) asm volatile("s_waitcnt vmcnt(" #n ")" ::: "memory")
#define PG8_WAIT_L(n) asm volatile("s_waitcnt lgkmcnt(" #n ")" ::: "memory")
#define PG8_BAR __builtin_amdgcn_s_barrier()
#define PG8_SCHED __builtin_amdgcn_sched_barrier(0)
    Unit cur, nxt; int ui = 0;
    if (!S.next(0, cur)) return;
    f32x4 acc[2][2][4][2];
#pragma unroll
    for (int a = 0; a < 2; ++a)
#pragma unroll
        for (int b = 0; b < 2; ++b)
#pragma unroll
            for (int m = 0; m < 4; ++m)
#pragma unroll
                for (int n = 0; n < 2; ++n) acc[a][b][m][n] = (f32x4){0.f, 0.f, 0.f, 0.f};
    bf16x8 At[4][2], B0[2][2], B1[2][2];
    const size_t tstep = 2 * hstep;
    const char* cA = (const char*)g.A + (size_t)cur.pm * tstep; const char* cB = (const char*)g.Bt + (size_t)cur.brow * tstep;
    S.a_ready(cur);
    if constexpr (SP2) {
        PG8_STAGE(PG8_SB(0, 0), cB, voffB); PG8_STAGE(PG8_SB(0, 1), cB + hstep, voffB); PG8_STAGE(PG8_SA(0, 0), cA, voffA); PG8_STAGE(PG8_SA(0, 1), cA + hstep, voffA);
        if (wr == 1) PG8_BAR;
        PG8_WAIT_V(2); PG8_BAR;
        PG8_STAGE(PG8_SB(1, 0), cB + kstep, voffB); PG8_STAGE(PG8_SA(1, 0), cA + kstep, voffA); PG8_STAGE(PG8_SB(1, 1), cB + hstep + kstep, voffB);
        PG8_WAIT_V(6); PG8_BAR;
    } else {
        PG8_STAGE(PG8_SB(0, 0), cB, voffB); PG8_STAGE(PG8_SA(0, 0), cA, voffA); PG8_STAGE(PG8_SB(0, 1), cB + hstep, voffB); PG8_STAGE(PG8_SA(0, 1), cA + hstep, voffA);
        if (wr == 1) PG8_BAR;
        PG8_WAIT_V(4); PG8_BAR;
        PG8_STAGE(PG8_SB(1, 0), cB + kstep, voffB); PG8_STAGE(PG8_SA(1, 0), cA + kstep, voffA); PG8_STAGE(PG8_SB(1, 1), cB + hstep + kstep, voffB);
        PG8_WAIT_V(6); PG8_BAR;
    }
    for (;;) {
        const bool has_next = S.next(ui + 1, nxt);
        const char* nA = has_next ? (const char*)g.A + (size_t)nxt.pm * tstep : cA; const char* nB = has_next ? (const char*)g.Bt + (size_t)nxt.brow * tstep : cB;
        for (int t = 0; t < nt; t += 2) {
            const bool last = (t == nt - 2);
            const char* a1 = cA + (size_t)(t + 1) * kstep;
            const char* a2 = last ? nA : cA + (size_t)(t + 2) * kstep; const char* b2 = last ? nB : cB + (size_t)(t + 2) * kstep;
            const char* a3 = a2 + kstep; const char* b3 = b2 + kstep;
            if (last && has_next) S.a_ready(nxt);
            if constexpr (SP2) {
            PG8_LDB(B0, 0, 0); PG8_LDB(B1, 0, 1); PG8_SCHED; PG8_LDA(At, 0, 0); PG8_STAGE(PG8_SA(1, 1), a1 + hstep, voffA);
            PG8_WAIT_V(8); PG8_WAIT_L(0); PG8_BAR; PG8_MMA(0, 0, At, B0); PG8_MMA(0, 1, At, B1); PG8_BAR; PG8_SCHED;
            PG8_LDA(At, 0, 1); PG8_STAGE(PG8_SB(0, 0), b2, voffB); PG8_STAGE(PG8_SB(0, 1), b2 + hstep, voffB); PG8_STAGE(PG8_SA(0, 0), a2, voffA);
            PG8_WAIT_V(8); PG8_WAIT_L(0); PG8_BAR; PG8_MMA(1, 0, At, B0); PG8_MMA(1, 1, At, B1); PG8_BAR; PG8_SCHED;
            PG8_LDB(B0, 1, 0); PG8_LDB(B1, 1, 1); PG8_SCHED; PG8_LDA(At, 1, 0); PG8_STAGE(PG8_SA(0, 1), a2 + hstep, voffA);
            PG8_WAIT_V(8); PG8_WAIT_L(0); PG8_BAR; PG8_MMA(0, 0, At, B0); PG8_MMA(0, 1, At, B1); PG8_BAR; PG8_SCHED;
            PG8_LDA(At, 1, 1); PG8_STAGE(PG8_SB(1, 0), b3, voffB); PG8_STAGE(PG8_SB(1, 1), b3 + hstep, voffB); PG8_STAGE(PG8_SA(1, 0), a3, voffA);
            PG8_WAIT_V(8); PG8_WAIT_L(0); PG8_BAR; PG8_MMA(1, 0, At, B0); PG8_MMA(1, 1, At, B1); PG8_BAR; PG8_SCHED;
            } else {
            PG8_LDB(B0, 0, 0); PG8_SCHED; PG8_LDA(At, 0, 0); PG8_STAGE(PG8_SA(1, 1), a1 + hstep, voffA);
            PG8_WAIT_L(8); PG8_BAR; PG8_WAIT_L(0); PG8_MMA(0, 0, At, B0); PG8_BAR; PG8_SCHED;
            PG8_LDB(B1, 0, 1); PG8_STAGE(PG8_SB(0, 0), b2, voffB);
            PG8_BAR; PG8_WAIT_L(0); PG8_MMA(0, 1, At, B1); PG8_BAR;
            PG8_LDA(At, 0, 1); PG8_STAGE(PG8_SA(0, 0), a2, voffA);
            PG8_BAR; PG8_WAIT_L(0); PG8_MMA(1, 0, At, B0); PG8_BAR; PG8_SCHED;
            PG8_STAGE(PG8_SB(0, 1), b2 + hstep, voffB);
            PG8_WAIT_V(6); PG8_BAR; PG8_MMA(1, 1, At, B1); PG8_BAR;
            PG8_LDB(B0, 1, 0); PG8_SCHED; PG8_LDA(At, 1, 0); PG8_STAGE(PG8_SA(0, 1), a2 + hstep, voffA);
            PG8_WAIT_L(8); PG8_BAR; PG8_WAIT_L(0); PG8_MMA(0, 0, At, B0); PG8_BAR; PG8_SCHED;
            PG8_LDB(B1, 1, 1); PG8_STAGE(PG8_SB(1, 0), b3, voffB);
            PG8_BAR; PG8_WAIT_L(0); PG8_MMA(0, 1, At, B1); PG8_BAR;
            PG8_LDA(At, 1, 1); PG8_STAGE(PG8_SA(1, 0), a3, voffA);
            PG8_BAR; PG8_WAIT_L(0); PG8_MMA(1, 0, At, B0); PG8_BAR; PG8_SCHED;
            PG8_STAGE(PG8_SB(1, 1), b3 + hstep, voffB);
            PG8_WAIT_V(6); PG8_BAR; PG8_MMA(1, 1, At, B1); PG8_BAR;
            }
        }
        if constexpr (ALIGN_EPI) { if (wr == 0) PG8_BAR; }
        if constexpr (!Epi::AFTER_DRAIN) { E(acc, cur, wr, wc, fr, fq); S.done(cur); }
        if (!has_next) break;
#pragma unroll
        for (int a = 0; a < 2; ++a)
#pragma unroll
            for (int b = 0; b < 2; ++b)
#pragma unroll
                for (int m = 0; m < 4; ++m)
#pragma unroll
                    for (int n = 0; n < 2; ++n) acc[a][b][m][n] = (f32x4){0.f, 0.f, 0.f, 0.f};
        cur = nxt; cA = nA; cB = nB; ++ui;
        if constexpr (ALIGN_EPI) { if (wr == 1) PG8_BAR; }
    }
    PG8_WAIT_V(0);
    if constexpr (!ALIGN_EPI) { if (wr == 0) PG8_BAR; }
    PG8_BAR;
    if constexpr (Epi::AFTER_DRAIN) { E.fused(acc, cur, wr, wc, fr, fq, lds, wid, lane); S.done(cur); }
#undef PG8_SA
#undef PG8_SB
#undef PG8_STAGE
#undef PG8_LDA
#undef PG8_LDB
#undef PG8_MMA
#undef PG8_WAIT_V
#undef PG8_WAIT_L
#undef PG8_BAR
#undef PG8_SCHED
}
}

using pg8::bf16_t; using pg8::bf16x8; using pg8::f32x4; using pg8::u32x4; using pg8::Unit;
typedef float f32x2 __attribute__((ext_vector_type(2)));
typedef unsigned u32x2 __attribute__((ext_vector_type(2)));
#define LAS __attribute__((address_space(3)))

constexpr int NB = 2, SEQ = 8192, T = NB * SEQ, D = 1024;
constexpr int EVEN_IN = 2560, ODD_IN = 5120;
constexpr int NEXP = 16, DEXP = 512;
constexpr int PMAX = 36864;
constexpr int MAXTILES = PMAX / 256;
constexpr float DN_ALPHA = 1.41421356237f;
constexpr float LN_EPS = 1e-5f, RMS_EPS = 1e-6f;

constexpr size_t MiB = 1u << 20;
constexpr size_t WS_CTL = 0, CTL_BYTES = 1 * MiB;
constexpr size_t WS_ROPE = 1 * MiB;
constexpr size_t WS_LBV = 3 * MiB;
constexpr size_t WS_WINE = 4 * MiB;
constexpr size_t WS_WOUTE = 9 * MiB;
constexpr size_t WS_WINO = 11 * MiB;
constexpr size_t WS_WOUTO = 21 * MiB;
constexpr size_t WS_LGT = 23 * MiB;
constexpr size_t WS_HB = 24 * MiB;
constexpr size_t WS_PROJ = 56 * MiB;
constexpr size_t WS_XS = WS_PROJ;
constexpr size_t WS_HID = WS_PROJ + 72 * MiB;
constexpr size_t WS_SCR = WS_PROJ + 80 * MiB;
constexpr size_t WS_WGU = 216 * MiB;
constexpr size_t WS_WD = 248 * MiB;
constexpr size_t WS_TOK = 264 * MiB;
constexpr size_t WS_END = 266 * MiB;
constexpr int CW_COUNTS = 1024;
constexpr int CW_CURSOR = 1024 + 64;
constexpr int CW_NTILES = 1024 + 128;
constexpr int CW_TILEE = 2048;
constexpr size_t TOK_E = 0, TOK_G = 128 * 1024, TOK_SLOT = 256 * 1024, TOK_BH = 384 * 1024;

struct Params {
    const float* x; const float* w_in_even; const float* w_out_even; const float* conv_w; const float* conv_b; const float* gate_w; const float* gate_b; const float* lam;
    const float* w_in_odd; const float* w_out_odd; const float* lower_bounds; const float* norm_w; const float* ln_w; const float* ln_b; const float* router_w;
    const float* moe_gate; const float* moe_up; const float* moe_down;
    float* out; unsigned char* ws;
};

__device__ __forceinline__ float bf2f(unsigned b) { return __uint_as_float(b << 16); }
__device__ __forceinline__ float bflo(unsigned u) { return __uint_as_float(u << 16); }
__device__ __forceinline__ float bfhi(unsigned u) { return __uint_as_float(u & 0xffff0000u); }
__device__ __forceinline__ unsigned f2bf(float f) { unsigned u = __float_as_uint(f); return (u + 0x7fffu + ((u >> 16) & 1u)) >> 16; }
__device__ __forceinline__ unsigned pk2(float lo, float hi) { return f2bf(lo) | (f2bf(hi) << 16); }
__device__ __forceinline__ float sigm(float x) { return 1.f / (1.f + __expf(-x)); }
__device__ __forceinline__ float silu(float x) { return x / (1.f + __expf(-x)); }
__device__ __forceinline__ float gelu_tanh(float x) { const float u = 0.7978845608028654f * (x + 0.044715f * x * x * x); return x / (1.f + __expf(-2.f * u)); }
__device__ __forceinline__ float wave_sum(float v) {
#pragma unroll
    for (int o = 1; o < 64; o <<= 1) v += __shfl_xor(v, o);
    return v;
}
#define LDS_WAIT() asm volatile("s_waitcnt lgkmcnt(0)" ::: "memory")

__device__ __forceinline__ void store8bf(bf16_t* p, const f32x4& v0, const f32x4& v1) {
    u32x4 w; w.x = pg8::cvt_pk_bf16(v0[0], v0[1]); w.y = pg8::cvt_pk_bf16(v0[2], v0[3]); w.z = pg8::cvt_pk_bf16(v1[0], v1[1]); w.w = pg8::cvt_pk_bf16(v1[2], v1[3]);
    *(u32x4*)p = w;
}
struct EpiInproj0 {
    static constexpr bool PERM = true, AFTER_DRAIN = false;
    bf16_t* O; const float* rope;
    __device__ __forceinline__ void operator()(const f32x4 (&acc)[2][2][4][2], const Unit& u, int wr, int wc, int fr, int fq) const {
        const int row0 = u.pm * 256 + wr * 64 + fr, colt = u.pn * 256 + wc * 32 + 8 * fq;
#pragma unroll
        for (int ai = 0; ai < 2; ++ai)
#pragma unroll
            for (int m = 0; m < 4; ++m) {
                const int row = row0 + ai * 128 + m * 16; const int pos = row & (SEQ - 1);
#pragma unroll
                for (int bj = 0; bj < 2; ++bj) {
                    const int col = colt + bj * 128;
                    f32x4 v0 = acc[ai][bj][m][0], v1 = acc[ai][bj][m][1];
                    if (u.pn < 2) {
                        const float sc = (col < 256) ? 0.125f : 1.0f;
                        const f32x4* rp = (const f32x4*)(rope + ((size_t)pos * 32 + ((col & 63) >> 1)) * 2);
                        const f32x4 c0 = rp[0], c1 = rp[1];
                        f32x4 r0, r1;
                        r0[0] = (v0[0] * c0[0] - v0[1] * c0[1]) * sc; r0[1] = (v0[0] * c0[1] + v0[1] * c0[0]) * sc;
                        r0[2] = (v0[2] * c0[2] - v0[3] * c0[3]) * sc; r0[3] = (v0[2] * c0[3] + v0[3] * c0[2]) * sc;
                        r1[0] = (v1[0] * c1[0] - v1[1] * c1[1]) * sc; r1[1] = (v1[0] * c1[1] + v1[1] * c1[0]) * sc;
                        r1[2] = (v1[2] * c1[2] - v1[3] * c1[3]) * sc; r1[3] = (v1[2] * c1[3] + v1[3] * c1[2]) * sc;
                        v0 = r0; v1 = r1;
                    }
                    store8bf(O + (size_t)row * EVEN_IN + col, v0, v1);
                }
            }
    }
};
struct EpiInproj1 {
    static constexpr bool PERM = true, AFTER_DRAIN = false;
    bf16_t* O; const float* lbv;
    __device__ __forceinline__ void operator()(const f32x4 (&acc)[2][2][4][2], const Unit& u, int wr, int wc, int fr, int fq) const {
        const int row0 = u.pm * 256 + wr * 64 + fr, colt = u.pn * 256 + wc * 32 + 8 * fq;
        const int seg = u.pn >> 2;
#pragma unroll
        for (int bj = 0; bj < 2; ++bj) {
            const int col = colt + bj * 128;
            f32x4 lb0 = {0.f, 0.f, 0.f, 0.f}, lb1 = {0.f, 0.f, 0.f, 0.f};
            if (seg == 2 || seg == 3) { lb0 = *(const f32x4*)(lbv + (col & 1023)); lb1 = *(const f32x4*)(lbv + (col & 1023) + 4); }
#pragma unroll
            for (int ai = 0; ai < 2; ++ai)
#pragma unroll
                for (int m = 0; m < 4; ++m) {
                    const int row = row0 + ai * 128 + m * 16;
                    f32x4 v0 = acc[ai][bj][m][0], v1 = acc[ai][bj][m][1];
                    if (seg == 0) {
#pragma unroll
                        for (int j = 0; j < 4; ++j) { v0[j] = silu(v0[j]) * 0.08838834764831845f; v1[j] = silu(v1[j]) * 0.08838834764831845f; }
                    } else if (seg == 2 || seg == 3) {
#pragma unroll
                        for (int j = 0; j < 4; ++j) { v0[j] = __logf(lb0[j] + (1.f - lb0[j]) * sigm(v0[j])); v1[j] = __logf(lb1[j] + (1.f - lb1[j]) * sigm(v1[j])); }
                    }
                    store8bf(O + (size_t)row * ODD_IN + col, v0, v1);
                }
        }
    }
};
struct EpiResid {
    static constexpr bool PERM = false, AFTER_DRAIN = false;
    const float* res; float* out;
    __device__ __forceinline__ void operator()(const f32x4 (&acc)[2][2][4][2], const Unit& u, int wr, int wc, int fr, int fq) const {
        const int row0 = u.pm * 256 + wr * 64 + fr, col0 = u.pn * 256 + wc * 32 + 4 * fq;
#pragma unroll
        for (int ai = 0; ai < 2; ++ai)
#pragma unroll
            for (int m = 0; m < 4; ++m) {
                const size_t off = (size_t)(row0 + ai * 128 + m * 16) * D + col0;
#pragma unroll
                for (int bj = 0; bj < 2; ++bj)
#pragma unroll
                    for (int n = 0; n < 2; ++n) { const f32x4 r = *(const f32x4*)(res + off + bj * 128 + n * 16); *(f32x4*)(out + off + bj * 128 + n * 16) = r * DN_ALPHA + acc[ai][bj][m][n]; }
            }
    }
};
struct EpiGateUp {
    static constexpr bool PERM = true, AFTER_DRAIN = false;
    bf16_t* O;
    __device__ __forceinline__ void operator()(const f32x4 (&acc)[2][2][4][2], const Unit& u, int wr, int wc, int fr, int fq) const {
        const int row0 = u.pm * 256 + wr * 64 + fr, col = u.pn * 128 + wc * 32 + 8 * fq;
#pragma unroll
        for (int ai = 0; ai < 2; ++ai)
#pragma unroll
            for (int m = 0; m < 4; ++m) {
                const int row = row0 + ai * 128 + m * 16;
                f32x4 v0, v1;
#pragma unroll
                for (int j = 0; j < 4; ++j) { v0[j] = silu(acc[ai][0][m][0][j]) * acc[ai][1][m][0][j]; v1[j] = silu(acc[ai][0][m][1][j]) * acc[ai][1][m][1][j]; }
                store8bf(O + (size_t)row * DEXP + col, v0, v1);
            }
    }
};
struct EpiBf16 {
    static constexpr bool PERM = true, AFTER_DRAIN = false;
    bf16_t* O; int ldc;
    __device__ __forceinline__ void operator()(const f32x4 (&acc)[2][2][4][2], const Unit& u, int wr, int wc, int fr, int fq) const {
        const int row0 = u.pm * 256 + wr * 64 + fr, colt = u.pn * 256 + wc * 32 + 8 * fq;
#pragma unroll
        for (int ai = 0; ai < 2; ++ai)
#pragma unroll
            for (int m = 0; m < 4; ++m) {
                const int row = row0 + ai * 128 + m * 16;
#pragma unroll
                for (int bj = 0; bj < 2; ++bj) store8bf(O + (size_t)row * ldc + colt + bj * 128, acc[ai][bj][m][0], acc[ai][bj][m][1]);
            }
    }
};

__device__ __forceinline__ void transpose_item(const float* W, int N, bf16_t* WT, int K, int k0, int n0, int drow0, LAS float* scr, int lane) {
#pragma unroll 8
    for (int i = 0; i < 32; ++i) { const int kk = 2 * i + (lane >> 5); scr[kk * 33 + (lane & 31)] = W[(size_t)(k0 + kk) * N + n0 + (lane & 31)]; }
    LDS_WAIT();
    const int c = lane & 7;
#pragma unroll
    for (int j = 0; j < 4; ++j) { const int n = (lane >> 3) + 8 * j; const LAS float* s = scr + (8 * c) * 33 + n;
        u32x4 o; o.x = pk2(s[0 * 33], s[1 * 33]); o.y = pk2(s[2 * 33], s[3 * 33]); o.z = pk2(s[4 * 33], s[5 * 33]); o.w = pk2(s[6 * 33], s[7 * 33]);
        *(u32x4*)(WT + (size_t)(drow0 + n) * K + k0 + 8 * c) = o; }
    LDS_WAIT();
}
__device__ __forceinline__ void transpose_dense(const float* W, int K, int N, bf16_t* WT, int item, LAS float* scr, int lane) {
    const int nblk = N / 32, kb = item / nblk, nb = item % nblk;
    transpose_item(W, N, WT, K, 64 * kb, 32 * nb, 32 * nb, scr, lane);
}
__device__ __forceinline__ void prologue_static(const Params& p, LAS float* scr, int gw, int ngw, int lane) {
    unsigned char* ws = p.ws;
    constexpr int I_WINE = 16 * 80, I_WOUTE = 16 * 32, I_WINO = 16 * 160, I_WOUTO = 16 * 32, I_LG = 16 * 8;
    constexpr int NITEMS = I_WINE + I_WOUTE + I_WINO + I_WOUTO + I_LG;
    for (int it = gw; it < NITEMS; it += ngw) {
        int r = it;
        if (r < I_WINE) { transpose_dense(p.w_in_even, 1024, EVEN_IN, (bf16_t*)(ws + WS_WINE), r, scr, lane); continue; } r -= I_WINE;
        if (r < I_WOUTE) { transpose_dense(p.w_out_even, 1024, 1024, (bf16_t*)(ws + WS_WOUTE), r, scr, lane); continue; } r -= I_WOUTE;
        if (r < I_WINO) { transpose_dense(p.w_in_odd, 1024, ODD_IN, (bf16_t*)(ws + WS_WINO), r, scr, lane); continue; } r -= I_WINO;
        if (r < I_WOUTO) { transpose_dense(p.w_out_odd, 1024, 1024, (bf16_t*)(ws + WS_WOUTO), r, scr, lane); continue; } r -= I_WOUTO;
        { const int mat = r >> 3, sub = r & 7;
          transpose_dense(p.gate_w + (size_t)mat * 128 * 128, 128, 128, (bf16_t*)(ws + WS_LGT) + (size_t)mat * 128 * 128, sub, scr, lane); }
    }
    { const size_t n8 = (size_t)T * D / 8; bf16_t* xb = (bf16_t*)(ws + WS_HB);
      for (size_t i = (size_t)gw * 64 + lane; i < n8; i += (size_t)ngw * 64) {
          const f32x4 a = *(const f32x4*)(p.x + i * 8), b = *(const f32x4*)(p.x + i * 8 + 4);
          u32x4 o; o.x = pk2(a[0], a[1]); o.y = pk2(a[2], a[3]); o.z = pk2(b[0], b[1]); o.w = pk2(b[2], b[3]);
          *(u32x4*)(xb + i * 8) = o; } }
    { float* rope = (float*)(ws + WS_ROPE);
      for (int i = gw * 64 + lane; i < SEQ * 32; i += ngw * 64) {
          const int pos = i >> 5, fi = i & 31;
          double inv = 0.15915494309189535;
          if (fi & 1) inv *= 0.7498942093324559; if (fi & 2) inv *= 0.5623413251903491; if (fi & 4) inv *= 0.31622776601683794; if (fi & 8) inv *= 0.1; if (fi & 16) inv *= 0.01;
          const double rev = (double)pos * inv; const float fr = (float)(rev - floor(rev));
          rope[2 * i] = __builtin_amdgcn_cosf(fr); rope[2 * i + 1] = __builtin_amdgcn_sinf(fr); }
      float* lbv = (float*)(ws + WS_LBV);
      for (int i = gw * 64 + lane; i < 1024; i += ngw * 64) { const float l0 = p.lower_bounds[i], l1 = p.lower_bounds[1024 + i]; lbv[i] = 1.f / (1.f + __expf(l0 - l1)); } }
}
__device__ __forceinline__ void prologue_moe(const Params& p, int layer, LAS float* scr, int gw, int ngw, int lane) {
    unsigned char* ws = p.ws;
    constexpr int I_GU = 16 * 16, I_D = 8 * 32;
    constexpr int NITEMS = NEXP * (2 * I_GU + I_D);
    for (int it = gw; it < NITEMS; it += ngw) {
        const int e = it / (2 * I_GU + I_D); int r = it % (2 * I_GU + I_D);
        if (r < 2 * I_GU) { const int sel = r / I_GU; r %= I_GU; const int kb = r / 16, nb = r % 16, n0 = 32 * nb;
            const float* W = (sel ? p.moe_up : p.moe_gate) + ((size_t)layer * NEXP + e) * 1024 * 512;
            transpose_item(W, 512, (bf16_t*)(ws + WS_WGU) + (size_t)e * 1024 * 1024, 1024, 64 * kb, n0, 256 * (n0 >> 7) + 128 * sel + (n0 & 127), scr, lane);
        } else { r -= 2 * I_GU;
            const float* W = p.moe_down + ((size_t)layer * NEXP + e) * 512 * 1024;
            transpose_dense(W, 512, 1024, (bf16_t*)(ws + WS_WD) + (size_t)e * 1024 * 512, r, scr, lane); }
    }
}

__device__ __forceinline__ void ln_rows_store(const f32x4 (&v)[4], const float* lw, const float* lb, float* orow, bf16_t* brow, int lane, f32x4 (&h)[4]) {
    float s = 0.f;
#pragma unroll
    for (int j = 0; j < 4; ++j) s += (v[j][0] + v[j][1]) + (v[j][2] + v[j][3]);
    const float mean = wave_sum(s) * (1.f / D); float s2 = 0.f;
#pragma unroll
    for (int j = 0; j < 4; ++j) { const f32x4 d = v[j] - mean; s2 += (d[0] * d[0] + d[1] * d[1]) + (d[2] * d[2] + d[3] * d[3]); }
    const float rstd = 1.f / sqrtf(wave_sum(s2) * (1.f / D) + LN_EPS);
#pragma unroll
    for (int j = 0; j < 4; ++j) { const int c = 4 * lane + 256 * j; const f32x4 w = *(const f32x4*)(lw + c), b = *(const f32x4*)(lb + c);
        h[j] = (v[j] - mean) * rstd * w + b;
        *(f32x4*)(orow + c) = h[j];
        u32x2 o; o.x = pk2(h[j][0], h[j][1]); o.y = pk2(h[j][2], h[j][3]); *(u32x2*)(brow + c) = o; }
}
__device__ __forceinline__ void ln_router_row(const Params& p, int layer, int row, int lane, LAS int* hist) {
    unsigned char* ws = p.ws; float* res = p.out + (size_t)row * D; bf16_t* hb = (bf16_t*)(ws + WS_HB) + (size_t)row * D;
    f32x4 v[4], h[4];
#pragma unroll
    for (int j = 0; j < 4; ++j) v[j] = *(const f32x4*)(res + 4 * lane + 256 * j);
    ln_rows_store(v, p.ln_w + (size_t)(layer * 2 + 0) * D, p.ln_b + (size_t)(layer * 2 + 0) * D, res, hb, lane, h);
    float lg[16];
#pragma unroll
    for (int e = 0; e < 16; ++e) lg[e] = 0.f;
#pragma unroll
    for (int j = 0; j < 4; ++j)
#pragma unroll
        for (int i = 0; i < 4; ++i) { const float* rw = p.router_w + (size_t)(4 * lane + 256 * j + i) * 16; const float hv = h[j][i];
#pragma unroll
            for (int q = 0; q < 4; ++q) { const f32x4 w = *(const f32x4*)(rw + 4 * q); lg[4 * q] += hv * w[0]; lg[4 * q + 1] += hv * w[1]; lg[4 * q + 2] += hv * w[2]; lg[4 * q + 3] += hv * w[3]; } }
#pragma unroll
    for (int e = 0; e < 16; ++e) lg[e] = wave_sum(lg[e]);
    float mx = lg[0];
#pragma unroll
    for (int e = 1; e < 16; ++e) mx = fmaxf(mx, lg[e]);
    float pr[16], sum = 0.f;
#pragma unroll
    for (int e = 0; e < 16; ++e) { pr[e] = __expf(lg[e] - mx); sum += pr[e]; }
    const float inv = 1.f / sum;
#pragma unroll
    for (int e = 0; e < 16; ++e) pr[e] *= inv;
    float best = -1.f; int be0 = 0, be1 = 1; float bv0 = 0.f, bv1 = 0.f;
#pragma unroll
    for (int g = 0; g < 4; ++g) {
        int i1 = 0; float v1 = pr[4 * g];
#pragma unroll
        for (int i = 1; i < 4; ++i) if (pr[4 * g + i] > v1) { v1 = pr[4 * g + i]; i1 = i; }
        int i2 = -1; float v2 = -1.f;
#pragma unroll
        for (int i = 0; i < 4; ++i) if (i != i1 && pr[4 * g + i] > v2) { v2 = pr[4 * g + i]; i2 = i; }
        const float sc = v1 + v2;
        if (sc > best) { best = sc; be0 = 4 * g + i1; be1 = 4 * g + i2; bv0 = v1; bv1 = v2; }
    }
    if (lane == 0) {
        int* te = (int*)(ws + WS_TOK + TOK_E); float* tg = (float*)(ws + WS_TOK + TOK_G);
        te[2 * row] = be0; te[2 * row + 1] = be1; const float gs = 1.f / (bv0 + bv1); tg[2 * row] = bv0 * gs; tg[2 * row + 1] = bv1 * gs;
        atomicAdd((int*)&hist[be0], 1); atomicAdd((int*)&hist[be1], 1);
    }
}
__device__ __forceinline__ void combine_ln_row(const Params& p, int layer, int row, int lane) {
    unsigned char* ws = p.ws; float* res = p.out + (size_t)row * D; bf16_t* hb = (bf16_t*)(ws + WS_HB) + (size_t)row * D;
    const int* tsl = (const int*)(ws + WS_TOK + TOK_SLOT); const float* tg = (const float*)(ws + WS_TOK + TOK_G);
    const int s0 = tsl[2 * row], s1 = tsl[2 * row + 1]; const float g0 = tg[2 * row], g1 = tg[2 * row + 1];
    const bf16_t* y0 = (const bf16_t*)(ws + WS_XS) + (size_t)s0 * D; const bf16_t* y1 = (const bf16_t*)(ws + WS_XS) + (size_t)s1 * D;
    f32x4 v[4], h[4];
#pragma unroll
    for (int j = 0; j < 4; ++j) { const int c = 4 * lane + 256 * j; const f32x4 r = *(const f32x4*)(res + c);
        const u32x2 a = *(const u32x2*)(y0 + c), b = *(const u32x2*)(y1 + c);
        v[j][0] = DN_ALPHA * r[0] + g0 * bflo(a.x) + g1 * bflo(b.x); v[j][1] = DN_ALPHA * r[1] + g0 * bfhi(a.x) + g1 * bfhi(b.x);
        v[j][2] = DN_ALPHA * r[2] + g0 * bflo(a.y) + g1 * bflo(b.y); v[j][3] = DN_ALPHA * r[3] + g0 * bfhi(a.y) + g1 * bfhi(b.y); }
    ln_rows_store(v, p.ln_w + (size_t)(layer * 2 + 1) * D, p.ln_b + (size_t)(layer * 2 + 1) * D, res, hb, lane, h);
}
#define XB_TMO      128
#define XB_XCNT(j)  (256  + 64 * (j))
#define XB_XSUB(j)  (1280 + 64 * (j))
#define XB_XGEN(j)  (2304 + 64 * (j))
#define XB_TOP      3328
#define XB_TOPGEN   3392
#define XCD_BAR_WORDS 3456
#define XB_SPIN_CAP (1u << 18)

__device__ __forceinline__ unsigned xb_ld(unsigned* p)              { return __hip_atomic_load(p, __ATOMIC_RELAXED, __HIP_MEMORY_SCOPE_AGENT); }
__device__ __forceinline__ unsigned xb_add(unsigned* p, unsigned v) { return __hip_atomic_fetch_add(p, v, __ATOMIC_RELAXED, __HIP_MEMORY_SCOPE_AGENT); }
__device__ __forceinline__ unsigned xb_xcc_id() { return (unsigned)__builtin_amdgcn_s_getreg((3 << 11) | 20) & 0xFu; }
#define XB_SPIN(cond, bar) do { unsigned _sp = 0; while (cond) { __builtin_amdgcn_s_sleep(1); \
    if ((++_sp & 255u) == 0u) { if (xb_ld(&(bar)[XB_TMO])) break; if (_sp > XB_SPIN_CAP) { atomicAdd(&(bar)[XB_TMO], 1u); break; } } } } while (0)

struct XcdBarrier {
    unsigned* bar; unsigned x;
    volatile LAS unsigned* st;
};

__device__ __forceinline__ XcdBarrier xcd_barrier_post(unsigned* bar, volatile LAS unsigned* st) {
    XcdBarrier b; b.bar = bar; b.x = xb_xcc_id(); b.st = st;
    if (threadIdx.x == 0) (void)xb_add(&bar[XB_XCNT(b.x)], 1u);
    return b;
}
__device__ __forceinline__ void xcd_barrier_complete(unsigned* bar, unsigned x, unsigned& nloc, unsigned& nx) {
    const unsigned G = gridDim.x * gridDim.y * gridDim.z;
    unsigned sum, cnt, mine, sp = 0u;
    for (;;) {
        sum = 0u; cnt = 0u; mine = 0u;
#pragma unroll
        for (unsigned j = 0; j < 16; ++j) { const unsigned c = xb_ld(&bar[XB_XCNT(j)]); sum += c; cnt += (c > 0u) ? 1u : 0u; mine = (j == x) ? c : mine; }
        if (sum == G) break;
        __builtin_amdgcn_s_sleep(1);
        if ((++sp & 255u) == 0u) { if (xb_ld(&bar[XB_TMO])) break; if (sp > XB_SPIN_CAP) { atomicAdd(&bar[XB_TMO], 1u); break; } }
    }
    nloc = mine > 0u ? mine : 1u; nx = cnt > 0u ? cnt : 1u;
}

__device__ __forceinline__ void xcd_barrier(const XcdBarrier& b) {
    asm volatile("s_waitcnt vmcnt(0)" ::: "memory");
    __syncthreads();
    if (threadIdx.x == 0) {
        unsigned* bar = b.bar;
        __builtin_amdgcn_s_waitcnt(0);
        unsigned nloc = b.st[0], nx = b.st[1];
        if (nloc == 0u) { xcd_barrier_complete(bar, b.x, nloc, nx); b.st[0] = nloc; b.st[1] = nx; }
        const unsigned old = xb_add(&bar[XB_XSUB(b.x)], 1u);
        const unsigned gen = old / nloc;
        if (old + 1u == (gen + 1u) * nloc) {
            __builtin_amdgcn_fence(__ATOMIC_RELEASE, "agent");
            asm volatile("s_waitcnt vmcnt(0)" ::: "memory");
            const unsigned og = xb_add(&bar[XB_TOP], 1u);
            const unsigned tg = og / nx;
            if (og + 1u == (tg + 1u) * nx) xb_add(&bar[XB_TOPGEN], 1u);
            else XB_SPIN(xb_ld(&bar[XB_TOPGEN]) == tg, bar);
            __builtin_amdgcn_fence(__ATOMIC_ACQUIRE, "agent");
            xb_add(&bar[XB_XGEN(b.x)], 1u);
            asm volatile("s_waitcnt vmcnt(0)" ::: "memory");
        } else {
            XB_SPIN(xb_ld(&bar[XB_XGEN(b.x)]) == gen, bar);
            __builtin_amdgcn_fence(__ATOMIC_ACQUIRE, "agent");
            asm volatile("s_waitcnt vmcnt(0)" ::: "memory");
        }
    }
    __syncthreads();
}

constexpr int STAGE_LDS = 131072;
constexpr int MISC_OFF = STAGE_LDS + 320;
constexpr int LDS_BYTES = 147456;
constexpr int CW_BAR = 4096;

__device__ __forceinline__ void ph_inproj0(const Params& p, PG8_LAS unsigned char* lds, int bid, int nb) {
    pg8::Gemm g{(const bf16_t*)(p.ws + WS_HB), (const bf16_t*)(p.ws + WS_WINE), T, EVEN_IN, D};
    pg8::StaticOrder S; S.init(T, EVEN_IN, D, nb, bid);
    EpiInproj0 E{(bf16_t*)(p.ws + WS_PROJ), (const float*)(p.ws + WS_ROPE)};
    pg8::gemm_phase<EpiInproj0, pg8::StaticOrder, true, true>(lds, g, S, E);
}
__device__ __forceinline__ void ph_inproj1(const Params& p, PG8_LAS unsigned char* lds, int bid, int nb) {
    pg8::Gemm g{(const bf16_t*)(p.ws + WS_HB), (const bf16_t*)(p.ws + WS_WINO), T, ODD_IN, D};
    pg8::StaticOrder S; S.init(T, ODD_IN, D, nb, bid);
    EpiInproj1 E{(bf16_t*)(p.ws + WS_PROJ), (const float*)(p.ws + WS_LBV)};
    pg8::gemm_phase<EpiInproj1, pg8::StaticOrder, true, true>(lds, g, S, E);
}
__device__ __forceinline__ void ph_outproj(const Params& p, int layer, PG8_LAS unsigned char* lds, int bid, int nb) {
    pg8::Gemm g{(const bf16_t*)(p.ws + WS_HB), (const bf16_t*)(p.ws + (layer ? WS_WOUTO : WS_WOUTE)), T, D, D};
    pg8::StaticOrder S; S.init(T, D, D, nb, bid);
    EpiResid E{layer ? (const float*)p.out : p.x, p.out};
    pg8::gemm_phase<EpiResid, pg8::StaticOrder, true, true>(lds, g, S, E);
}
__device__ __forceinline__ void ph_moe_gateup(const Params& p, int layer, PG8_LAS unsigned char* lds, int bid, int nb) {
    const unsigned* ctl = (const unsigned*)(p.ws + WS_CTL);
    pg8::Gemm g{(const bf16_t*)(p.ws + WS_XS), (const bf16_t*)(p.ws + WS_WGU), PMAX, 1024, D};
    pg8::GroupedOrder S; S.tile_e = (const int*)(ctl + CW_TILEE + 256 * layer); S.ntiles = __builtin_amdgcn_readfirstlane((int)ctl[CW_NTILES + layer]); S.nN = 4; S.G = nb; S.c = bid;
    EpiGateUp E{(bf16_t*)(p.ws + WS_HID)};
    pg8::gemm_phase<EpiGateUp, pg8::GroupedOrder, true, true>(lds, g, S, E);
}
__device__ __forceinline__ void ph_moe_down(const Params& p, int layer, PG8_LAS unsigned char* lds, int bid, int nb) {
    const unsigned* ctl = (const unsigned*)(p.ws + WS_CTL);
    pg8::Gemm g{(const bf16_t*)(p.ws + WS_HID), (const bf16_t*)(p.ws + WS_WD), PMAX, 1024, DEXP};
    pg8::GroupedOrder S; S.tile_e = (const int*)(ctl + CW_TILEE + 256 * layer); S.ntiles = __builtin_amdgcn_readfirstlane((int)ctl[CW_NTILES + layer]); S.nN = 4; S.G = nb; S.c = bid;
    EpiBf16 E{(bf16_t*)(p.ws + WS_XS), D};
    pg8::gemm_phase<EpiBf16, pg8::GroupedOrder, true, true>(lds, g, S, E);
}

__device__ __forceinline__ void ph_ret_naive(const Params& p, int tid, int bid) {
    const int vb = bid * 4 + (tid >> 7); if (vb >= 16) return;
    const int dir = vb & 1, bh = vb >> 1, b = bh >> 2, h = bh & 3, e = tid & 127;
    const bf16_t* proj = (const bf16_t*)(p.ws + WS_PROJ);
    float* O = (float*)(p.ws + WS_SCR) + (size_t)dir * T * 512;
    const float gamma = 1.f - exp2f(-5.f - (float)h);
    float S[64];
#pragma unroll
    for (int d = 0; d < 64; ++d) S[d] = 0.f;
    for (int step = 0; step < SEQ; ++step) {
        const int t = dir ? SEQ - 1 - step : step; const size_t row = (size_t)b * SEQ + t;
        const bf16_t* pr = proj + row * EVEN_IN;
        const float v = bf2f(pr[512 + h * 128 + e]);
        float o = 0.f;
#pragma unroll
        for (int c = 0; c < 8; ++c) {
            const u32x4 qq = *(const u32x4*)(pr + h * 64 + 8 * c), kk = *(const u32x4*)(pr + 256 + h * 64 + 8 * c);
            const unsigned qa[4] = {qq.x, qq.y, qq.z, qq.w}, ka[4] = {kk.x, kk.y, kk.z, kk.w};
#pragma unroll
            for (int j = 0; j < 4; ++j) {
                const float q0 = bflo(qa[j]), q1 = bfhi(qa[j]), k0 = bflo(ka[j]), k1 = bfhi(ka[j]);
                const int d = 8 * c + 2 * j;
                if (dir == 0) { S[d] = gamma * S[d] + k0 * v; o += q0 * S[d]; S[d + 1] = gamma * S[d + 1] + k1 * v; o += q1 * S[d + 1]; }
                else { const float s0 = gamma * S[d], s1 = gamma * S[d + 1]; o += q0 * s0 + q1 * s1; S[d] = s0 + k0 * v; S[d + 1] = s1 + k1 * v; }
            }
        }
        O[row * 512 + h * 128 + e] = o;
    }
}
__device__ __forceinline__ void ph_ret_norm(const Params& p, int tid, int bid, int nb) {
    const int lane = tid & 63;
    const float* Of = (const float*)(p.ws + WS_SCR); const float* Ob = Of + (size_t)T * 512;
    const bf16_t* proj = (const bf16_t*)(p.ws + WS_PROJ); bf16_t* mix = (bf16_t*)(p.ws + WS_HB);
    for (int gwv = bid * 8 + (tid >> 6); gwv < T * 4; gwv += nb * 8) {
        const int row = gwv >> 2, h = gwv & 3;
        const size_t o = (size_t)row * 512 + h * 128 + 2 * lane;
        const float a0 = Of[o] + Ob[o], a1 = Of[o + 1] + Ob[o + 1];
        const float mean = wave_sum(a0 + a1) * (1.f / 128.f); const float d0 = a0 - mean, d1 = a1 - mean;
        const float rstd = 1.f / sqrtf(wave_sum(d0 * d0 + d1 * d1) * (1.f / 128.f) + LN_EPS);
        const unsigned gg = *(const unsigned*)(proj + (size_t)row * EVEN_IN + 1024 + h * 128 + 2 * lane);
        *(unsigned*)(mix + (size_t)row * D + h * 128 + 2 * lane) = pk2(d0 * rstd * silu(bflo(gg)), d1 * rstd * silu(bfhi(gg)));
    }
}
__device__ __forceinline__ void ph_lru_ab(const Params& p, int tid, LAS float* xc_s, int bid, int nb) {
    const int w = tid;
    const bf16_t* proj = (const bf16_t*)(p.ws + WS_PROJ);
    float* LA = (float*)(p.ws + WS_SCR); float* BV = LA + (size_t)2 * T * 512;
    for (int item = bid; item < T / 8; item += nb) {
        const int t0 = item * 8;
        __syncthreads();
        for (int tt = 0; tt < 8; ++tt) { const int t = t0 + tt, s = t & (SEQ - 1); float a = p.conv_b[w];
#pragma unroll
            for (int j = 0; j < 4; ++j) { const int ss = s + j - 2; if (ss >= 0 && ss < SEQ) a += p.conv_w[j * 512 + w] * bf2f(proj[(size_t)(t + j - 2) * EVEN_IN + 1536 + w]); }
            xc_s[tt * 512 + w] = a; }
        __syncthreads();
        const int n = w >> 7, d = w & 127;
        float g[4][8];
#pragma unroll
        for (int zg = 0; zg < 4; ++zg)
#pragma unroll
            for (int tt = 0; tt < 8; ++tt) g[zg][tt] = 0.f;
        for (int c = 0; c < 128; ++c) {
            float wv[4];
#pragma unroll
            for (int zg = 0; zg < 4; ++zg) wv[zg] = p.gate_w[((size_t)(zg * 4 + n) * 128 + c) * 128 + d];
#pragma unroll
            for (int tt = 0; tt < 8; ++tt) { const float xv = xc_s[tt * 512 + n * 128 + c];
#pragma unroll
                for (int zg = 0; zg < 4; ++zg) g[zg][tt] += xv * wv[zg]; }
        }
#pragma unroll
        for (int z = 0; z < 2; ++z) {
            const float sp = __logf(1.f + __expf(-p.lam[z * 512 + w]));
            const float br = p.gate_b[((z * 2 + 0) * 4 + n) * 128 + d], bi = p.gate_b[((z * 2 + 1) * 4 + n) * 128 + d];
#pragma unroll
            for (int tt = 0; tt < 8; ++tt) {
                const float r = sigm(g[z * 2][tt] + br), ig = sigm(g[z * 2 + 1][tt] + bi);
                const float la = -8.f * r * sp;
                const size_t idx = ((size_t)z * T + t0 + tt) * 512 + w;
                LA[idx] = la; BV[idx] = sqrtf(1.f - __expf(2.f * la)) * ig * xc_s[tt * 512 + w];
            }
        }
    }
}
__device__ __forceinline__ void ph_lru_scan(const Params& p, int tid, int bid) {
    const int gid = bid * 512 + tid; if (gid >= 2048) return;
    const int w = gid & 511, z = (gid >> 9) & 1, b = gid >> 10;
    const float* LA = (const float*)(p.ws + WS_SCR); float* BV = (float*)(p.ws + WS_SCR) + (size_t)2 * T * 512;
    float h = 0.f;
    for (int step = 0; step < SEQ; step += 8) {
        float la[8], bv[8]; size_t idx[8];
#pragma unroll
        for (int i = 0; i < 8; ++i) { const int t = z ? SEQ - 1 - (step + i) : step + i; idx[i] = ((size_t)z * T + (size_t)b * SEQ + t) * 512 + w; la[i] = LA[idx[i]]; bv[i] = BV[idx[i]]; }
#pragma unroll
        for (int i = 0; i < 8; ++i) { h = __expf(la[i]) * h + bv[i]; BV[idx[i]] = h; }
    }
}
__device__ __forceinline__ void ph_lru_out(const Params& p, int tid, int bid, int nb) {
    const int w = tid;
    const float* HS = (const float*)(p.ws + WS_SCR) + (size_t)2 * T * 512;
    const bf16_t* proj = (const bf16_t*)(p.ws + WS_PROJ); bf16_t* mix = (bf16_t*)(p.ws + WS_HB);
    for (int row = bid; row < T; row += nb) {
        const float hs = HS[(size_t)row * 512 + w] + HS[((size_t)T + row) * 512 + w];
        const float gr = bf2f(proj[(size_t)row * EVEN_IN + 2048 + w]);
        mix[(size_t)row * D + 512 + w] = (bf16_t)f2bf(hs * gelu_tanh(gr));
    }
}
__device__ __forceinline__ void ph_gla_naive(const Params& p, int tid, LAS float* sm, int bid) {
    if (bid >= 8) return;
    const int vq = tid >> 7, vb = bid * 4 + vq;
    LAS float* fs = sm + vq * 512; LAS float* qs = fs + 256;
    const int dir = vb & 1, bh = vb >> 1, b = bh >> 3, h = bh & 7, e = tid & 127;
    bf16_t* proj = (bf16_t*)(p.ws + WS_PROJ);
    float S[128];
#pragma unroll
    for (int d = 0; d < 128; ++d) S[d] = 0.f;
    for (int step = 0; step < SEQ; ++step) {
        const int t = dir ? SEQ - 1 - step : step; bf16_t* pr = proj + ((size_t)b * SEQ + t) * ODD_IN;
        const int buf = step & 1;
        fs[buf * 128 + e] = __expf(bf2f(pr[2048 + dir * 1024 + h * 128 + e])); qs[buf * 128 + e] = bf2f(pr[h * 128 + e]);
        const float v = bf2f(pr[1024 + h * 128 + e]);
        __syncthreads();
        float o = 0.f;
#pragma unroll
        for (int d = 0; d < 128; ++d) { const float f = fs[buf * 128 + d]; S[d] = f * S[d] + (1.f - f) * v; o += qs[buf * 128 + d] * S[d]; }
        pr[2048 + dir * 1024 + h * 128 + e] = (bf16_t)f2bf(o);
    }
}
__device__ __forceinline__ void ph_hg_norm(const Params& p, int tid, int bid, int nb) {
    const int lane = tid & 63;
    for (int row = bid * 8 + (tid >> 6); row < T; row += nb * 8) {
        const bf16_t* pr = (const bf16_t*)(p.ws + WS_PROJ) + (size_t)row * ODD_IN; bf16_t* mix = (bf16_t*)(p.ws + WS_HB) + (size_t)row * D;
        f32x4 o[4]; float ss = 0.f;
#pragma unroll
        for (int j = 0; j < 4; ++j) { const int c = 4 * lane + 256 * j; const u32x2 a = *(const u32x2*)(pr + 2048 + c), bb = *(const u32x2*)(pr + 3072 + c);
            o[j][0] = bflo(a.x) + bflo(bb.x); o[j][1] = bfhi(a.x) + bfhi(bb.x); o[j][2] = bflo(a.y) + bflo(bb.y); o[j][3] = bfhi(a.y) + bfhi(bb.y);
            ss += (o[j][0] * o[j][0] + o[j][1] * o[j][1]) + (o[j][2] * o[j][2] + o[j][3] * o[j][3]); }
        const float rstd = 1.f / sqrtf(wave_sum(ss) * (1.f / D) + RMS_EPS);
#pragma unroll
        for (int j = 0; j < 4; ++j) { const int c = 4 * lane + 256 * j; const f32x4 nw = *(const f32x4*)(p.norm_w + c); const u32x2 gg = *(const u32x2*)(pr + 4096 + c);
            u32x2 w; w.x = pk2(o[j][0] * rstd * nw[0] * silu(bflo(gg.x)), o[j][1] * rstd * nw[1] * silu(bfhi(gg.x)));
            w.y = pk2(o[j][2] * rstd * nw[2] * silu(bflo(gg.y)), o[j][3] * rstd * nw[3] * silu(bfhi(gg.y)));
            *(u32x2*)(mix + c) = w; }
    }
}
__device__ __forceinline__ void ph_ln_router(const Params& p, int tid, int layer, LAS int* hist, int bid, int nb) {
    const int wave = tid >> 6, lane = tid & 63;
    for (int tb = bid; tb < T / 64; tb += nb) {
        __syncthreads();
        if (tid < 16) hist[tid] = 0;
        __syncthreads();
        for (int i = 0; i < 8; ++i) ln_router_row(p, layer, tb * 64 + wave * 8 + i, lane, hist);
        __syncthreads();
        if (tid < 16) ((int*)(p.ws + WS_TOK + TOK_BH))[(layer * 256 + tb) * 16 + tid] = hist[tid];
    }
}
__device__ __forceinline__ void ph_slots(const Params& p, int tid, int layer, LAS int* sm, int bid, int nb) {
    LAS int* tot = sm; LAS int* pre = sm + 16; LAS int* base = sm + 32; LAS int* lslot = sm + 64; LAS int* le = sm + 192;
    unsigned char* ws = p.ws; int* ctl = (int*)(ws + WS_CTL);
    const int* bh = (const int*)(ws + WS_TOK + TOK_BH) + layer * 256 * 16;
    const int* te = (const int*)(ws + WS_TOK + TOK_E);
    for (int tb = bid; tb < T / 64; tb += nb) {
        const int t0 = tb * 64;
        __syncthreads();
        if (tid < 16) { int a = 0, b = 0; for (int k = 0; k < 256; ++k) { const int v = bh[k * 16 + tid]; a += v; if (k < tb) b += v; } tot[tid] = a; pre[tid] = b; }
        if (tid < 128) le[tid] = te[2 * t0 + tid];
        __syncthreads();
        if (tid == 0) { int acc = 0; for (int e = 0; e < 16; ++e) { base[e] = acc; acc += (tot[e] + 255) / 256 * 256; }
            if (tb == 0) { int k = 0; for (int e = 0; e < 16; ++e) { const int nt = (tot[e] + 255) / 256; for (int i = 0; i < nt; ++i) ctl[CW_TILEE + 256 * layer + k++] = e; } ctl[CW_NTILES + layer] = k; } }
        __syncthreads();
        if (tid < 128) { const int e = le[tid]; int rank = 0; for (int a = 0; a < tid; ++a) rank += (le[a] == e) ? 1 : 0;
            const int s = base[e] + pre[e] + rank; lslot[tid] = s; ((int*)(ws + WS_TOK + TOK_SLOT))[2 * t0 + tid] = s; }
        __syncthreads();
        const int wave = tid >> 6, lane = tid & 63;
        const bf16_t* hb = (const bf16_t*)(ws + WS_HB); bf16_t* xs = (bf16_t*)(ws + WS_XS);
        for (int i = 0; i < 8; ++i) { const int tl = wave * 8 + i; const size_t row = t0 + tl;
            const u32x4 a = *(const u32x4*)(hb + row * D + 8 * lane), b2 = *(const u32x4*)(hb + row * D + 512 + 8 * lane);
#pragma unroll
            for (int k = 0; k < 2; ++k) { bf16_t* dst = xs + (size_t)lslot[2 * tl + k] * D; *(u32x4*)(dst + 8 * lane) = a; *(u32x4*)(dst + 512 + 8 * lane) = b2; } }
    }
}
__device__ __forceinline__ void ph_combine_ln(const Params& p, int tid, int layer, int bid, int nb) {
    const int lane = tid & 63;
    for (int row = bid * 8 + (tid >> 6); row < T; row += nb * 8) combine_ln_row(p, layer, row, lane);
}

__device__ __forceinline__ Params load_params() {
    typedef const float* cfp;
    const volatile __attribute__((address_space(4))) cfp* kp = (const volatile __attribute__((address_space(4))) cfp*)__builtin_amdgcn_kernarg_segment_ptr();
    Params q;
    q.x = kp[0]; q.w_in_even = kp[1]; q.w_out_even = kp[2]; q.conv_w = kp[3]; q.conv_b = kp[4]; q.gate_w = kp[5]; q.gate_b = kp[6]; q.lam = kp[7];
    q.w_in_odd = kp[8]; q.w_out_odd = kp[9]; q.lower_bounds = kp[10]; q.norm_w = kp[11]; q.ln_w = kp[12]; q.ln_b = kp[13]; q.router_w = kp[14];
    q.moe_gate = kp[15]; q.moe_up = kp[16]; q.moe_down = kp[17]; q.out = (float*)kp[18]; q.ws = (unsigned char*)kp[19];
    return q;
}
#define PH_BEGIN { const Params p = load_params(); int tid_ = threadIdx.x; asm volatile("" : "+v"(tid_)); int bid = blockIdx.x, nb = gridDim.x; asm volatile("" : "+s"(bid), "+s"(nb)); \
    const int wave = __builtin_amdgcn_readfirstlane(tid_ >> 6), lane = tid_ & 63; LAS float* scrw = (LAS float*)(lds + wave * 16384); const int gw = bid * 8 + wave, ngw = nb * 8; \
    (void)lane; (void)scrw; (void)gw; (void)ngw;
#define PH_END }
#define GRID_BAR() { XcdBarrier b_; b_.bar = (unsigned*)(load_params().ws + WS_CTL) + CW_BAR; b_.x = xb_xcc_id(); b_.st = MISC + 8; xcd_barrier(b_); }
__global__ void __launch_bounds__(512, 2) mega_fwd(Params p_unused) {
    extern __shared__ __attribute__((aligned(16))) unsigned char shm[];
    PG8_LAS unsigned char* lds = (PG8_LAS unsigned char*)shm;
    volatile LAS unsigned* MISC = (volatile LAS unsigned*)(lds + MISC_OFF);
    for (int u = threadIdx.x; u < (LDS_BYTES - STAGE_LDS) / 4; u += 512) ((LAS unsigned*)(lds + STAGE_LDS))[u] = 0u;
    __syncthreads();
    (void)xcd_barrier_post((unsigned*)(load_params().ws + WS_CTL) + CW_BAR, MISC + 8);

    PH_BEGIN prologue_static(p, scrw, gw, ngw, lane); PH_END
    GRID_BAR();
    PH_BEGIN ph_inproj0(p, lds, bid, nb); PH_END
    GRID_BAR();
    PH_BEGIN ph_ret_naive(p, tid_, bid); PH_END
    GRID_BAR();
    PH_BEGIN ph_ret_norm(p, tid_, bid, nb); PH_END
    GRID_BAR();
    PH_BEGIN ph_lru_ab(p, tid_, (LAS float*)lds, bid, nb); PH_END
    GRID_BAR();
    PH_BEGIN ph_lru_scan(p, tid_, bid); PH_END
    GRID_BAR();
    PH_BEGIN ph_lru_out(p, tid_, bid, nb); PH_END
    GRID_BAR();
    PH_BEGIN ph_outproj(p, 0, lds, bid, nb); PH_END
    GRID_BAR();
    PH_BEGIN prologue_moe(p, 0, scrw, gw, ngw, lane); ph_ln_router(p, tid_, 0, (LAS int*)lds, bid, nb); PH_END
    GRID_BAR();
    PH_BEGIN ph_slots(p, tid_, 0, (LAS int*)lds, bid, nb); PH_END
    GRID_BAR();
    PH_BEGIN ph_moe_gateup(p, 0, lds, bid, nb); PH_END
    GRID_BAR();
    PH_BEGIN ph_moe_down(p, 0, lds, bid, nb); PH_END
    GRID_BAR();
    PH_BEGIN ph_combine_ln(p, tid_, 0, bid, nb); PH_END
    GRID_BAR();
    PH_BEGIN ph_inproj1(p, lds, bid, nb); PH_END
    GRID_BAR();
    PH_BEGIN ph_gla_naive(p, tid_, (LAS float*)lds, bid); PH_END
    GRID_BAR();
    PH_BEGIN ph_hg_norm(p, tid_, bid, nb); PH_END
    GRID_BAR();
    PH_BEGIN ph_outproj(p, 1, lds, bid, nb); PH_END
    GRID_BAR();
    PH_BEGIN prologue_moe(p, 1, scrw, gw, ngw, lane); ph_ln_router(p, tid_, 1, (LAS int*)lds, bid, nb); PH_END
    GRID_BAR();
    PH_BEGIN ph_slots(p, tid_, 1, (LAS int*)lds, bid, nb); PH_END
    GRID_BAR();
    PH_BEGIN ph_moe_gateup(p, 1, lds, bid, nb); PH_END
    GRID_BAR();
    PH_BEGIN ph_moe_down(p, 1, lds, bid, nb); PH_END
    GRID_BAR();
    PH_BEGIN ph_combine_ln(p, tid_, 1, bid, nb); PH_END
}

extern "C" void kernel_launch(void* const* d_in, const int* in_sizes, int n_in, void* d_out, int out_size, void* d_ws, size_t ws_size, hipStream_t stream) {
    static int grid = 0;
    if (grid == 0) {
        if (n_in != 18 || in_sizes[0] != T * D || out_size != T * D || ws_size < WS_END) { fprintf(stderr, "kernel_launch: unexpected shapes (n_in %d, in0 %d, out %d, ws %zu)\n", n_in, n_in > 0 ? in_sizes[0] : -1, out_size, ws_size); grid = -1; return; }
        int dev = 0, cus = 0, per_cu = 0;
        if (hipGetDevice(&dev) != hipSuccess || hipDeviceGetAttribute(&cus, hipDeviceAttributeMultiprocessorCount, dev) != hipSuccess) { grid = -1; return; }
        if (hipFuncSetAttribute((const void*)mega_fwd, hipFuncAttributeMaxDynamicSharedMemorySize, LDS_BYTES) != hipSuccess) { fprintf(stderr, "kernel_launch: hipFuncSetAttribute failed\n"); grid = -1; return; }
        if (hipOccupancyMaxActiveBlocksPerMultiprocessor(&per_cu, (const void*)mega_fwd, 512, LDS_BYTES) != hipSuccess || per_cu < 1) { fprintf(stderr, "kernel_launch: occupancy query says %d workgroups per CU\n", per_cu); }
        (void)hipGetLastError();
        grid = cus > 0 ? cus : 256;
    }
    if (grid < 0) return;
    Params p{};
    p.x = (const float*)d_in[0]; p.w_in_even = (const float*)d_in[1]; p.w_out_even = (const float*)d_in[2]; p.conv_w = (const float*)d_in[3]; p.conv_b = (const float*)d_in[4];
    p.gate_w = (const float*)d_in[5]; p.gate_b = (const float*)d_in[6]; p.lam = (const float*)d_in[7]; p.w_in_odd = (const float*)d_in[8]; p.w_out_odd = (const float*)d_in[9];
    p.lower_bounds = (const float*)d_in[10]; p.norm_w = (const float*)d_in[11]; p.ln_w = (const float*)d_in[12]; p.ln_b = (const float*)d_in[13]; p.router_w = (const float*)d_in[14];
    p.moe_gate = (const float*)d_in[15]; p.moe_up = (const float*)d_in[16]; p.moe_down = (const float*)d_in[17];
    p.out = (float*)d_out; p.ws = (unsigned char*)d_ws;
    if (hipMemsetAsync((char*)d_ws + WS_CTL, 0, CTL_BYTES, stream) != hipSuccess) return;
    hipLaunchKernelGGL(mega_fwd, dim3(grid), dim3(512), LDS_BYTES, stream, p);
}
```

```cpp
#include <hip/hip_runtime.h>
#include <cstdio>
#include <cstdint>

namespace pg8 {
#define PG8_LAS __attribute__((address_space(3)))
typedef unsigned short bf16_t;
typedef short bf16x8 __attribute__((ext_vector_type(8)));
typedef float f32x4 __attribute__((ext_vector_type(4)));
typedef unsigned u32x4 __attribute__((ext_vector_type(4)));
constexpr int BM = 256, BK = 64, HALF = 128, HTB = HALF * BK * 2  , STAGE_BYTES = 8 * HTB, NXCD = 8, WGM = 8;

__host__ __device__ __forceinline__ int lds_byte(int r, int c) { const int st = (r >> 4) * 2 + (c >> 5), rr = r & 15, cc = c & 31, ob = rr * 64 + cc * 2; return st * 1024 + (ob ^ (((ob >> 9) & 1) << 5)); }
__host__ __device__ __forceinline__ void stage_rc(int b, int& R, int& C) { const int st = b / 1024, sb = b % 1024, swz = sb ^ (((sb >> 9) & 1) << 5); R = (st >> 1) * 16 + swz / 64; C = (st & 1) * 32 + (swz % 64) / 2; }
__host__ __device__ __forceinline__ int perm32(int rho) { const int n = rho >> 4, i = rho & 15; return 8 * (i >> 2) + 4 * n + (i & 3); }

struct Unit { int pm, pn, brow; };
struct Gemm { const bf16_t* A; const bf16_t* Bt; int M, N, K; };

struct StaticOrder {
    int nM, nN, nwg, G, c;
    __host__ __device__ void init(int M, int N, int K, int G_, int c_) { nM = M / BM; nN = N / BM; nwg = nM * nN; G = G_; c = c_; }
    __host__ __device__ bool next(int i, Unit& u) const {
        const long L = (long)i * G + c; if (L >= nwg) return false;
        int wgid = (int)L; { const int q = nwg / NXCD, r = nwg % NXCD, xcd = wgid % NXCD, off = wgid / NXCD; wgid = (xcd < r ? xcd * (q + 1) : r * (q + 1) + (xcd - r) * q) + off; }
        const int nig = WGM * nN, gid = wgid / nig, fm = gid * WGM, gsz = (nM - fm) < WGM ? (nM - fm) : WGM;
        u.pm = fm + ((wgid % nig) % gsz); u.pn = (wgid % nig) / gsz; u.brow = u.pn; return true;
    }
    __device__ __forceinline__ void a_ready(const Unit&) const {}
    __device__ __forceinline__ void done(const Unit&) const {}
};
struct GroupedOrder {
    const int* tile_e; int ntiles, nN, G, c;
    __device__ bool next(int i, Unit& u) const {
        const int L = i * G + c; if (L >= ntiles * nN) return false;
        u.pm = L / nN; u.pn = L % nN;
        u.brow = __builtin_amdgcn_readfirstlane(tile_e[u.pm]) * nN + u.pn; return true;
    }
    __device__ __forceinline__ void a_ready(const Unit&) const {}
    __device__ __forceinline__ void done(const Unit&) const {}
};

__device__ __forceinline__ unsigned cvt_pk_bf16(float lo, float hi) { unsigned r; asm volatile("v_cvt_pk_bf16_f32 %0, %1, %2" : "=v"(r) : "v"(lo), "v"(hi)); return r; }

template <class Epi, class Sched, bool ALIGN_EPI = false, bool SP2 = false>
__device__ __forceinline__ void gemm_phase(PG8_LAS unsigned char* lds, const Gemm g, const Sched& S, const Epi& E) {
    int tid_ = threadIdx.x; asm volatile("" : "+v"(tid_));
    const int tid = tid_, wid = __builtin_amdgcn_readfirstlane(tid >> 6), lane = tid & 63, wr = wid >> 2, wc = wid & 3, fr = lane & 15, fq = lane >> 4;
    const int K = g.K, nt = K / BK;
    unsigned voffA[2], voffB[2];
#pragma unroll
    for (int i = 0; i < 2; ++i) { int R, C; stage_rc(tid * 16 + i * 8192, R, C); const int Rb = Epi::PERM ? ((R & ~31) + perm32(R & 31)) : R;
        voffA[i] = (unsigned)(R * K + C) * 2u; voffB[i] = (unsigned)(Rb * K + C) * 2u; }
    const size_t kstep = (size_t)(BK * 2);
    const size_t hstep = (size_t)HALF * K * 2;
    const unsigned ldsw = (unsigned)wid * 1024u;
    const int aoff = lds_byte(wr * 64 + fr, fq * 8), boff = lds_byte(wc * 32 + fr, fq * 8);
#define PG8_SA(b, h) (((b) * 2 + (h)) * HTB)
#define PG8_SB(b, h) ((4 + (b) * 2 + (h)) * HTB)
#define PG8_STAGE(bufoff, gbase, voff) do { _Pragma("unroll") for (int _i = 0; _i < 2; ++_i) \
        __builtin_amdgcn_global_load_lds((const unsigned*)((const char*)(gbase) + (voff)[_i]), (PG8_LAS unsigned*)(lds + (bufoff) + ldsw + _i * 8192), 16, 0, 0); } while (0)
#define PG8_LDA(dst, b, h) do { _Pragma("unroll") for (int m = 0; m < 4; ++m) _Pragma("unroll") for (int k = 0; k < 2; ++k) dst[m][k] = *(const PG8_LAS bf16x8*)(lds + PG8_SA(b, h) + aoff + m * 2048 + k * 1024); } while (0)
#define PG8_LDB(dst, b, h) do { _Pragma("unroll") for (int n = 0; n < 2; ++n) _Pragma("unroll") for (int k = 0; k < 2; ++k) dst[n][k] = *(const PG8_LAS bf16x8*)(lds + PG8_SB(b, h) + boff + n * 2048 + k * 1024); } while (0)
#define PG8_MMA(ai, bj, At, Bt) do { __builtin_amdgcn_s_setprio(1); _Pragma("unroll") for (int m = 0; m < 4; ++m) _Pragma("unroll") for (int n = 0; n < 2; ++n) _Pragma("unroll") for (int k = 0; k < 2; ++k) \
        acc[ai][bj][m][n] = __builtin_amdgcn_mfma_f32_16x16x32_bf16(Bt[n][k], At[m][k], acc[ai][bj][m][n], 0, 0, 0); __builtin_amdgcn_s_setprio(0); } while (0)
#define PG8_WAIT_V(n) asm volatile("s_waitcnt vmcnt(" #n ")" ::: "memory")
#define PG8_WAIT_L(n) asm volatile("s_waitcnt lgkmcnt(" #n ")" ::: "memory")
#define PG8_BAR __builtin_amdgcn_s_barrier()
#define PG8_SCHED __builtin_amdgcn_sched_barrier(0)
    Unit cur, nxt; int ui = 0;
    if (!S.next(0, cur)) return;
    f32x4 acc[2][2][4][2];
#pragma unroll
    for (int a = 0; a < 2; ++a)
#pragma unroll
        for (int b = 0; b < 2; ++b)
#pragma unroll
            for (int m = 0; m < 4; ++m)
#pragma unroll
                for (int n = 0; n < 2; ++n) acc[a][b][m][n] = (f32x4){0.f, 0.f, 0.f, 0.f};
    bf16x8 At[4][2], B0[2][2], B1[2][2];
    const size_t tstep = 2 * hstep;
    const char* cA = (const char*)g.A + (size_t)cur.pm * tstep; const char* cB = (const char*)g.Bt + (size_t)cur.brow * tstep;
    S.a_ready(cur);
    if constexpr (SP2) {
        PG8_STAGE(PG8_SB(0, 0), cB, voffB); PG8_STAGE(PG8_SB(0, 1), cB + hstep, voffB); PG8_STAGE(PG8_SA(0, 0), cA, voffA); PG8_STAGE(PG8_SA(0, 1), cA + hstep, voffA);
        if (wr == 1) PG8_BAR;
        PG8_WAIT_V(2); PG8_BAR;
        PG8_STAGE(PG8_SB(1, 0), cB + kstep, voffB); PG8_STAGE(PG8_SA(1, 0), cA + kstep, voffA); PG8_STAGE(PG8_SB(1, 1), cB + hstep + kstep, voffB);
        PG8_WAIT_V(6); PG8_BAR;
    } else {
        PG8_STAGE(PG8_SB(0, 0), cB, voffB); PG8_STAGE(PG8_SA(0, 0), cA, voffA); PG8_STAGE(PG8_SB(0, 1), cB + hstep, voffB); PG8_STAGE(PG8_SA(0, 1), cA + hstep, voffA);
        if (wr == 1) PG8_BAR;
        PG8_WAIT_V(4); PG8_BAR;
        PG8_STAGE(PG8_SB(1, 0), cB + kstep, voffB); PG8_STAGE(PG8_SA(1, 0), cA + kstep, voffA); PG8_STAGE(PG8_SB(1, 1), cB + hstep + kstep, voffB);
        PG8_WAIT_V(6); PG8_BAR;
    }
    for (;;) {
        const bool has_next = S.next(ui + 1, nxt);
        const char* nA = has_next ? (const char*)g.A + (size_t)nxt.pm * tstep : cA; const char* nB = has_next ? (const char*)g.Bt + (size_t)nxt.brow * tstep : cB;
        for (int t = 0; t < nt; t += 2) {
            const bool last = (t == nt - 2);
            const char* a1 = cA + (size_t)(t + 1) * kstep;
            const char* a2 = last ? nA : cA + (size_t)(t + 2) * kstep; const char* b2 = last ? nB : cB + (size_t)(t + 2) * kstep;
            const char* a3 = a2 + kstep; const char* b3 = b2 + kstep;
            if (last && has_next) S.a_ready(nxt);
            if constexpr (SP2) {
            PG8_LDB(B0, 0, 0); PG8_LDB(B1, 0, 1); PG8_SCHED; PG8_LDA(At, 0, 0); PG8_STAGE(PG8_SA(1, 1), a1 + hstep, voffA);
            PG8_WAIT_V(8); PG8_WAIT_L(0); PG8_BAR; PG8_MMA(0, 0, At, B0); PG8_MMA(0, 1, At, B1); PG8_BAR; PG8_SCHED;
            PG8_LDA(At, 0, 1); PG8_STAGE(PG8_SB(0, 0), b2, voffB); PG8_STAGE(PG8_SB(0, 1), b2 + hstep, voffB); PG8_STAGE(PG8_SA(0, 0), a2, voffA);
            PG8_WAIT_V(8); PG8_WAIT_L(0); PG8_BAR; PG8_MMA(1, 0, At, B0); PG8_MMA(1, 1, At, B1); PG8_BAR; PG8_SCHED;
            PG8_LDB(B0, 1, 0); PG8_LDB(B1, 1, 1); PG8_SCHED; PG8_LDA(At, 1, 0); PG8_STAGE(PG8_SA(0, 1), a2 + hstep, voffA);
            PG8_WAIT_V(8); PG8_WAIT_L(0); PG8_BAR; PG8_MMA(0, 0, At, B0); PG8_MMA(0, 1, At, B1); PG8_BAR; PG8_SCHED;
            PG8_LDA(At, 1, 1); PG8_STAGE(PG8_SB(1, 0), b3, voffB); PG8_STAGE(PG8_SB(1, 1), b3 + hstep, voffB); PG8_STAGE(PG8_SA(1, 0), a3, voffA);
            PG8_WAIT_V(8); PG8_WAIT_L(0); PG8_BAR; PG8_MMA(1, 0, At, B0); PG8_MMA(1, 1, At, B1); PG8_BAR; PG8_SCHED;
            } else {
            PG8_LDB(B0, 0, 0); PG8_SCHED; PG8_LDA(At, 0, 0); PG8_STAGE(PG8_SA(1, 1), a1 + hstep, voffA);
            PG8_WAIT_L(8); PG8_BAR; PG8_WAIT_L(0); PG8_MMA(0, 0, At, B0); PG8_BAR; PG8_SCHED;
            PG8_LDB(B1, 0, 1); PG8_STAGE(PG8_SB(0, 0), b2, voffB);
            PG8_BAR; PG8_WAIT_L(0); PG8_MMA(0, 1, At, B1); PG8_BAR;
            PG8_LDA(At, 0, 1); PG8_STAGE(PG8_SA(0, 0), a2, voffA);
            PG8_BAR; PG8_WAIT_L(0); PG8_MMA(1, 0, At, B0); PG8_BAR; PG8_SCHED;
            PG8_STAGE(PG8_SB(0, 1), b2 + hstep, voffB);
            PG8_WAIT_V(6); PG8_BAR; PG8_MMA(1, 1, At, B1); PG8_BAR;
            PG8_LDB(B0, 1, 0); PG8_SCHED; PG8_LDA(At, 1, 0); PG8_STAGE(PG8_SA(0, 1), a2 + hstep, voffA);
            PG8_WAIT_L(8); PG8_BAR; PG8_WAIT_L(0); PG8_MMA(0, 0, At, B0); PG8_BAR; PG8_SCHED;
            PG8_LDB(B1, 1, 1); PG8_STAGE(PG8_SB(1, 0), b3, voffB);
            PG8_BAR; PG8_WAIT_L(0); PG8_MMA(0, 1, At, B1); PG8_BAR;
            PG8_LDA(At, 1, 1); PG8_STAGE(PG8_SA(1, 0), a3, voffA);
            PG8_BAR; PG8_WAIT_L(0); PG8_MMA(1, 0, At, B0); PG8_BAR; PG8_SCHED;
            PG8_STAGE(PG8_SB(1, 1), b3 + hstep, voffB);
            PG8_WAIT_V(6); PG8_BAR; PG8_MMA(1, 1, At, B1); PG8_BAR;
            }
        }
        if constexpr (ALIGN_EPI) { if (wr == 0) PG8_BAR; }
        if constexpr (!Epi::AFTER_DRAIN) { E(acc, cur, wr, wc, fr, fq); S.done(cur); }
        if (!has_next) break;
#pragma unroll
        for (int a = 0; a < 2; ++a)
#pragma unroll
            for (int b = 0; b < 2; ++b)
#pragma unroll
                for (int m = 0; m < 4; ++m)
#pragma unroll
                    for (int n = 0; n < 2; ++n) acc[a][b][m][n] = (f32x4){0.f, 0.f, 0.f, 0.f};
        cur = nxt; cA = nA; cB = nB; ++ui;
        if constexpr (ALIGN_EPI) { if (wr == 1) PG8_BAR; }
    }
    PG8_WAIT_V(0);
    if constexpr (!ALIGN_EPI) { if (wr == 0) PG8_BAR; }
    PG8_BAR;
    if constexpr (Epi::AFTER_DRAIN) { E.fused(acc, cur, wr, wc, fr, fq, lds, wid, lane); S.done(cur); }
#undef PG8_SA
#undef PG8_SB
#undef PG8_STAGE
#undef PG8_LDA
#undef PG8_LDB
#undef PG8_MMA
#undef PG8_WAIT_V
#undef PG8_WAIT_L
#undef PG8_BAR
#undef PG8_SCHED
}
}

using pg8::bf16_t; using pg8::bf16x8; using pg8::f32x4; using pg8::u32x4; using pg8::Unit;
typedef float f32x2 __attribute__((ext_vector_type(2)));
typedef unsigned u32x2 __attribute__((ext_vector_type(2)));
#define LAS __attribute__((address_space(3)))

constexpr int NB = 2, SEQ = 8192, T = NB * SEQ, D = 1024;
constexpr int EVEN_IN = 2560, ODD_IN = 5120;
constexpr int NEXP = 16, DEXP = 512;
constexpr int PMAX = 36864;
constexpr int MAXTILES = PMAX / 256;
constexpr float DN_ALPHA = 1.41421356237f;
constexpr float LN_EPS = 1e-5f, RMS_EPS = 1e-6f;

constexpr size_t MiB = 1u << 20;
constexpr size_t WS_CTL = 0, CTL_BYTES = 1 * MiB;
constexpr size_t WS_ROPE = 1 * MiB;
constexpr size_t WS_LBV = 3 * MiB;
constexpr size_t WS_WINE = 4 * MiB;
constexpr size_t WS_WOUTE = 9 * MiB;
constexpr size_t WS_WINO = 11 * MiB;
constexpr size_t WS_WOUTO = 21 * MiB;
constexpr size_t WS_LGT = 23 * MiB;
constexpr size_t WS_HB = 24 * MiB;
constexpr size_t WS_PROJ = 56 * MiB;
constexpr size_t WS_XS = WS_PROJ;
constexpr size_t WS_HID = WS_PROJ + 72 * MiB;
constexpr size_t WS_SCR = WS_PROJ + 80 * MiB;
constexpr size_t WS_WGU = 216 * MiB;
constexpr size_t WS_WD = 248 * MiB;
constexpr size_t WS_TOK = 3 * MiB + 65536;
constexpr size_t WS_END = 282 * MiB;
constexpr int CW_COUNTS = 1024;
constexpr int CW_CURSOR = 1024 + 64;
constexpr int CW_NTILES = 1024 + 128;
constexpr int CW_TILEE = 2048;
constexpr size_t TOK_E = 0, TOK_G = 128 * 1024, TOK_SLOT = 256 * 1024, TOK_BH = 384 * 1024;

struct Params {
    const float* x; const float* w_in_even; const float* w_out_even; const float* conv_w; const float* conv_b; const float* gate_w; const float* gate_b; const float* lam;
    const float* w_in_odd; const float* w_out_odd; const float* lower_bounds; const float* norm_w; const float* ln_w; const float* ln_b; const float* router_w;
    const float* moe_gate; const float* moe_up; const float* moe_down;
    float* out; unsigned char* ws;
};

__device__ __forceinline__ float bf2f(unsigned b) { return __uint_as_float(b << 16); }
__device__ __forceinline__ float bflo(unsigned u) { return __uint_as_float(u << 16); }
__device__ __forceinline__ float bfhi(unsigned u) { return __uint_as_float(u & 0xffff0000u); }
__device__ __forceinline__ unsigned f2bf(float f) { unsigned u = __float_as_uint(f); return (u + 0x7fffu + ((u >> 16) & 1u)) >> 16; }
__device__ __forceinline__ unsigned pk2(float lo, float hi) { return f2bf(lo) | (f2bf(hi) << 16); }
__device__ __forceinline__ float sigm(float x) { return 1.f / (1.f + __expf(-x)); }
__device__ __forceinline__ float silu(float x) { return x / (1.f + __expf(-x)); }
__device__ __forceinline__ float gelu_tanh(float x) { const float u = 0.7978845608028654f * (x + 0.044715f * x * x * x); return x / (1.f + __expf(-2.f * u)); }
__device__ __forceinline__ float wave_sum(float v) {
#pragma unroll
    for (int o = 1; o < 64; o <<= 1) v += __shfl_xor(v, o);
    return v;
}
#define LDS_WAIT() asm volatile("s_waitcnt lgkmcnt(0)" ::: "memory")
typedef __bf16 bf16x2_t __attribute__((ext_vector_type(2)));
__device__ __forceinline__ unsigned cvtpk(float lo, float hi) { const f32x2 v = {lo, hi}; const bf16x2_t b = __builtin_convertvector(v, bf16x2_t); return __builtin_bit_cast(unsigned, b); }

__device__ __forceinline__ void store8bf(bf16_t* p, const f32x4& v0, const f32x4& v1) {
    u32x4 w; w.x = cvtpk(v0[0], v0[1]); w.y = cvtpk(v0[2], v0[3]); w.z = cvtpk(v1[0], v1[1]); w.w = cvtpk(v1[2], v1[3]);
    *(u32x4*)p = w;
}
struct EpiInproj0 {
    static constexpr bool PERM = true, AFTER_DRAIN = false;
    bf16_t* O; const float* rope;
    __device__ __forceinline__ void operator()(const f32x4 (&acc)[2][2][4][2], const Unit& u, int wr, int wc, int fr, int fq) const {
        const int row0 = u.pm * 256 + wr * 64 + fr, colt = u.pn * 256 + wc * 32 + 8 * fq;
#pragma unroll
        for (int ai = 0; ai < 2; ++ai)
#pragma unroll
            for (int m = 0; m < 4; ++m) {
                const int row = row0 + ai * 128 + m * 16; const int pos = row & (SEQ - 1);
#pragma unroll
                for (int bj = 0; bj < 2; ++bj) {
                    const int col = colt + bj * 128;
                    f32x4 v0 = acc[ai][bj][m][0], v1 = acc[ai][bj][m][1];
                    if (u.pn < 2) {
                        const float sc = (col < 256) ? 0.125f : 1.0f;
                        const f32x4* rp = (const f32x4*)(rope + ((size_t)pos * 32 + ((col & 63) >> 1)) * 2);
                        const f32x4 c0 = rp[0], c1 = rp[1];
                        f32x4 r0, r1;
                        r0[0] = (v0[0] * c0[0] - v0[1] * c0[1]) * sc; r0[1] = (v0[0] * c0[1] + v0[1] * c0[0]) * sc;
                        r0[2] = (v0[2] * c0[2] - v0[3] * c0[3]) * sc; r0[3] = (v0[2] * c0[3] + v0[3] * c0[2]) * sc;
                        r1[0] = (v1[0] * c1[0] - v1[1] * c1[1]) * sc; r1[1] = (v1[0] * c1[1] + v1[1] * c1[0]) * sc;
                        r1[2] = (v1[2] * c1[2] - v1[3] * c1[3]) * sc; r1[3] = (v1[2] * c1[3] + v1[3] * c1[2]) * sc;
                        v0 = r0; v1 = r1;
                    }
                    store8bf(O + (size_t)row * EVEN_IN + col, v0, v1);
                }
            }
    }
};
struct EpiInproj1 {
    static constexpr bool PERM = true, AFTER_DRAIN = false;
    bf16_t* O; const float* lbv;
    __device__ __forceinline__ void operator()(const f32x4 (&acc)[2][2][4][2], const Unit& u, int wr, int wc, int fr, int fq) const {
        const int row0 = u.pm * 256 + wr * 64 + fr, colt = u.pn * 256 + wc * 32 + 8 * fq;
        const int seg = u.pn >> 2;
#pragma unroll
        for (int bj = 0; bj < 2; ++bj) {
            const int col = colt + bj * 128;
            f32x4 lb0 = {0.f, 0.f, 0.f, 0.f}, lb1 = {0.f, 0.f, 0.f, 0.f};
            if (seg == 2 || seg == 3) { lb0 = *(const f32x4*)(lbv + (col & 1023)); lb1 = *(const f32x4*)(lbv + (col & 1023) + 4); }
#pragma unroll
            for (int ai = 0; ai < 2; ++ai)
#pragma unroll
                for (int m = 0; m < 4; ++m) {
                    const int row = row0 + ai * 128 + m * 16;
                    f32x4 v0 = acc[ai][bj][m][0], v1 = acc[ai][bj][m][1];
                    if (seg == 0) {
#pragma unroll
                        for (int j = 0; j < 4; ++j) { v0[j] = silu(v0[j]) * 0.08838834764831845f; v1[j] = silu(v1[j]) * 0.08838834764831845f; }
                    } else if (seg == 2 || seg == 3) {
#pragma unroll
                        for (int j = 0; j < 4; ++j) { v0[j] = __logf(lb0[j] + (1.f - lb0[j]) * sigm(v0[j])); v1[j] = __logf(lb1[j] + (1.f - lb1[j]) * sigm(v1[j])); }
                    }
                    store8bf(O + (size_t)row * ODD_IN + col, v0, v1);
                }
        }
    }
};
struct EpiResid {
    static constexpr bool PERM = false, AFTER_DRAIN = false;
    const float* res; float* out;
    __device__ __forceinline__ void operator()(const f32x4 (&acc)[2][2][4][2], const Unit& u, int wr, int wc, int fr, int fq) const {
        const int row0 = u.pm * 256 + wr * 64 + fr, col0 = u.pn * 256 + wc * 32 + 4 * fq;
#pragma unroll
        for (int ai = 0; ai < 2; ++ai)
#pragma unroll
            for (int m = 0; m < 4; ++m) {
                const size_t off = (size_t)(row0 + ai * 128 + m * 16) * D + col0;
#pragma unroll
                for (int bj = 0; bj < 2; ++bj)
#pragma unroll
                    for (int n = 0; n < 2; ++n) { const f32x4 r = *(const f32x4*)(res + off + bj * 128 + n * 16); *(f32x4*)(out + off + bj * 128 + n * 16) = r * DN_ALPHA + acc[ai][bj][m][n]; }
            }
    }
};
struct EpiGateUp {
    static constexpr bool PERM = true, AFTER_DRAIN = false;
    bf16_t* O;
    __device__ __forceinline__ void operator()(const f32x4 (&acc)[2][2][4][2], const Unit& u, int wr, int wc, int fr, int fq) const {
        const int row0 = u.pm * 256 + wr * 64 + fr, col = u.pn * 128 + wc * 32 + 8 * fq;
#pragma unroll
        for (int ai = 0; ai < 2; ++ai)
#pragma unroll
            for (int m = 0; m < 4; ++m) {
                const int row = row0 + ai * 128 + m * 16;
                f32x4 v0, v1;
#pragma unroll
                for (int j = 0; j < 4; ++j) { v0[j] = silu(acc[ai][0][m][0][j]) * acc[ai][1][m][0][j]; v1[j] = silu(acc[ai][0][m][1][j]) * acc[ai][1][m][1][j]; }
                store8bf(O + (size_t)row * DEXP + col, v0, v1);
            }
    }
};
struct EpiBf16 {
    static constexpr bool PERM = true, AFTER_DRAIN = false;
    bf16_t* O; int ldc;
    __device__ __forceinline__ void operator()(const f32x4 (&acc)[2][2][4][2], const Unit& u, int wr, int wc, int fr, int fq) const {
        const int row0 = u.pm * 256 + wr * 64 + fr, colt = u.pn * 256 + wc * 32 + 8 * fq;
#pragma unroll
        for (int ai = 0; ai < 2; ++ai)
#pragma unroll
            for (int m = 0; m < 4; ++m) {
                const int row = row0 + ai * 128 + m * 16;
#pragma unroll
                for (int bj = 0; bj < 2; ++bj) store8bf(O + (size_t)row * ldc + colt + bj * 128, acc[ai][bj][m][0], acc[ai][bj][m][1]);
            }
    }
};

__device__ __forceinline__ void transpose_item(const float* W, int N, bf16_t* WT, int K, int k0, int n0, int drow0, LAS float* scr, int lane) {
#pragma unroll 8
    for (int i = 0; i < 32; ++i) { const int kk = 2 * i + (lane >> 5); scr[kk * 33 + (lane & 31)] = W[(size_t)(k0 + kk) * N + n0 + (lane & 31)]; }
    LDS_WAIT();
    const int c = lane & 7;
#pragma unroll
    for (int j = 0; j < 4; ++j) { const int n = (lane >> 3) + 8 * j; const LAS float* s = scr + (8 * c) * 33 + n;
        u32x4 o; o.x = pk2(s[0 * 33], s[1 * 33]); o.y = pk2(s[2 * 33], s[3 * 33]); o.z = pk2(s[4 * 33], s[5 * 33]); o.w = pk2(s[6 * 33], s[7 * 33]);
        *(u32x4*)(WT + (size_t)(drow0 + n) * K + k0 + 8 * c) = o; }
    LDS_WAIT();
}
__device__ __forceinline__ void transpose_dense(const float* W, int K, int N, bf16_t* WT, int item, LAS float* scr, int lane) {
    const int nblk = N / 32, kb = item / nblk, nb = item % nblk;
    transpose_item(W, N, WT, K, 64 * kb, 32 * nb, 32 * nb, scr, lane);
}
__device__ __forceinline__ void prologue_static(const Params& p, LAS float* scr, int gw, int ngw, int lane) {
    unsigned char* ws = p.ws;
    constexpr int I_WINE = 16 * 80, I_WOUTE = 16 * 32, I_WINO = 16 * 160, I_WOUTO = 16 * 32, I_LG = 16 * 8;
    constexpr int NITEMS = I_WINE + I_WOUTE + I_WINO + I_WOUTO + I_LG;
    for (int it = gw; it < NITEMS; it += ngw) {
        int r = it;
        if (r < I_WINE) { transpose_dense(p.w_in_even, 1024, EVEN_IN, (bf16_t*)(ws + WS_WINE), r, scr, lane); continue; } r -= I_WINE;
        if (r < I_WOUTE) { transpose_dense(p.w_out_even, 1024, 1024, (bf16_t*)(ws + WS_WOUTE), r, scr, lane); continue; } r -= I_WOUTE;
        if (r < I_WINO) { transpose_dense(p.w_in_odd, 1024, ODD_IN, (bf16_t*)(ws + WS_WINO), r, scr, lane); continue; } r -= I_WINO;
        if (r < I_WOUTO) { transpose_dense(p.w_out_odd, 1024, 1024, (bf16_t*)(ws + WS_WOUTO), r, scr, lane); continue; } r -= I_WOUTO;
        { const int mat = r >> 3, sub = r & 7;
          transpose_dense(p.gate_w + (size_t)mat * 128 * 128, 128, 128, (bf16_t*)(ws + WS_LGT) + (size_t)mat * 128 * 128, sub, scr, lane); }
    }
    { const size_t n8 = (size_t)T * D / 8; bf16_t* xb = (bf16_t*)(ws + WS_HB);
      for (size_t i = (size_t)gw * 64 + lane; i < n8; i += (size_t)ngw * 64) {
          const f32x4 a = *(const f32x4*)(p.x + i * 8), b = *(const f32x4*)(p.x + i * 8 + 4);
          u32x4 o; o.x = pk2(a[0], a[1]); o.y = pk2(a[2], a[3]); o.z = pk2(b[0], b[1]); o.w = pk2(b[2], b[3]);
          *(u32x4*)(xb + i * 8) = o; } }
    { float* rope = (float*)(ws + WS_ROPE);
      for (int i = gw * 64 + lane; i < SEQ * 32; i += ngw * 64) {
          const int pos = i >> 5, fi = i & 31;
          double inv = 0.15915494309189535;
          if (fi & 1) inv *= 0.7498942093324559; if (fi & 2) inv *= 0.5623413251903491; if (fi & 4) inv *= 0.31622776601683794; if (fi & 8) inv *= 0.1; if (fi & 16) inv *= 0.01;
          const double rev = (double)pos * inv; const float fr = (float)(rev - floor(rev));
          rope[2 * i] = __builtin_amdgcn_cosf(fr); rope[2 * i + 1] = __builtin_amdgcn_sinf(fr); }
      float* lbv = (float*)(ws + WS_LBV);
      for (int i = gw * 64 + lane; i < 1024; i += ngw * 64) { const float l0 = p.lower_bounds[i], l1 = p.lower_bounds[1024 + i]; lbv[i] = 1.f / (1.f + __expf(l0 - l1)); } }
}
__device__ __forceinline__ void prologue_moe(const Params& p, int layer, LAS float* scr, int gw, int ngw, int lane) {
    unsigned char* ws = p.ws;
    constexpr int I_GU = 16 * 16, I_D = 8 * 32;
    constexpr int NITEMS = NEXP * (2 * I_GU + I_D);
    for (int it = gw; it < NITEMS; it += ngw) {
        const int e = it / (2 * I_GU + I_D); int r = it % (2 * I_GU + I_D);
        if (r < 2 * I_GU) { const int sel = r / I_GU; r %= I_GU; const int kb = r / 16, nb = r % 16, n0 = 32 * nb;
            const float* W = (sel ? p.moe_up : p.moe_gate) + ((size_t)layer * NEXP + e) * 1024 * 512;
            transpose_item(W, 512, (bf16_t*)(ws + WS_WGU) + (size_t)e * 1024 * 1024, 1024, 64 * kb, n0, 256 * (n0 >> 7) + 128 * sel + (n0 & 127), scr, lane);
        } else { r -= 2 * I_GU;
            const float* W = p.moe_down + ((size_t)layer * NEXP + e) * 512 * 1024;
            transpose_dense(W, 512, 1024, (bf16_t*)(ws + WS_WD) + (size_t)e * 1024 * 512, r, scr, lane); }
    }
}

__device__ __forceinline__ void ln_rows_store(const f32x4 (&v)[4], const float* lw, const float* lb, float* orow, bf16_t* brow, int lane, f32x4 (&h)[4]) {
    float s = 0.f;
#pragma unroll
    for (int j = 0; j < 4; ++j) s += (v[j][0] + v[j][1]) + (v[j][2] + v[j][3]);
    const float mean = wave_sum(s) * (1.f / D); float s2 = 0.f;
#pragma unroll
    for (int j = 0; j < 4; ++j) { const f32x4 d = v[j] - mean; s2 += (d[0] * d[0] + d[1] * d[1]) + (d[2] * d[2] + d[3] * d[3]); }
    const float rstd = 1.f / sqrtf(wave_sum(s2) * (1.f / D) + LN_EPS);
#pragma unroll
    for (int j = 0; j < 4; ++j) { const int c = 4 * lane + 256 * j; const f32x4 w = *(const f32x4*)(lw + c), b = *(const f32x4*)(lb + c);
        h[j] = (v[j] - mean) * rstd * w + b;
        *(f32x4*)(orow + c) = h[j];
        u32x2 o; o.x = pk2(h[j][0], h[j][1]); o.y = pk2(h[j][2], h[j][3]); *(u32x2*)(brow + c) = o; }
}
__device__ __forceinline__ void ln_router_row(const Params& p, int layer, int row, int lane, LAS int* hist) {
    unsigned char* ws = p.ws; float* res = p.out + (size_t)row * D; bf16_t* hb = (bf16_t*)(ws + WS_HB) + (size_t)row * D;
    f32x4 v[4], h[4];
#pragma unroll
    for (int j = 0; j < 4; ++j) v[j] = *(const f32x4*)(res + 4 * lane + 256 * j);
    ln_rows_store(v, p.ln_w + (size_t)(layer * 2 + 0) * D, p.ln_b + (size_t)(layer * 2 + 0) * D, res, hb, lane, h);
    float lg[16];
#pragma unroll
    for (int e = 0; e < 16; ++e) lg[e] = 0.f;
#pragma unroll
    for (int j = 0; j < 4; ++j)
#pragma unroll
        for (int i = 0; i < 4; ++i) { const float* rw = p.router_w + (size_t)(4 * lane + 256 * j + i) * 16; const float hv = h[j][i];
#pragma unroll
            for (int q = 0; q < 4; ++q) { const f32x4 w = *(const f32x4*)(rw + 4 * q); lg[4 * q] += hv * w[0]; lg[4 * q + 1] += hv * w[1]; lg[4 * q + 2] += hv * w[2]; lg[4 * q + 3] += hv * w[3]; } }
#pragma unroll
    for (int e = 0; e < 16; ++e) lg[e] = wave_sum(lg[e]);
    float mx = lg[0];
#pragma unroll
    for (int e = 1; e < 16; ++e) mx = fmaxf(mx, lg[e]);
    float pr[16], sum = 0.f;
#pragma unroll
    for (int e = 0; e < 16; ++e) { pr[e] = __expf(lg[e] - mx); sum += pr[e]; }
    const float inv = 1.f / sum;
#pragma unroll
    for (int e = 0; e < 16; ++e) pr[e] *= inv;
    float best = -1.f; int be0 = 0, be1 = 1; float bv0 = 0.f, bv1 = 0.f;
#pragma unroll
    for (int g = 0; g < 4; ++g) {
        int i1 = 0; float v1 = pr[4 * g];
#pragma unroll
        for (int i = 1; i < 4; ++i) if (pr[4 * g + i] > v1) { v1 = pr[4 * g + i]; i1 = i; }
        int i2 = -1; float v2 = -1.f;
#pragma unroll
        for (int i = 0; i < 4; ++i) if (i != i1 && pr[4 * g + i] > v2) { v2 = pr[4 * g + i]; i2 = i; }
        const float sc = v1 + v2;
        if (sc > best) { best = sc; be0 = 4 * g + i1; be1 = 4 * g + i2; bv0 = v1; bv1 = v2; }
    }
    if (lane == 0) {
        int* te = (int*)(ws + WS_TOK + TOK_E); float* tg = (float*)(ws + WS_TOK + TOK_G);
        te[2 * row] = be0; te[2 * row + 1] = be1; const float gs = 1.f / (bv0 + bv1); tg[2 * row] = bv0 * gs; tg[2 * row + 1] = bv1 * gs;
        atomicAdd((int*)&hist[be0], 1); atomicAdd((int*)&hist[be1], 1);
    }
}
__device__ __forceinline__ void combine_ln_row(const Params& p, int layer, int row, int lane) {
    unsigned char* ws = p.ws; float* res = p.out + (size_t)row * D; bf16_t* hb = (bf16_t*)(ws + WS_HB) + (size_t)row * D;
    const int* tsl = (const int*)(ws + WS_TOK + TOK_SLOT); const float* tg = (const float*)(ws + WS_TOK + TOK_G);
    const int s0 = tsl[2 * row], s1 = tsl[2 * row + 1]; const float g0 = tg[2 * row], g1 = tg[2 * row + 1];
    const bf16_t* y0 = (const bf16_t*)(ws + WS_XS) + (size_t)s0 * D; const bf16_t* y1 = (const bf16_t*)(ws + WS_XS) + (size_t)s1 * D;
    f32x4 v[4], h[4];
#pragma unroll
    for (int j = 0; j < 4; ++j) { const int c = 4 * lane + 256 * j; const f32x4 r = *(const f32x4*)(res + c);
        const u32x2 a = *(const u32x2*)(y0 + c), b = *(const u32x2*)(y1 + c);
        v[j][0] = DN_ALPHA * r[0] + g0 * bflo(a.x) + g1 * bflo(b.x); v[j][1] = DN_ALPHA * r[1] + g0 * bfhi(a.x) + g1 * bfhi(b.x);
        v[j][2] = DN_ALPHA * r[2] + g0 * bflo(a.y) + g1 * bflo(b.y); v[j][3] = DN_ALPHA * r[3] + g0 * bfhi(a.y) + g1 * bfhi(b.y); }
    ln_rows_store(v, p.ln_w + (size_t)(layer * 2 + 1) * D, p.ln_b + (size_t)(layer * 2 + 1) * D, res, hb, lane, h);
}
#define XB_TMO      128
#define XB_XCNT(j)  (256  + 64 * (j))
#define XB_XSUB(j)  (1280 + 64 * (j))
#define XB_XGEN(j)  (2304 + 64 * (j))
#define XB_TOP      3328
#define XB_TOPGEN   3392
#define XCD_BAR_WORDS 3456
#define XB_SPIN_CAP (1u << 18)

__device__ __forceinline__ unsigned xb_ld(unsigned* p)              { return __hip_atomic_load(p, __ATOMIC_RELAXED, __HIP_MEMORY_SCOPE_AGENT); }
__device__ __forceinline__ unsigned xb_add(unsigned* p, unsigned v) { return __hip_atomic_fetch_add(p, v, __ATOMIC_RELAXED, __HIP_MEMORY_SCOPE_AGENT); }
__device__ __forceinline__ unsigned xb_xcc_id() { return (unsigned)__builtin_amdgcn_s_getreg((3 << 11) | 20) & 0xFu; }
#define XB_SPIN(cond, bar) do { unsigned _sp = 0; while (cond) { __builtin_amdgcn_s_sleep(1); \
    if ((++_sp & 255u) == 0u) { if (xb_ld(&(bar)[XB_TMO])) break; if (_sp > XB_SPIN_CAP) { atomicAdd(&(bar)[XB_TMO], 1u); break; } } } } while (0)

struct XcdBarrier {
    unsigned* bar; unsigned x;
    volatile LAS unsigned* st;
};

__device__ __forceinline__ XcdBarrier xcd_barrier_post(unsigned* bar, volatile LAS unsigned* st) {
    XcdBarrier b; b.bar = bar; b.x = xb_xcc_id(); b.st = st;
    if (threadIdx.x == 0) (void)xb_add(&bar[XB_XCNT(b.x)], 1u);
    return b;
}
__device__ __forceinline__ void xcd_barrier_complete(unsigned* bar, unsigned x, unsigned& nloc, unsigned& nx) {
    const unsigned G = gridDim.x * gridDim.y * gridDim.z;
    unsigned sum, cnt, mine, sp = 0u;
    for (;;) {
        sum = 0u; cnt = 0u; mine = 0u;
#pragma unroll
        for (unsigned j = 0; j < 16; ++j) { const unsigned c = xb_ld(&bar[XB_XCNT(j)]); sum += c; cnt += (c > 0u) ? 1u : 0u; mine = (j == x) ? c : mine; }
        if (sum == G) break;
        __builtin_amdgcn_s_sleep(1);
        if ((++sp & 255u) == 0u) { if (xb_ld(&bar[XB_TMO])) break; if (sp > XB_SPIN_CAP) { atomicAdd(&bar[XB_TMO], 1u); break; } }
    }
    nloc = mine > 0u ? mine : 1u; nx = cnt > 0u ? cnt : 1u;
}

__device__ __forceinline__ void xcd_barrier(const XcdBarrier& b) {
    asm volatile("s_waitcnt vmcnt(0)" ::: "memory");
    __syncthreads();
    if (threadIdx.x == 0) {
        unsigned* bar = b.bar;
        __builtin_amdgcn_s_waitcnt(0);
        unsigned nloc = b.st[0], nx = b.st[1];
        if (nloc == 0u) { xcd_barrier_complete(bar, b.x, nloc, nx); b.st[0] = nloc; b.st[1] = nx; }
        const unsigned old = xb_add(&bar[XB_XSUB(b.x)], 1u);
        const unsigned gen = old / nloc;
        if (old + 1u == (gen + 1u) * nloc) {
            __builtin_amdgcn_fence(__ATOMIC_RELEASE, "agent");
            asm volatile("s_waitcnt vmcnt(0)" ::: "memory");
            const unsigned og = xb_add(&bar[XB_TOP], 1u);
            const unsigned tg = og / nx;
            if (og + 1u == (tg + 1u) * nx) xb_add(&bar[XB_TOPGEN], 1u);
            else XB_SPIN(xb_ld(&bar[XB_TOPGEN]) == tg, bar);
            __builtin_amdgcn_fence(__ATOMIC_ACQUIRE, "agent");
            xb_add(&bar[XB_XGEN(b.x)], 1u);
            asm volatile("s_waitcnt vmcnt(0)" ::: "memory");
        } else {
            XB_SPIN(xb_ld(&bar[XB_XGEN(b.x)]) == gen, bar);
            __builtin_amdgcn_fence(__ATOMIC_ACQUIRE, "agent");
            asm volatile("s_waitcnt vmcnt(0)" ::: "memory");
        }
    }
    __syncthreads();
}

constexpr int STAGE_LDS = 131072;
constexpr int MISC_OFF = STAGE_LDS + 320;
constexpr int LDS_BYTES = 147456;
constexpr int CW_BAR = 4096;

__device__ __forceinline__ void ph_inproj0(const Params& p, PG8_LAS unsigned char* lds, int bid, int nb) {
    pg8::Gemm g{(const bf16_t*)(p.ws + WS_HB), (const bf16_t*)(p.ws + WS_WINE), T, EVEN_IN, D};
    pg8::StaticOrder S; S.init(T, EVEN_IN, D, nb, bid);
    EpiInproj0 E{(bf16_t*)(p.ws + WS_PROJ), (const float*)(p.ws + WS_ROPE)};
    pg8::gemm_phase<EpiInproj0, pg8::StaticOrder, true, true>(lds, g, S, E);
}
__device__ __forceinline__ void ph_inproj1(const Params& p, PG8_LAS unsigned char* lds, int bid, int nb) {
    pg8::Gemm g{(const bf16_t*)(p.ws + WS_HB), (const bf16_t*)(p.ws + WS_WINO), T, ODD_IN, D};
    pg8::StaticOrder S; S.init(T, ODD_IN, D, nb, bid);
    EpiInproj1 E{(bf16_t*)(p.ws + WS_PROJ), (const float*)(p.ws + WS_LBV)};
    pg8::gemm_phase<EpiInproj1, pg8::StaticOrder, true, true>(lds, g, S, E);
}
__device__ __forceinline__ void ph_outproj(const Params& p, int layer, PG8_LAS unsigned char* lds, int bid, int nb) {
    pg8::Gemm g{(const bf16_t*)(p.ws + WS_HB), (const bf16_t*)(p.ws + (layer ? WS_WOUTO : WS_WOUTE)), T, D, D};
    pg8::StaticOrder S; S.init(T, D, D, nb, bid);
    EpiResid E{layer ? (const float*)p.out : p.x, p.out};
    pg8::gemm_phase<EpiResid, pg8::StaticOrder, true, true>(lds, g, S, E);
}
__device__ __forceinline__ void ph_moe_gateup(const Params& p, int layer, PG8_LAS unsigned char* lds, int bid, int nb) {
    const unsigned* ctl = (const unsigned*)(p.ws + WS_CTL);
    pg8::Gemm g{(const bf16_t*)(p.ws + WS_XS), (const bf16_t*)(p.ws + WS_WGU), PMAX, 1024, D};
    pg8::GroupedOrder S; S.tile_e = (const int*)(ctl + CW_TILEE + 256 * layer); S.ntiles = __builtin_amdgcn_readfirstlane((int)ctl[CW_NTILES + layer]); S.nN = 4; S.G = nb; S.c = bid;
    EpiGateUp E{(bf16_t*)(p.ws + WS_HID)};
    pg8::gemm_phase<EpiGateUp, pg8::GroupedOrder, true, true>(lds, g, S, E);
}
__device__ __forceinline__ void ph_moe_down(const Params& p, int layer, PG8_LAS unsigned char* lds, int bid, int nb) {
    const unsigned* ctl = (const unsigned*)(p.ws + WS_CTL);
    pg8::Gemm g{(const bf16_t*)(p.ws + WS_HID), (const bf16_t*)(p.ws + WS_WD), PMAX, 1024, DEXP};
    pg8::GroupedOrder S; S.tile_e = (const int*)(ctl + CW_TILEE + 256 * layer); S.ntiles = __builtin_amdgcn_readfirstlane((int)ctl[CW_NTILES + layer]); S.nN = 4; S.G = nb; S.c = bid;
    EpiBf16 E{(bf16_t*)(p.ws + WS_XS), D};
    pg8::gemm_phase<EpiBf16, pg8::GroupedOrder, true, true>(lds, g, S, E);
}

__device__ __forceinline__ void ph_ret_naive(const Params& p, int tid, int bid) {
    const int vb = bid * 4 + (tid >> 7); if (vb >= 16) return;
    const int dir = vb & 1, bh = vb >> 1, b = bh >> 2, h = bh & 3, e = tid & 127;
    const bf16_t* proj = (const bf16_t*)(p.ws + WS_PROJ);
    float* O = (float*)(p.ws + WS_SCR) + (size_t)dir * T * 512;
    const float gamma = 1.f - exp2f(-5.f - (float)h);
    float S[64];
#pragma unroll
    for (int d = 0; d < 64; ++d) S[d] = 0.f;
    for (int step = 0; step < SEQ; ++step) {
        const int t = dir ? SEQ - 1 - step : step; const size_t row = (size_t)b * SEQ + t;
        const bf16_t* pr = proj + row * EVEN_IN;
        const float v = bf2f(pr[512 + h * 128 + e]);
        float o = 0.f;
#pragma unroll
        for (int c = 0; c < 8; ++c) {
            const u32x4 qq = *(const u32x4*)(pr + h * 64 + 8 * c), kk = *(const u32x4*)(pr + 256 + h * 64 + 8 * c);
            const unsigned qa[4] = {qq.x, qq.y, qq.z, qq.w}, ka[4] = {kk.x, kk.y, kk.z, kk.w};
#pragma unroll
            for (int j = 0; j < 4; ++j) {
                const float q0 = bflo(qa[j]), q1 = bfhi(qa[j]), k0 = bflo(ka[j]), k1 = bfhi(ka[j]);
                const int d = 8 * c + 2 * j;
                if (dir == 0) { S[d] = gamma * S[d] + k0 * v; o += q0 * S[d]; S[d + 1] = gamma * S[d + 1] + k1 * v; o += q1 * S[d + 1]; }
                else { const float s0 = gamma * S[d], s1 = gamma * S[d + 1]; o += q0 * s0 + q1 * s1; S[d] = s0 + k0 * v; S[d + 1] = s1 + k1 * v; }
            }
        }
        O[row * 512 + h * 128 + e] = o;
    }
}
__device__ __forceinline__ void ph_ret_norm(const Params& p, int tid, int bid, int nb) {
    const int lane = tid & 63;
    const float* Of = (const float*)(p.ws + WS_SCR); const float* Ob = Of + (size_t)T * 512;
    const bf16_t* proj = (const bf16_t*)(p.ws + WS_PROJ); bf16_t* mix = (bf16_t*)(p.ws + WS_HB);
    for (int gwv = bid * 8 + (tid >> 6); gwv < T * 4; gwv += nb * 8) {
        const int row = gwv >> 2, h = gwv & 3;
        const size_t o = (size_t)row * 512 + h * 128 + 2 * lane;
        const float a0 = Of[o] + Ob[o], a1 = Of[o + 1] + Ob[o + 1];
        const float mean = wave_sum(a0 + a1) * (1.f / 128.f); const float d0 = a0 - mean, d1 = a1 - mean;
        const float rstd = 1.f / sqrtf(wave_sum(d0 * d0 + d1 * d1) * (1.f / 128.f) + LN_EPS);
        const unsigned gg = *(const unsigned*)(proj + (size_t)row * EVEN_IN + 1024 + h * 128 + 2 * lane);
        *(unsigned*)(mix + (size_t)row * D + h * 128 + 2 * lane) = pk2(d0 * rstd * silu(bflo(gg)), d1 * rstd * silu(bfhi(gg)));
    }
}
__device__ __forceinline__ void ph_lru_ab(const Params& p, int tid, LAS float* xc_s, int bid, int nb) {
    const int w = tid;
    const bf16_t* proj = (const bf16_t*)(p.ws + WS_PROJ);
    float* LA = (float*)(p.ws + WS_SCR); float* BV = LA + (size_t)2 * T * 512;
    for (int item = bid; item < T / 8; item += nb) {
        const int t0 = item * 8;
        __syncthreads();
        for (int tt = 0; tt < 8; ++tt) { const int t = t0 + tt, s = t & (SEQ - 1); float a = p.conv_b[w];
#pragma unroll
            for (int j = 0; j < 4; ++j) { const int ss = s + j - 2; if (ss >= 0 && ss < SEQ) a += p.conv_w[j * 512 + w] * bf2f(proj[(size_t)(t + j - 2) * EVEN_IN + 1536 + w]); }
            xc_s[tt * 512 + w] = a; }
        __syncthreads();
        const int n = w >> 7, d = w & 127;
        float g[4][8];
#pragma unroll
        for (int zg = 0; zg < 4; ++zg)
#pragma unroll
            for (int tt = 0; tt < 8; ++tt) g[zg][tt] = 0.f;
        for (int c = 0; c < 128; ++c) {
            float wv[4];
#pragma unroll
            for (int zg = 0; zg < 4; ++zg) wv[zg] = p.gate_w[((size_t)(zg * 4 + n) * 128 + c) * 128 + d];
#pragma unroll
            for (int tt = 0; tt < 8; ++tt) { const float xv = xc_s[tt * 512 + n * 128 + c];
#pragma unroll
                for (int zg = 0; zg < 4; ++zg) g[zg][tt] += xv * wv[zg]; }
        }
#pragma unroll
        for (int z = 0; z < 2; ++z) {
            const float sp = __logf(1.f + __expf(-p.lam[z * 512 + w]));
            const float br = p.gate_b[((z * 2 + 0) * 4 + n) * 128 + d], bi = p.gate_b[((z * 2 + 1) * 4 + n) * 128 + d];
#pragma unroll
            for (int tt = 0; tt < 8; ++tt) {
                const float r = sigm(g[z * 2][tt] + br), ig = sigm(g[z * 2 + 1][tt] + bi);
                const float la = -8.f * r * sp;
                const size_t idx = ((size_t)z * T + t0 + tt) * 512 + w;
                LA[idx] = la; BV[idx] = sqrtf(1.f - __expf(2.f * la)) * ig * xc_s[tt * 512 + w];
            }
        }
    }
}
__device__ __forceinline__ void ph_lru_scan(const Params& p, int tid, int bid) {
    const int gid = bid * 512 + tid; if (gid >= 2048) return;
    const int w = gid & 511, z = (gid >> 9) & 1, b = gid >> 10;
    const float* LA = (const float*)(p.ws + WS_SCR); float* BV = (float*)(p.ws + WS_SCR) + (size_t)2 * T * 512;
    float h = 0.f;
    for (int step = 0; step < SEQ; step += 8) {
        float la[8], bv[8]; size_t idx[8];
#pragma unroll
        for (int i = 0; i < 8; ++i) { const int t = z ? SEQ - 1 - (step + i) : step + i; idx[i] = ((size_t)z * T + (size_t)b * SEQ + t) * 512 + w; la[i] = LA[idx[i]]; bv[i] = BV[idx[i]]; }
#pragma unroll
        for (int i = 0; i < 8; ++i) { h = __expf(la[i]) * h + bv[i]; BV[idx[i]] = h; }
    }
}
__device__ __forceinline__ void ph_lru_out(const Params& p, int tid, int bid, int nb) {
    const int w = tid;
    const float* HS = (const float*)(p.ws + WS_SCR) + (size_t)2 * T * 512;
    const bf16_t* proj = (const bf16_t*)(p.ws + WS_PROJ); bf16_t* mix = (bf16_t*)(p.ws + WS_HB);
    for (int row = bid; row < T; row += nb) {
        const float hs = HS[(size_t)row * 512 + w] + HS[((size_t)T + row) * 512 + w];
        const float gr = bf2f(proj[(size_t)row * EVEN_IN + 2048 + w]);
        mix[(size_t)row * D + 512 + w] = (bf16_t)f2bf(hs * gelu_tanh(gr));
    }
}
__device__ __forceinline__ void ph_gla_naive(const Params& p, int tid, LAS float* sm, int bid) {
    if (bid >= 8) return;
    const int vq = tid >> 7, vb = bid * 4 + vq;
    LAS float* fs = sm + vq * 512; LAS float* qs = fs + 256;
    const int dir = vb & 1, bh = vb >> 1, b = bh >> 3, h = bh & 7, e = tid & 127;
    bf16_t* proj = (bf16_t*)(p.ws + WS_PROJ);
    float S[128];
#pragma unroll
    for (int d = 0; d < 128; ++d) S[d] = 0.f;
    for (int step = 0; step < SEQ; ++step) {
        const int t = dir ? SEQ - 1 - step : step; bf16_t* pr = proj + ((size_t)b * SEQ + t) * ODD_IN;
        const int buf = step & 1;
        fs[buf * 128 + e] = __expf(bf2f(pr[2048 + dir * 1024 + h * 128 + e])); qs[buf * 128 + e] = bf2f(pr[h * 128 + e]);
        const float v = bf2f(pr[1024 + h * 128 + e]);
        __syncthreads();
        float o = 0.f;
#pragma unroll
        for (int d = 0; d < 128; ++d) { const float f = fs[buf * 128 + d]; S[d] = f * S[d] + (1.f - f) * v; o += qs[buf * 128 + d] * S[d]; }
        pr[2048 + dir * 1024 + h * 128 + e] = (bf16_t)f2bf(o);
    }
}
__device__ __forceinline__ void ph_hg_norm(const Params& p, int tid, int bid, int nb) {
    const int lane = tid & 63;
    for (int row = bid * 8 + (tid >> 6); row < T; row += nb * 8) {
        const bf16_t* pr = (const bf16_t*)(p.ws + WS_PROJ) + (size_t)row * ODD_IN; bf16_t* mix = (bf16_t*)(p.ws + WS_HB) + (size_t)row * D;
        f32x4 o[4]; float ss = 0.f;
#pragma unroll
        for (int j = 0; j < 4; ++j) { const int c = 4 * lane + 256 * j; const u32x2 a = *(const u32x2*)(pr + 2048 + c), bb = *(const u32x2*)(pr + 3072 + c);
            o[j][0] = bflo(a.x) + bflo(bb.x); o[j][1] = bfhi(a.x) + bfhi(bb.x); o[j][2] = bflo(a.y) + bflo(bb.y); o[j][3] = bfhi(a.y) + bfhi(bb.y);
            ss += (o[j][0] * o[j][0] + o[j][1] * o[j][1]) + (o[j][2] * o[j][2] + o[j][3] * o[j][3]); }
        const float rstd = 1.f / sqrtf(wave_sum(ss) * (1.f / D) + RMS_EPS);
#pragma unroll
        for (int j = 0; j < 4; ++j) { const int c = 4 * lane + 256 * j; const f32x4 nw = *(const f32x4*)(p.norm_w + c); const u32x2 gg = *(const u32x2*)(pr + 4096 + c);
            u32x2 w; w.x = pk2(o[j][0] * rstd * nw[0] * silu(bflo(gg.x)), o[j][1] * rstd * nw[1] * silu(bfhi(gg.x)));
            w.y = pk2(o[j][2] * rstd * nw[2] * silu(bflo(gg.y)), o[j][3] * rstd * nw[3] * silu(bfhi(gg.y)));
            *(u32x2*)(mix + c) = w; }
    }
}
__device__ __forceinline__ void ph_ln_router(const Params& p, int tid, int layer, LAS int* hist, int bid, int nb) {
    const int wave = tid >> 6, lane = tid & 63;
    for (int tb = bid; tb < T / 64; tb += nb) {
        __syncthreads();
        if (tid < 16) hist[tid] = 0;
        __syncthreads();
        for (int i = 0; i < 8; ++i) ln_router_row(p, layer, tb * 64 + wave * 8 + i, lane, hist);
        __syncthreads();
        if (tid < 16) ((int*)(p.ws + WS_TOK + TOK_BH))[(layer * 256 + tb) * 16 + tid] = hist[tid];
    }
}
__device__ __forceinline__ void ph_slots(const Params& p, int tid, int layer, LAS int* sm, int bid, int nb) {
    LAS int* tot = sm; LAS int* pre = sm + 16; LAS int* base = sm + 32; LAS int* lslot = sm + 64; LAS int* le = sm + 192;
    unsigned char* ws = p.ws; int* ctl = (int*)(ws + WS_CTL);
    const int* bh = (const int*)(ws + WS_TOK + TOK_BH) + layer * 256 * 16;
    const int* te = (const int*)(ws + WS_TOK + TOK_E);
    for (int tb = bid; tb < T / 64; tb += nb) {
        const int t0 = tb * 64;
        __syncthreads();
        if (tid < 16) { int a = 0, b = 0; for (int k = 0; k < 256; ++k) { const int v = bh[k * 16 + tid]; a += v; if (k < tb) b += v; } tot[tid] = a; pre[tid] = b; }
        if (tid < 128) le[tid] = te[2 * t0 + tid];
        __syncthreads();
        if (tid == 0) { int acc = 0; for (int e = 0; e < 16; ++e) { base[e] = acc; acc += (tot[e] + 255) / 256 * 256; }
            if (tb == 0) { int k = 0; for (int e = 0; e < 16; ++e) { const int nt = (tot[e] + 255) / 256; for (int i = 0; i < nt; ++i) ctl[CW_TILEE + 256 * layer + k++] = e; } ctl[CW_NTILES + layer] = k; } }
        __syncthreads();
        if (tid < 128) { const int e = le[tid]; int rank = 0; for (int a = 0; a < tid; ++a) rank += (le[a] == e) ? 1 : 0;
            const int s = base[e] + pre[e] + rank; lslot[tid] = s; ((int*)(ws + WS_TOK + TOK_SLOT))[2 * t0 + tid] = s; }
        __syncthreads();
        const int wave = tid >> 6, lane = tid & 63;
        const bf16_t* hb = (const bf16_t*)(ws + WS_HB); bf16_t* xs = (bf16_t*)(ws + WS_XS);
        for (int i = 0; i < 8; ++i) { const int tl = wave * 8 + i; const size_t row = t0 + tl;
            const u32x4 a = *(const u32x4*)(hb + row * D + 8 * lane), b2 = *(const u32x4*)(hb + row * D + 512 + 8 * lane);
#pragma unroll
            for (int k = 0; k < 2; ++k) { bf16_t* dst = xs + (size_t)lslot[2 * tl + k] * D; *(u32x4*)(dst + 8 * lane) = a; *(u32x4*)(dst + 512 + 8 * lane) = b2; } }
    }
}
__device__ __forceinline__ void ph_combine_ln(const Params& p, int tid, int layer, int bid, int nb) {
    const int lane = tid & 63;
    for (int row = bid * 8 + (tid >> 6); row < T; row += nb * 8) combine_ln_row(p, layer, row, lane);
}

constexpr int ENG_L = 512, ENG_NSC = SEQ / ENG_L, ENG_NC = ENG_L / 64;
struct EngDesc {
    const bf16_t* q; const bf16_t* kg; const bf16_t* v;
    bf16_t* o; int ors; int rs;
    int row0, dir, tau0;
    float lg;
    float* state; float* lgam;
};
typedef unsigned short u16x8 __attribute__((ext_vector_type(8)));
#define MFMA16(a, b, c) __builtin_amdgcn_mfma_f32_16x16x32_bf16((a), (b), (c), 0, 0, 0)

template <int DK, int MODE, int PASS>
__device__ __forceinline__ void engine_unit(const EngDesc& ds, LAS unsigned char* lds, int tid) {
    constexpr int CPW = DK / 8, NG = 64 / CPW, TG = CPW;
    constexpr int QS = (DK + 8) * 2, TS = 144;
    constexpr int OFF_QI = 0, OFF_KI = OFF_QI + 64 * QS, OFF_KT = OFF_KI + 64 * QS, OFF_VT = OFF_KT + DK * TS, OFF_ATT = OFF_VT + 128 * TS, OFF_BL = OFF_ATT + 64 * TS;
    constexpr int NDT = DK / 16, NKS = DK / 32;
    const int w = __builtin_amdgcn_readfirstlane(tid >> 6), l = tid & 63, fr = l & 15, fq = l >> 4;
    const int d1 = CPW * w + (l % CPW), g1 = l / CPW;
    const int e2 = 16 * w + fr, g2 = fq;
    f32x4 S[NDT];
#pragma unroll
    for (int dt = 0; dt < NDT; ++dt) { if (PASS == 1) S[dt] = *(const f32x4*)(ds.state + ((size_t)(w * NDT + dt) * 64 + l) * 4); else S[dt] = (f32x4){0.f, 0.f, 0.f, 0.f}; }
    float lgsum = 0.f;
    unsigned short rq[TG], rk[TG], rv[16];
#define ENG_ROW(tau) ((size_t)(ds.row0 + (ds.dir ? (SEQ - 1 - (tau)) : (tau))))
#define ENG_LOAD_RAW(c) do { const int tb_ = ds.tau0 + 64 * (c); \
        _Pragma("unroll") for (int i = 0; i < TG; ++i) { const size_t r_ = ENG_ROW(tb_ + g1 * TG + i) * ds.rs + d1; \
            if (MODE == 0 || true) rk[i] = ds.kg[r_]; if (PASS == 1) rq[i] = ds.q[r_]; } \
        _Pragma("unroll") for (int i = 0; i < 16; ++i) rv[i] = ds.v[ENG_ROW(tb_ + g2 * 16 + i) * ds.rs + e2]; } while (0)
    ENG_LOAD_RAW(0);
#pragma unroll 1
    for (int c = 0; c < ENG_NC; ++c) {
        __syncthreads();
        {
            float b[TG], bl;
            if (MODE == 1) {
                float run = 0.f;
#pragma unroll
                for (int i = 0; i < TG; ++i) { run += bf2f(rk[i]); b[i] = run; }
                float acc = run;
#pragma unroll
                for (int s = 0; (1 << s) < NG; ++s) { const float t = __shfl_up(acc, CPW << s); if (g1 >= (1 << s)) acc += t; }
                const float excl = acc - run;
                bl = __shfl(acc, (NG - 1) * CPW + (l % CPW));
#pragma unroll
                for (int i = 0; i < TG; ++i) b[i] += excl;
            } else {
#pragma unroll
                for (int i = 0; i < TG; ++i) b[i] = (float)(g1 * TG + i + 1) * ds.lg;
                bl = 64.f * ds.lg;
            }
            lgsum += bl;
            unsigned kt[TG / 2];
#pragma unroll
            for (int i = 0; i < TG; i += 2) {
                float kv0, kv1;
                if (MODE == 1) { kv0 = 1.f - __expf(bf2f(rk[i])); kv1 = 1.f - __expf(bf2f(rk[i + 1])); } else { kv0 = bf2f(rk[i]); kv1 = bf2f(rk[i + 1]); }
                const float x0 = b[i] - bl, x1 = b[i + 1] - bl;
                const float k0 = kv0 * __expf(-x0), k1 = kv1 * __expf(-x1);
                kt[i / 2] = cvtpk(k0, k1);
                if (PASS == 1) {
                    const float q0 = bf2f(rq[i]) * __expf(fminf(x0, 80.f)), q1 = bf2f(rq[i + 1]) * __expf(fminf(x1, 80.f));
                    const unsigned qp = cvtpk(q0, q1);
                    const int tk = g1 * TG + i;
                    *(LAS unsigned short*)(lds + OFF_QI + tk * QS + d1 * 2) = (unsigned short)(qp & 0xffffu); *(LAS unsigned short*)(lds + OFF_QI + (tk + 1) * QS + d1 * 2) = (unsigned short)(qp >> 16);
                    *(LAS unsigned short*)(lds + OFF_KI + tk * QS + d1 * 2) = (unsigned short)(kt[i / 2] & 0xffffu); *(LAS unsigned short*)(lds + OFF_KI + (tk + 1) * QS + d1 * 2) = (unsigned short)(kt[i / 2] >> 16);
                }
            }
#pragma unroll
            for (int i = 0; i < TG / 8; ++i) { u32x4 pk; pk.x = kt[4 * i]; pk.y = kt[4 * i + 1]; pk.z = kt[4 * i + 2]; pk.w = kt[4 * i + 3];
                *(LAS u32x4*)(lds + OFF_KT + d1 * TS + (g1 * TG + 8 * i) * 2) = pk; }
            if (g1 == 0) *(LAS float*)(lds + OFF_BL + d1 * 4) = bl;
#pragma unroll
            for (int i = 0; i < 2; ++i) { u32x4 pk; pk.x = rv[8 * i] | ((unsigned)rv[8 * i + 1] << 16); pk.y = rv[8 * i + 2] | ((unsigned)rv[8 * i + 3] << 16);
                pk.z = rv[8 * i + 4] | ((unsigned)rv[8 * i + 5] << 16); pk.w = rv[8 * i + 6] | ((unsigned)rv[8 * i + 7] << 16);
                *(LAS u32x4*)(lds + OFF_VT + e2 * TS + (g2 * 16 + 8 * i) * 2) = pk; }
        }
        if (c + 1 < ENG_NC) ENG_LOAD_RAW(c + 1);
        __syncthreads();
#pragma unroll
        for (int dt = 0; dt < NDT; ++dt) { const f32x4 bv = *(const LAS f32x4*)(lds + OFF_BL + (16 * dt + 4 * fq) * 4);
            S[dt][0] *= __expf(bv[0]); S[dt][1] *= __expf(bv[1]); S[dt][2] *= __expf(bv[2]); S[dt][3] *= __expf(bv[3]); }
        f32x4 oacc[4];
        if (PASS == 1) {
#pragma unroll
            for (int tt = 0; tt < 2; ++tt) {
                const int t = 2 * w + tt, jt = t >> 2, it = t & 3;
                f32x4 sc = {0.f, 0.f, 0.f, 0.f};
                if (jt <= it) {
#pragma unroll
                    for (int ks = 0; ks < NKS; ++ks) {
                        const bf16x8 a = *(const LAS bf16x8*)(lds + OFF_KI + (16 * jt + fr) * QS + (32 * ks + 8 * fq) * 2);
                        const bf16x8 bq = *(const LAS bf16x8*)(lds + OFF_QI + (16 * it + fr) * QS + (32 * ks + 8 * fq) * 2);
                        sc = MFMA16(a, bq, sc);
                    }
                    if (jt == it) {
#pragma unroll
                        for (int r = 0; r < 4; ++r) if (4 * fq + r > fr) sc[r] = 0.f;
                    }
                }
                u32x2 pk; pk.x = cvtpk(sc[0], sc[1]); pk.y = cvtpk(sc[2], sc[3]);
                *(LAS u32x2*)(lds + OFF_ATT + (16 * it + fr) * TS + (16 * jt + 4 * fq) * 2) = pk;
            }
            bf16x8 sa[NKS];
#pragma unroll
            for (int ks = 0; ks < NKS; ++ks) { u32x4 pk; pk.x = cvtpk(S[2 * ks][0], S[2 * ks][1]); pk.y = cvtpk(S[2 * ks][2], S[2 * ks][3]);
                pk.z = cvtpk(S[2 * ks + 1][0], S[2 * ks + 1][1]); pk.w = cvtpk(S[2 * ks + 1][2], S[2 * ks + 1][3]); sa[ks] = __builtin_bit_cast(bf16x8, pk); }
#pragma unroll
            for (int it = 0; it < 4; ++it) {
                oacc[it] = (f32x4){0.f, 0.f, 0.f, 0.f};
#pragma unroll
                for (int ks = 0; ks < NKS; ++ks) {
                    const u32x2 lo = *(const LAS u32x2*)(lds + OFF_QI + (16 * it + fr) * QS + (32 * ks + 4 * fq) * 2);
                    const u32x2 hi = *(const LAS u32x2*)(lds + OFF_QI + (16 * it + fr) * QS + (32 * ks + 16 + 4 * fq) * 2);
                    u32x4 pk; pk.x = lo.x; pk.y = lo.y; pk.z = hi.x; pk.w = hi.y;
                    oacc[it] = MFMA16(sa[ks], __builtin_bit_cast(bf16x8, pk), oacc[it]);
                }
            }
            __syncthreads();
        }
        bf16x8 vf[2];
#pragma unroll
        for (int ks = 0; ks < 2; ++ks) vf[ks] = *(const LAS bf16x8*)(lds + OFF_VT + (16 * w + fr) * TS + (32 * ks + 8 * fq) * 2);
        if (PASS == 1) {
#pragma unroll
            for (int it = 0; it < 4; ++it)
#pragma unroll
                for (int ks = 0; ks < 2; ++ks) if (ks == 0 || it >= 2) {
                    const bf16x8 ba = *(const LAS bf16x8*)(lds + OFF_ATT + (16 * it + fr) * TS + (32 * ks + 8 * fq) * 2);
                    oacc[it] = MFMA16(vf[ks], ba, oacc[it]);
                }
        }
#pragma unroll
        for (int dt = 0; dt < NDT; ++dt)
#pragma unroll
            for (int ks = 0; ks < 2; ++ks) {
                const bf16x8 a = *(const LAS bf16x8*)(lds + OFF_KT + (16 * dt + fr) * TS + (32 * ks + 8 * fq) * 2);
                S[dt] = MFMA16(a, vf[ks], S[dt]);
            }
        if (PASS == 1) {
#pragma unroll
            for (int it = 0; it < 4; ++it) { u32x2 pk; pk.x = cvtpk(oacc[it][0], oacc[it][1]); pk.y = cvtpk(oacc[it][2], oacc[it][3]);
                *(u32x2*)(ds.o + ENG_ROW(ds.tau0 + 64 * c + 16 * it + fr) * ds.ors + 16 * w + 4 * fq) = pk; }
        }
    }
    if (PASS == 0) {
#pragma unroll
        for (int dt = 0; dt < NDT; ++dt) *(f32x4*)(ds.state + ((size_t)(w * NDT + dt) * 64 + l) * 4) = S[dt];
        if (g1 == 0) ds.lgam[d1] = lgsum;
    }
#undef ENG_ROW
#undef ENG_LOAD_RAW
}
template <int DK>
__device__ __forceinline__ void eng_scan(const float* sloc, float* sin, const float* lgam, int nseq, int gtid, int gthreads) {
    constexpr int NDT = DK / 16, PER_SEQ = 8 * NDT * 64;
    for (int i = gtid; i < nseq * PER_SEQ; i += gthreads) {
        const int seq = i / PER_SEQ, r = i % PER_SEQ, l = r & 63, dt = (r >> 6) % NDT;
        const int d = 16 * dt + 4 * (l >> 4);
        f32x4 cur = {0.f, 0.f, 0.f, 0.f};
        for (int sc = 0; sc < ENG_NSC; ++sc) {
            const size_t so = ((size_t)(seq * ENG_NSC + sc) * PER_SEQ + r) * 4;
            const f32x4 loc = *(const f32x4*)(sloc + so); const f32x4 lg = *(const f32x4*)(lgam + (size_t)(seq * ENG_NSC + sc) * DK + d);
            *(f32x4*)(sin + so) = cur;
            cur[0] = __expf(lg[0]) * cur[0] + loc[0]; cur[1] = __expf(lg[1]) * cur[1] + loc[1]; cur[2] = __expf(lg[2]) * cur[2] + loc[2]; cur[3] = __expf(lg[3]) * cur[3] + loc[3];
        }
    }
}

constexpr size_t WS_RO = WS_SCR;
constexpr size_t WS_ST = 216 * MiB;
constexpr size_t WS_SIN = 248 * MiB;
constexpr size_t WS_LG = 280 * MiB;

template <int PASS>
__device__ __forceinline__ void ph_ret_pass(const Params& p, int tid, LAS unsigned char* lds, int bid, int nb) {
    bf16_t* proj = (bf16_t*)(p.ws + WS_PROJ);
    for (int u = bid; u < 16 * ENG_NSC; u += nb) {
        const int seq = u / ENG_NSC, sc = u % ENG_NSC, dir = seq & 1, bh = seq >> 1, b = bh >> 2, h = bh & 3;
        EngDesc ds; ds.q = proj + h * 64; ds.kg = proj + 256 + h * 64; ds.v = proj + 512 + h * 128; ds.rs = EVEN_IN;
        ds.o = (bf16_t*)(p.ws + WS_RO) + (size_t)dir * T * 512 + h * 128; ds.ors = 512;
        ds.row0 = b * SEQ; ds.dir = dir; ds.tau0 = sc * ENG_L; ds.lg = log1pf(-exp2f(-5.f - (float)h));
        ds.state = (float*)(p.ws + (PASS ? WS_SIN : WS_ST)) + (size_t)u * (64 * 128); ds.lgam = (float*)(p.ws + WS_LG) + (size_t)u * 64;
        engine_unit<64, 0, PASS>(ds, lds, tid);
    }
}
template <int PASS>
__device__ __forceinline__ void ph_gla_pass(const Params& p, int tid, LAS unsigned char* lds, int bid, int nb) {
    bf16_t* proj = (bf16_t*)(p.ws + WS_PROJ);
    for (int u = bid; u < 32 * ENG_NSC; u += nb) {
        const int seq = u / ENG_NSC, sc = u % ENG_NSC, dir = seq & 1, bh = seq >> 1, b = bh >> 3, h = bh & 7;
        EngDesc ds; ds.q = proj + h * 128; ds.kg = proj + 2048 + dir * 1024 + h * 128; ds.v = proj + 1024 + h * 128; ds.rs = ODD_IN;
        ds.o = proj + 2048 + dir * 1024 + h * 128; ds.ors = ODD_IN;
        ds.row0 = b * SEQ; ds.dir = dir; ds.tau0 = sc * ENG_L; ds.lg = 0.f;
        ds.state = (float*)(p.ws + (PASS ? WS_SIN : WS_ST)) + (size_t)u * (128 * 128); ds.lgam = (float*)(p.ws + WS_LG) + (size_t)u * 128;
        engine_unit<128, 1, PASS>(ds, lds, tid);
    }
}
__device__ __forceinline__ void ph_ret_norm2(const Params& p, int tid, int bid, int nb) {
    const int lane = tid & 63;
    const bf16_t* Of = (const bf16_t*)(p.ws + WS_RO); const bf16_t* Ob = Of + (size_t)T * 512;
    const bf16_t* proj = (const bf16_t*)(p.ws + WS_PROJ); bf16_t* mix = (bf16_t*)(p.ws + WS_HB);
    for (int gwv = bid * 8 + (tid >> 6); gwv < T * 4; gwv += nb * 8) {
        const int row = gwv >> 2, h = gwv & 3;
        const bf16_t* pr = proj + (size_t)row * EVEN_IN;
        const float qk = wave_sum(bf2f(pr[h * 64 + lane]) * bf2f(pr[256 + h * 64 + lane]));
        const size_t o = (size_t)row * 512 + h * 128 + 2 * lane;
        const unsigned uf = *(const unsigned*)(Of + o), ub = *(const unsigned*)(Ob + o), uv = *(const unsigned*)(pr + 512 + h * 128 + 2 * lane);
        const float a0 = bflo(uf) + bflo(ub) - qk * bflo(uv), a1 = bfhi(uf) + bfhi(ub) - qk * bfhi(uv);
        const float mean = wave_sum(a0 + a1) * (1.f / 128.f); const float d0 = a0 - mean, d1 = a1 - mean;
        const float rstd = 1.f / sqrtf(wave_sum(d0 * d0 + d1 * d1) * (1.f / 128.f) + LN_EPS);
        const unsigned gg = *(const unsigned*)(pr + 1024 + h * 128 + 2 * lane);
        *(unsigned*)(mix + (size_t)row * D + h * 128 + 2 * lane) = pk2(d0 * rstd * silu(bflo(gg)), d1 * rstd * silu(bfhi(gg)));
    }
}

__device__ __forceinline__ Params load_params() {
    typedef const float* cfp;
    const volatile __attribute__((address_space(4))) cfp* kp = (const volatile __attribute__((address_space(4))) cfp*)__builtin_amdgcn_kernarg_segment_ptr();
    Params q;
    q.x = kp[0]; q.w_in_even = kp[1]; q.w_out_even = kp[2]; q.conv_w = kp[3]; q.conv_b = kp[4]; q.gate_w = kp[5]; q.gate_b = kp[6]; q.lam = kp[7];
    q.w_in_odd = kp[8]; q.w_out_odd = kp[9]; q.lower_bounds = kp[10]; q.norm_w = kp[11]; q.ln_w = kp[12]; q.ln_b = kp[13]; q.router_w = kp[14];
    q.moe_gate = kp[15]; q.moe_up = kp[16]; q.moe_down = kp[17]; q.out = (float*)kp[18]; q.ws = (unsigned char*)kp[19];
    return q;
}
#define PH_BEGIN { const Params p = load_params(); int tid_ = threadIdx.x; asm volatile("" : "+v"(tid_)); int bid = blockIdx.x, nb = gridDim.x; asm volatile("" : "+s"(bid), "+s"(nb)); \
    const int wave = __builtin_amdgcn_readfirstlane(tid_ >> 6), lane = tid_ & 63; LAS float* scrw = (LAS float*)(lds + wave * 16384); const int gw = bid * 8 + wave, ngw = nb * 8; \
    (void)lane; (void)scrw; (void)gw; (void)ngw;
#define PH_END }
#define GRID_BAR() { XcdBarrier b_; b_.bar = (unsigned*)(load_params().ws + WS_CTL) + CW_BAR; b_.x = xb_xcc_id(); b_.st = MISC + 8; xcd_barrier(b_); }
__global__ void __launch_bounds__(512, 2) mega_fwd(Params p_unused) {
    extern __shared__ __attribute__((aligned(16))) unsigned char shm[];
    PG8_LAS unsigned char* lds = (PG8_LAS unsigned char*)shm;
    volatile LAS unsigned* MISC = (volatile LAS unsigned*)(lds + MISC_OFF);
    for (int u = threadIdx.x; u < (LDS_BYTES - STAGE_LDS) / 4; u += 512) ((LAS unsigned*)(lds + STAGE_LDS))[u] = 0u;
    __syncthreads();
    (void)xcd_barrier_post((unsigned*)(load_params().ws + WS_CTL) + CW_BAR, MISC + 8);

    PH_BEGIN prologue_static(p, scrw, gw, ngw, lane); PH_END
    GRID_BAR();
    PH_BEGIN ph_inproj0(p, lds, bid, nb); PH_END
    GRID_BAR();
    PH_BEGIN ph_ret_pass<0>(p, tid_, lds, bid, nb); PH_END
    GRID_BAR();
    PH_BEGIN eng_scan<64>((const float*)(p.ws + WS_ST), (float*)(p.ws + WS_SIN), (const float*)(p.ws + WS_LG), 16, bid * 512 + tid_, nb * 512); PH_END
    GRID_BAR();
    PH_BEGIN ph_ret_pass<1>(p, tid_, lds, bid, nb); PH_END
    GRID_BAR();
    PH_BEGIN ph_ret_norm2(p, tid_, bid, nb); PH_END
    GRID_BAR();
    PH_BEGIN ph_lru_ab(p, tid_, (LAS float*)lds, bid, nb); PH_END
    GRID_BAR();
    PH_BEGIN ph_lru_scan(p, tid_, bid); PH_END
    GRID_BAR();
    PH_BEGIN ph_lru_out(p, tid_, bid, nb); PH_END
    GRID_BAR();
    PH_BEGIN ph_outproj(p, 0, lds, bid, nb); PH_END
    GRID_BAR();
    PH_BEGIN prologue_moe(p, 0, scrw, gw, ngw, lane); ph_ln_router(p, tid_, 0, (LAS int*)lds, bid, nb); PH_END
    GRID_BAR();
    PH_BEGIN ph_slots(p, tid_, 0, (LAS int*)lds, bid, nb); PH_END
    GRID_BAR();
    PH_BEGIN ph_moe_gateup(p, 0, lds, bid, nb); PH_END
    GRID_BAR();
    PH_BEGIN ph_moe_down(p, 0, lds, bid, nb); PH_END
    GRID_BAR();
    PH_BEGIN ph_combine_ln(p, tid_, 0, bid, nb); PH_END
    GRID_BAR();
    PH_BEGIN ph_inproj1(p, lds, bid, nb); PH_END
    GRID_BAR();
    PH_BEGIN ph_gla_pass<0>(p, tid_, lds, bid, nb); PH_END
    GRID_BAR();
    PH_BEGIN eng_scan<128>((const float*)(p.ws + WS_ST), (float*)(p.ws + WS_SIN), (const float*)(p.ws + WS_LG), 32, bid * 512 + tid_, nb * 512); PH_END
    GRID_BAR();
    PH_BEGIN ph_gla_pass<1>(p, tid_, lds, bid, nb); PH_END
    GRID_BAR();
    PH_BEGIN ph_hg_norm(p, tid_, bid, nb); PH_END
    GRID_BAR();
    PH_BEGIN ph_outproj(p, 1, lds, bid, nb); PH_END
    GRID_BAR();
    PH_BEGIN prologue_moe(p, 1, scrw, gw, ngw, lane); ph_ln_router(p, tid_, 1, (LAS int*)lds, bid, nb); PH_END
    GRID_BAR();
    PH_BEGIN ph_slots(p, tid_, 1, (LAS int*)lds, bid, nb); PH_END
    GRID_BAR();
    PH_BEGIN ph_moe_gateup(p, 1, lds, bid, nb); PH_END
    GRID_BAR();
    PH_BEGIN ph_moe_down(p, 1, lds, bid, nb); PH_END
    GRID_BAR();
    PH_BEGIN ph_combine_ln(p, tid_, 1, bid, nb); PH_END
}

extern "C" void kernel_launch(void* const* d_in, const int* in_sizes, int n_in, void* d_out, int out_size, void* d_ws, size_t ws_size, hipStream_t stream) {
    static int grid = 0;
    if (grid == 0) {
        if (n_in != 18 || in_sizes[0] != T * D || out_size != T * D || ws_size < WS_END) { fprintf(stderr, "kernel_launch: unexpected shapes (n_in %d, in0 %d, out %d, ws %zu)\n", n_in, n_in > 0 ? in_sizes[0] : -1, out_size, ws_size); grid = -1; return; }
        int dev = 0, cus = 0, per_cu = 0;
        if (hipGetDevice(&dev) != hipSuccess || hipDeviceGetAttribute(&cus, hipDeviceAttributeMultiprocessorCount, dev) != hipSuccess) { grid = -1; return; }
        if (hipFuncSetAttribute((const void*)mega_fwd, hipFuncAttributeMaxDynamicSharedMemorySize, LDS_BYTES) != hipSuccess) { fprintf(stderr, "kernel_launch: hipFuncSetAttribute failed\n"); grid = -1; return; }
        if (hipOccupancyMaxActiveBlocksPerMultiprocessor(&per_cu, (const void*)mega_fwd, 512, LDS_BYTES) != hipSuccess || per_cu < 1) { fprintf(stderr, "kernel_launch: occupancy query says %d workgroups per CU\n", per_cu); }
        (void)hipGetLastError();
        grid = cus > 0 ? cus : 256;
    }
    if (grid < 0) return;
    Params p{};
    p.x = (const float*)d_in[0]; p.w_in_even = (const float*)d_in[1]; p.w_out_even = (const float*)d_in[2]; p.conv_w = (const float*)d_in[3]; p.conv_b = (const float*)d_in[4];
    p.gate_w = (const float*)d_in[5]; p.gate_b = (const float*)d_in[6]; p.lam = (const float*)d_in[7]; p.w_in_odd = (const float*)d_in[8]; p.w_out_odd = (const float*)d_in[9];
    p.lower_bounds = (const float*)d_in[10]; p.norm_w = (const float*)d_in[11]; p.ln_w = (const float*)d_in[12]; p.ln_b = (const float*)d_in[13]; p.router_w = (const float*)d_in[14];
    p.moe_gate = (const float*)d_in[15]; p.moe_up = (const float*)d_in[16]; p.moe_down = (const float*)d_in[17];
    p.out = (float*)d_out; p.ws = (unsigned char*)d_ws;
    if (hipMemsetAsync((char*)d_ws + WS_CTL, 0, CTL_BYTES, stream) != hipSuccess) return;
    hipLaunchKernelGGL(mega_fwd, dim3(grid), dim3(512), LDS_BYTES, stream, p);
}
```

```cpp
#include <hip/hip_runtime.h>
#include <cstdio>
#include <cstdint>

namespace pg8 {
#define PG8_LAS __attribute__((address_space(3)))
typedef unsigned short bf16_t;
typedef short bf16x8 __attribute__((ext_vector_type(8)));
typedef float f32x4 __attribute__((ext_vector_type(4)));
typedef unsigned u32x4 __attribute__((ext_vector_type(4)));
constexpr int BM = 256, BK = 64, HALF = 128, HTB = HALF * BK * 2  , STAGE_BYTES = 8 * HTB, NXCD = 8, WGM = 8;

__host__ __device__ __forceinline__ int lds_byte(int r, int c) { const int st = (r >> 4) * 2 + (c >> 5), rr = r & 15, cc = c & 31, ob = rr * 64 + cc * 2; return st * 1024 + (ob ^ (((ob >> 9) & 1) << 5)); }
__host__ __device__ __forceinline__ void stage_rc(int b, int& R, int& C) { const int st = b / 1024, sb = b % 1024, swz = sb ^ (((sb >> 9) & 1) << 5); R = (st >> 1) * 16 + swz / 64; C = (st & 1) * 32 + (swz % 64) / 2; }
__host__ __device__ __forceinline__ int perm32(int rho) { const int n = rho >> 4, i = rho & 15; return 8 * (i >> 2) + 4 * n + (i & 3); }

struct Unit { int pm, pn, brow; };
struct Gemm { const bf16_t* A; const bf16_t* Bt; int M, N, K; };

struct StaticOrder {
    int nM, nN, nwg, G, c;
    __host__ __device__ void init(int M, int N, int K, int G_, int c_) { nM = M / BM; nN = N / BM; nwg = nM * nN; G = G_; c = c_; }
    __host__ __device__ bool next(int i, Unit& u) const {
        const long L = (long)i * G + c; if (L >= nwg) return false;
        int wgid = (int)L; { const int q = nwg / NXCD, r = nwg % NXCD, xcd = wgid % NXCD, off = wgid / NXCD; wgid = (xcd < r ? xcd * (q + 1) : r * (q + 1) + (xcd - r) * q) + off; }
        const int nig = WGM * nN, gid = wgid / nig, fm = gid * WGM, gsz = (nM - fm) < WGM ? (nM - fm) : WGM;
        u.pm = fm + ((wgid % nig) % gsz); u.pn = (wgid % nig) / gsz; u.brow = u.pn; return true;
    }
    __device__ __forceinline__ void a_ready(const Unit&) const {}
    __device__ __forceinline__ void done(const Unit&) const {}
};
struct GroupedOrder {
    const int* tile_e; int ntiles, nN, G, c;
    __device__ bool next(int i, Unit& u) const {
        const int L = i * G + c; if (L >= ntiles * nN) return false;
        u.pm = L / nN; u.pn = L % nN;
        u.brow = __builtin_amdgcn_readfirstlane(tile_e[u.pm]) * nN + u.pn; return true;
    }
    __device__ __forceinline__ void a_ready(const Unit&) const {}
    __device__ __forceinline__ void done(const Unit&) const {}
};

__device__ __forceinline__ unsigned cvt_pk_bf16(float lo, float hi) { unsigned r; asm volatile("v_cvt_pk_bf16_f32 %0, %1, %2" : "=v"(r) : "v"(lo), "v"(hi)); return r; }

template <class Epi, class Sched, bool ALIGN_EPI = false, bool SP2 = false>
__device__ __forceinline__ void gemm_phase(PG8_LAS unsigned char* lds, const Gemm g, const Sched& S, const Epi& E) {
    int tid_ = threadIdx.x; asm volatile("" : "+v"(tid_));
    const int tid = tid_, wid = __builtin_amdgcn_readfirstlane(tid >> 6), lane = tid & 63, wr = wid >> 2, wc = wid & 3, fr = lane & 15, fq = lane >> 4;
    const int K = g.K, nt = K / BK;
    unsigned voffA[2], voffB[2];
#pragma unroll
    for (int i = 0; i < 2; ++i) { int R, C; stage_rc(tid * 16 + i * 8192, R, C); const int Rb = Epi::PERM ? ((R & ~31) + perm32(R & 31)) : R;
        voffA[i] = (unsigned)(R * K + C) * 2u; voffB[i] = (unsigned)(Rb * K + C) * 2u; }
    const size_t kstep = (size_t)(BK * 2);
    const size_t hstep = (size_t)HALF * K * 2;
    const unsigned ldsw = (unsigned)wid * 1024u;
    const int aoff = lds_byte(wr * 64 + fr, fq * 8), boff = lds_byte(wc * 32 + fr, fq * 8);
#define PG8_SA(b, h) (((b) * 2 + (h)) * HTB)
#define PG8_SB(b, h) ((4 + (b) * 2 + (h)) * HTB)
#define PG8_STAGE(bufoff, gbase, voff) do { _Pragma("unroll") for (int _i = 0; _i < 2; ++_i) \
        __builtin_amdgcn_global_load_lds((const unsigned*)((const char*)(gbase) + (voff)[_i]), (PG8_LAS unsigned*)(lds + (bufoff) + ldsw + _i * 8192), 16, 0, 0); } while (0)
#define PG8_LDA(dst, b, h) do { _Pragma("unroll") for (int m = 0; m < 4; ++m) _Pragma("unroll") for (int k = 0; k < 2; ++k) dst[m][k] = *(const PG8_LAS bf16x8*)(lds + PG8_SA(b, h) + aoff + m * 2048 + k * 1024); } while (0)
#define PG8_LDB(dst, b, h) do { _Pragma("unroll") for (int n = 0; n < 2; ++n) _Pragma("unroll") for (int k = 0; k < 2; ++k) dst[n][k] = *(const PG8_LAS bf16x8*)(lds + PG8_SB(b, h) + boff + n * 2048 + k * 1024); } while (0)
#define PG8_MMA(ai, bj, At, Bt) do { __builtin_amdgcn_s_setprio(1); _Pragma("unroll") for (int m = 0; m < 4; ++m) _Pragma("unroll") for (int n = 0; n < 2; ++n) _Pragma("unroll") for (int k = 0; k < 2; ++k) \
        acc[ai][bj][m][n] = __builtin_amdgcn_mfma_f32_16x16x32_bf16(Bt[n][k], At[m][k], acc[ai][bj][m][n], 0, 0, 0); __builtin_amdgcn_s_setprio(0); } while (0)
#define PG8_WAIT_V(n) asm volatile("s_waitcnt vmcnt(" #n ")" ::: "memory")
#define PG8_WAIT_L(n) asm volatile("s_waitcnt lgkmcnt(" #n ")" ::: "memory")
#define PG8_BAR __builtin_amdgcn_s_barrier()
#define PG8_SCHED __builtin_amdgcn_sched_barrier(0)
    Unit cur, nxt; int ui = 0;
    if (!S.next(0, cur)) return;
    f32x4 acc[2][2][4][2];
#pragma unroll
    for (int a = 0; a < 2; ++a)
#pragma unroll
        for (int b = 0; b < 2; ++b)
#pragma unroll
            for (int m = 0; m < 4; ++m)
#pragma unroll
                for (int n = 0; n < 2; ++n) acc[a][b][m][n] = (f32x4){0.f, 0.f, 0.f, 0.f};
    bf16x8 At[4][2], B0[2][2], B1[2][2];
    const size_t tstep = 2 * hstep;
    const char* cA = (const char*)g.A + (size_t)cur.pm * tstep; const char* cB = (const char*)g.Bt + (size_t)cur.brow * tstep;
    S.a_ready(cur);
    if constexpr (SP2) {
        PG8_STAGE(PG8_SB(0, 0), cB, voffB); PG8_STAGE(PG8_SB(0, 1), cB + hstep, voffB); PG8_STAGE(PG8_SA(0, 0), cA, voffA); PG8_STAGE(PG8_SA(0, 1), cA + hstep, voffA);
        if (wr == 1) PG8_BAR;
        PG8_WAIT_V(2); PG8_BAR;
        PG8_STAGE(PG8_SB(1, 0), cB + kstep, voffB); PG8_STAGE(PG8_SA(1, 0), cA + kstep, voffA); PG8_STAGE(PG8_SB(1, 1), cB + hstep + kstep, voffB);
        PG8_WAIT_V(6); PG8_BAR;
    } else {
        PG8_STAGE(PG8_SB(0, 0), cB, voffB); PG8_STAGE(PG8_SA(0, 0), cA, voffA); PG8_STAGE(PG8_SB(0, 1), cB + hstep, voffB); PG8_STAGE(PG8_SA(0, 1), cA + hstep, voffA);
        if (wr == 1) PG8_BAR;
        PG8_WAIT_V(4); PG8_BAR;
        PG8_STAGE(PG8_SB(1, 0), cB + kstep, voffB); PG8_STAGE(PG8_SA(1, 0), cA + kstep, voffA); PG8_STAGE(PG8_SB(1, 1), cB + hstep + kstep, voffB);
        PG8_WAIT_V(6); PG8_BAR;
    }
    for (;;) {
        const bool has_next = S.next(ui + 1, nxt);
        const char* nA = has_next ? (const char*)g.A + (size_t)nxt.pm * tstep : cA; const char* nB = has_next ? (const char*)g.Bt + (size_t)nxt.brow * tstep : cB;
        for (int t = 0; t < nt; t += 2) {
            const bool last = (t == nt - 2);
            const char* a1 = cA + (size_t)(t + 1) * kstep;
            const char* a2 = last ? nA : cA + (size_t)(t + 2) * kstep; const char* b2 = last ? nB : cB + (size_t)(t + 2) * kstep;
            const char* a3 = a2 + kstep; const char* b3 = b2 + kstep;
            if (last && has_next) S.a_ready(nxt);
            if constexpr (SP2) {
            PG8_LDB(B0, 0, 0); PG8_LDB(B1, 0, 1); PG8_SCHED; PG8_LDA(At, 0, 0); PG8_STAGE(PG8_SA(1, 1), a1 + hstep, voffA);
            PG8_WAIT_V(8); PG8_WAIT_L(0); PG8_BAR; PG8_MMA(0, 0, At, B0); PG8_MMA(0, 1, At, B1); PG8_BAR; PG8_SCHED;
            PG8_LDA(At, 0, 1); PG8_STAGE(PG8_SB(0, 0), b2, voffB); PG8_STAGE(PG8_SB(0, 1), b2 + hstep, voffB); PG8_STAGE(PG8_SA(0, 0), a2, voffA);
            PG8_WAIT_V(8); PG8_WAIT_L(0); PG8_BAR; PG8_MMA(1, 0, At, B0); PG8_MMA(1, 1, At, B1); PG8_BAR; PG8_SCHED;
            PG8_LDB(B0, 1, 0); PG8_LDB(B1, 1, 1); PG8_SCHED; PG8_LDA(At, 1, 0); PG8_STAGE(PG8_SA(0, 1), a2 + hstep, voffA);
            PG8_WAIT_V(8); PG8_WAIT_L(0); PG8_BAR; PG8_MMA(0, 0, At, B0); PG8_MMA(0, 1, At, B1); PG8_BAR; PG8_SCHED;
            PG8_LDA(At, 1, 1); PG8_STAGE(PG8_SB(1, 0), b3, voffB); PG8_STAGE(PG8_SB(1, 1), b3 + hstep, voffB); PG8_STAGE(PG8_SA(1, 0), a3, voffA);
            PG8_WAIT_V(8); PG8_WAIT_L(0); PG8_BAR; PG8_MMA(1, 0, At, B0); PG8_MMA(1, 1, At, B1); PG8_BAR; PG8_SCHED;
            } else {
            PG8_LDB(B0, 0, 0); PG8_SCHED; PG8_LDA(At, 0, 0); PG8_STAGE(PG8_SA(1, 1), a1 + hstep, voffA);
            PG8_WAIT_L(8); PG8_BAR; PG8_WAIT_L(0); PG8_MMA(0, 0, At, B0); PG8_BAR; PG8_SCHED;
            PG8_LDB(B1, 0, 1); PG8_STAGE(PG8_SB(0, 0), b2, voffB);
            PG8_BAR; PG8_WAIT_L(0); PG8_MMA(0, 1, At, B1); PG8_BAR;
            PG8_LDA(At, 0, 1); PG8_STAGE(PG8_SA(0, 0), a2, voffA);
            PG8_BAR; PG8_WAIT_L(0); PG8_MMA(1, 0, At, B0); PG8_BAR; PG8_SCHED;
            PG8_STAGE(PG8_SB(0, 1), b2 + hstep, voffB);
            PG8_WAIT_V(6); PG8_BAR; PG8_MMA(1, 1, At, B1); PG8_BAR;
            PG8_LDB(B0, 1, 0); PG8_SCHED; PG8_LDA(At, 1, 0); PG8_STAGE(PG8_SA(0, 1), a2 + hstep, voffA);
            PG8_WAIT_L(8); PG8_BAR; PG8_WAIT_L(0); PG8_MMA(0, 0, At, B0); PG8_BAR; PG8_SCHED;
            PG8_LDB(B1, 1, 1); PG8_STAGE(PG8_SB(1, 0), b3, voffB);
            PG8_BAR; PG8_WAIT_L(0); PG8_MMA(0, 1, At, B1); PG8_BAR;
            PG8_LDA(At, 1, 1); PG8_STAGE(PG8_SA(1, 0), a3, voffA);
            PG8_BAR; PG8_WAIT_L(0); PG8_MMA(1, 0, At, B0); PG8_BAR; PG8_SCHED;
            PG8_STAGE(PG8_SB(1, 1), b3 + hstep, voffB);
            PG8_WAIT_V(6); PG8_BAR; PG8_MMA(1, 1, At, B1); PG8_BAR;
            }
        }
        if constexpr (ALIGN_EPI) { if (wr == 0) PG8_BAR; }
        if constexpr (!Epi::AFTER_DRAIN) { E(acc, cur, wr, wc, fr, fq); S.done(cur); }
        if (!has_next) break;
#pragma unroll
        for (int a = 0; a < 2; ++a)
#pragma unroll
            for (int b = 0; b < 2; ++b)
#pragma unroll
                for (int m = 0; m < 4; ++m)
#pragma unroll
                    for (int n = 0; n < 2; ++n) acc[a][b][m][n] = (f32x4){0.f, 0.f, 0.f, 0.f};
        cur = nxt; cA = nA; cB = nB; ++ui;
        if constexpr (ALIGN_EPI) { if (wr == 1) PG8_BAR; }
    }
    PG8_WAIT_V(0);
    if constexpr (!ALIGN_EPI) { if (wr == 0) PG8_BAR; }
    PG8_BAR;
    if constexpr (Epi::AFTER_DRAIN) { E.fused(acc, cur, wr, wc, fr, fq, lds, wid, lane); S.done(cur); }
#undef PG8_SA
#undef PG8_SB
#undef PG8_STAGE
#undef PG8_LDA
#undef PG8_LDB
#undef PG8_MMA
#undef PG8_WAIT_V
#undef PG8_WAIT_L
#undef PG8_BAR
#undef PG8_SCHED
}
}

using pg8::bf16_t; using pg8::bf16x8; using pg8::f32x4; using pg8::u32x4; using pg8::Unit;
typedef float f32x2 __attribute__((ext_vector_type(2)));
typedef unsigned u32x2 __attribute__((ext_vector_type(2)));
#define LAS __attribute__((address_space(3)))

constexpr int NB = 2, SEQ = 8192, T = NB * SEQ, D = 1024;
constexpr int EVEN_IN = 2560, ODD_IN = 5120;
constexpr int NEXP = 16, DEXP = 512;
constexpr int PMAX = 36864;
constexpr int MAXTILES = PMAX / 256;
constexpr float DN_ALPHA = 1.41421356237f;
constexpr float LN_EPS = 1e-5f, RMS_EPS = 1e-6f;

constexpr size_t MiB = 1u << 20;
constexpr size_t WS_CTL = 0, CTL_BYTES = 1 * MiB;
constexpr size_t WS_ROPE = 1 * MiB;
constexpr size_t WS_LBV = 3 * MiB;
constexpr size_t WS_WINE = 4 * MiB;
constexpr size_t WS_WOUTE = 9 * MiB;
constexpr size_t WS_WINO = 11 * MiB;
constexpr size_t WS_WOUTO = 21 * MiB;
constexpr size_t WS_LGT = 23 * MiB;
constexpr size_t WS_HB = 24 * MiB;
constexpr size_t WS_PROJ = 56 * MiB;
constexpr size_t WS_XS = WS_PROJ;
constexpr size_t WS_HID = WS_PROJ + 72 * MiB;
constexpr size_t WS_SCR = WS_PROJ + 80 * MiB;
constexpr size_t WS_WGU = 216 * MiB;
constexpr size_t WS_WD = 248 * MiB;
constexpr size_t WS_TOK = 3 * MiB + 65536;
constexpr size_t WS_END = 282 * MiB;
constexpr int CW_COUNTS = 1024;
constexpr int CW_CURSOR = 1024 + 64;
constexpr int CW_NTILES = 1024 + 128;
constexpr int CW_TILEE = 2048;
constexpr size_t TOK_E = 0, TOK_G = 128 * 1024, TOK_SLOT = 256 * 1024, TOK_BH = 384 * 1024;

struct Params {
    const float* x; const float* w_in_even; const float* w_out_even; const float* conv_w; const float* conv_b; const float* gate_w; const float* gate_b; const float* lam;
    const float* w_in_odd; const float* w_out_odd; const float* lower_bounds; const float* norm_w; const float* ln_w; const float* ln_b; const float* router_w;
    const float* moe_gate; const float* moe_up; const float* moe_down;
    float* out; unsigned char* ws;
};

__device__ __forceinline__ float bf2f(unsigned b) { return __uint_as_float(b << 16); }
__device__ __forceinline__ float bflo(unsigned u) { return __uint_as_float(u << 16); }
__device__ __forceinline__ float bfhi(unsigned u) { return __uint_as_float(u & 0xffff0000u); }
__device__ __forceinline__ unsigned f2bf(float f) { unsigned u = __float_as_uint(f); return (u + 0x7fffu + ((u >> 16) & 1u)) >> 16; }
__device__ __forceinline__ unsigned pk2(float lo, float hi) { return f2bf(lo) | (f2bf(hi) << 16); }
__device__ __forceinline__ float sigm(float x) { return 1.f / (1.f + __expf(-x)); }
__device__ __forceinline__ float silu(float x) { return x / (1.f + __expf(-x)); }
__device__ __forceinline__ float gelu_tanh(float x) { const float u = 0.7978845608028654f * (x + 0.044715f * x * x * x); return x / (1.f + __expf(-2.f * u)); }
__device__ __forceinline__ float wave_sum(float v) {
#pragma unroll
    for (int o = 1; o < 64; o <<= 1) v += __shfl_xor(v, o);
    return v;
}
#define LDS_WAIT() asm volatile("s_waitcnt lgkmcnt(0)" ::: "memory")
typedef __bf16 bf16x2_t __attribute__((ext_vector_type(2)));
__device__ __forceinline__ unsigned cvtpk(float lo, float hi) { const f32x2 v = {lo, hi}; const bf16x2_t b = __builtin_convertvector(v, bf16x2_t); return __builtin_bit_cast(unsigned, b); }

__device__ __forceinline__ void store8bf(bf16_t* p, const f32x4& v0, const f32x4& v1) {
    u32x4 w; w.x = cvtpk(v0[0], v0[1]); w.y = cvtpk(v0[2], v0[3]); w.z = cvtpk(v1[0], v1[1]); w.w = cvtpk(v1[2], v1[3]);
    *(u32x4*)p = w;
}
struct EpiInproj0 {
    static constexpr bool PERM = true, AFTER_DRAIN = false;
    bf16_t* O; const float* rope;
    __device__ __forceinline__ void operator()(const f32x4 (&acc)[2][2][4][2], const Unit& u, int wr, int wc, int fr, int fq) const {
        const int row0 = u.pm * 256 + wr * 64 + fr, colt = u.pn * 256 + wc * 32 + 8 * fq;
#pragma unroll
        for (int ai = 0; ai < 2; ++ai)
#pragma unroll
            for (int m = 0; m < 4; ++m) {
                const int row = row0 + ai * 128 + m * 16; const int pos = row & (SEQ - 1);
#pragma unroll
                for (int bj = 0; bj < 2; ++bj) {
                    const int col = colt + bj * 128;
                    f32x4 v0 = acc[ai][bj][m][0], v1 = acc[ai][bj][m][1];
                    if (u.pn < 2) {
                        const float sc = (col < 256) ? 0.125f : 1.0f;
                        const f32x4* rp = (const f32x4*)(rope + ((size_t)pos * 32 + ((col & 63) >> 1)) * 2);
                        const f32x4 c0 = rp[0], c1 = rp[1];
                        f32x4 r0, r1;
                        r0[0] = (v0[0] * c0[0] - v0[1] * c0[1]) * sc; r0[1] = (v0[0] * c0[1] + v0[1] * c0[0]) * sc;
                        r0[2] = (v0[2] * c0[2] - v0[3] * c0[3]) * sc; r0[3] = (v0[2] * c0[3] + v0[3] * c0[2]) * sc;
                        r1[0] = (v1[0] * c1[0] - v1[1] * c1[1]) * sc; r1[1] = (v1[0] * c1[1] + v1[1] * c1[0]) * sc;
                        r1[2] = (v1[2] * c1[2] - v1[3] * c1[3]) * sc; r1[3] = (v1[2] * c1[3] + v1[3] * c1[2]) * sc;
                        v0 = r0; v1 = r1;
                    }
                    store8bf(O + (size_t)row * EVEN_IN + col, v0, v1);
                }
            }
    }
};
struct EpiInproj1 {
    static constexpr bool PERM = true, AFTER_DRAIN = false;
    bf16_t* O; const float* lbv;
    __device__ __forceinline__ void operator()(const f32x4 (&acc)[2][2][4][2], const Unit& u, int wr, int wc, int fr, int fq) const {
        const int row0 = u.pm * 256 + wr * 64 + fr, colt = u.pn * 256 + wc * 32 + 8 * fq;
        const int seg = u.pn >> 2;
#pragma unroll
        for (int bj = 0; bj < 2; ++bj) {
            const int col = colt + bj * 128;
            f32x4 lb0 = {0.f, 0.f, 0.f, 0.f}, lb1 = {0.f, 0.f, 0.f, 0.f};
            if (seg == 2 || seg == 3) { lb0 = *(const f32x4*)(lbv + (col & 1023)); lb1 = *(const f32x4*)(lbv + (col & 1023) + 4); }
#pragma unroll
            for (int ai = 0; ai < 2; ++ai)
#pragma unroll
                for (int m = 0; m < 4; ++m) {
                    const int row = row0 + ai * 128 + m * 16;
                    f32x4 v0 = acc[ai][bj][m][0], v1 = acc[ai][bj][m][1];
                    if (seg == 0) {
#pragma unroll
                        for (int j = 0; j < 4; ++j) { v0[j] = silu(v0[j]) * 0.08838834764831845f; v1[j] = silu(v1[j]) * 0.08838834764831845f; }
                    } else if (seg == 2 || seg == 3) {
#pragma unroll
                        for (int j = 0; j < 4; ++j) { v0[j] = __logf(lb0[j] + (1.f - lb0[j]) * sigm(v0[j])); v1[j] = __logf(lb1[j] + (1.f - lb1[j]) * sigm(v1[j])); }
                    }
                    store8bf(O + (size_t)row * ODD_IN + col, v0, v1);
                }
        }
    }
};
struct EpiResid {
    static constexpr bool PERM = false, AFTER_DRAIN = false;
    const float* res; float* out;
    __device__ __forceinline__ void operator()(const f32x4 (&acc)[2][2][4][2], const Unit& u, int wr, int wc, int fr, int fq) const {
        const int row0 = u.pm * 256 + wr * 64 + fr, col0 = u.pn * 256 + wc * 32 + 4 * fq;
#pragma unroll
        for (int ai = 0; ai < 2; ++ai)
#pragma unroll
            for (int m = 0; m < 4; ++m) {
                const size_t off = (size_t)(row0 + ai * 128 + m * 16) * D + col0;
#pragma unroll
                for (int bj = 0; bj < 2; ++bj)
#pragma unroll
                    for (int n = 0; n < 2; ++n) { const f32x4 r = *(const f32x4*)(res + off + bj * 128 + n * 16); *(f32x4*)(out + off + bj * 128 + n * 16) = r * DN_ALPHA + acc[ai][bj][m][n]; }
            }
    }
};
struct EpiGateUp {
    static constexpr bool PERM = true, AFTER_DRAIN = false;
    bf16_t* O;
    __device__ __forceinline__ void operator()(const f32x4 (&acc)[2][2][4][2], const Unit& u, int wr, int wc, int fr, int fq) const {
        const int row0 = u.pm * 256 + wr * 64 + fr, col = u.pn * 128 + wc * 32 + 8 * fq;
#pragma unroll
        for (int ai = 0; ai < 2; ++ai)
#pragma unroll
            for (int m = 0; m < 4; ++m) {
                const int row = row0 + ai * 128 + m * 16;
                f32x4 v0, v1;
#pragma unroll
                for (int j = 0; j < 4; ++j) { v0[j] = silu(acc[ai][0][m][0][j]) * acc[ai][1][m][0][j]; v1[j] = silu(acc[ai][0][m][1][j]) * acc[ai][1][m][1][j]; }
                store8bf(O + (size_t)row * DEXP + col, v0, v1);
            }
    }
};
struct EpiBf16 {
    static constexpr bool PERM = true, AFTER_DRAIN = false;
    bf16_t* O; int ldc;
    __device__ __forceinline__ void operator()(const f32x4 (&acc)[2][2][4][2], const Unit& u, int wr, int wc, int fr, int fq) const {
        const int row0 = u.pm * 256 + wr * 64 + fr, colt = u.pn * 256 + wc * 32 + 8 * fq;
#pragma unroll
        for (int ai = 0; ai < 2; ++ai)
#pragma unroll
            for (int m = 0; m < 4; ++m) {
                const int row = row0 + ai * 128 + m * 16;
#pragma unroll
                for (int bj = 0; bj < 2; ++bj) store8bf(O + (size_t)row * ldc + colt + bj * 128, acc[ai][bj][m][0], acc[ai][bj][m][1]);
            }
    }
};

__device__ __forceinline__ void transpose_item(const float* W, int N, bf16_t* WT, int K, int k0, int n0, int drow0, LAS float* scr, int lane) {
#pragma unroll 8
    for (int i = 0; i < 32; ++i) { const int kk = 2 * i + (lane >> 5); scr[kk * 33 + (lane & 31)] = W[(size_t)(k0 + kk) * N + n0 + (lane & 31)]; }
    LDS_WAIT();
    const int c = lane & 7;
#pragma unroll
    for (int j = 0; j < 4; ++j) { const int n = (lane >> 3) + 8 * j; const LAS float* s = scr + (8 * c) * 33 + n;
        u32x4 o; o.x = pk2(s[0 * 33], s[1 * 33]); o.y = pk2(s[2 * 33], s[3 * 33]); o.z = pk2(s[4 * 33], s[5 * 33]); o.w = pk2(s[6 * 33], s[7 * 33]);
        *(u32x4*)(WT + (size_t)(drow0 + n) * K + k0 + 8 * c) = o; }
    LDS_WAIT();
}
__device__ __forceinline__ void transpose_dense(const float* W, int K, int N, bf16_t* WT, int item, LAS float* scr, int lane) {
    const int nblk = N / 32, kb = item / nblk, nb = item % nblk;
    transpose_item(W, N, WT, K, 64 * kb, 32 * nb, 32 * nb, scr, lane);
}
__device__ __forceinline__ void prologue_static(const Params& p, LAS float* scr, int gw, int ngw, int lane) {
    unsigned char* ws = p.ws;
    constexpr int I_WINE = 16 * 80, I_WOUTE = 16 * 32, I_WINO = 16 * 160, I_WOUTO = 16 * 32, I_LG = 16 * 8;
    constexpr int NITEMS = I_WINE + I_WOUTE + I_WINO + I_WOUTO + I_LG;
    for (int it = gw; it < NITEMS; it += ngw) {
        int r = it;
        if (r < I_WINE) { transpose_dense(p.w_in_even, 1024, EVEN_IN, (bf16_t*)(ws + WS_WINE), r, scr, lane); continue; } r -= I_WINE;
        if (r < I_WOUTE) { transpose_dense(p.w_out_even, 1024, 1024, (bf16_t*)(ws + WS_WOUTE), r, scr, lane); continue; } r -= I_WOUTE;
        if (r < I_WINO) { transpose_dense(p.w_in_odd, 1024, ODD_IN, (bf16_t*)(ws + WS_WINO), r, scr, lane); continue; } r -= I_WINO;
        if (r < I_WOUTO) { transpose_dense(p.w_out_odd, 1024, 1024, (bf16_t*)(ws + WS_WOUTO), r, scr, lane); continue; } r -= I_WOUTO;
        { const int mat = r >> 3, sub = r & 7;
          transpose_dense(p.gate_w + (size_t)mat * 128 * 128, 128, 128, (bf16_t*)(ws + WS_LGT) + (size_t)mat * 128 * 128, sub, scr, lane); }
    }
    { const size_t n8 = (size_t)T * D / 8; bf16_t* xb = (bf16_t*)(ws + WS_HB);
      for (size_t i = (size_t)gw * 64 + lane; i < n8; i += (size_t)ngw * 64) {
          const f32x4 a = *(const f32x4*)(p.x + i * 8), b = *(const f32x4*)(p.x + i * 8 + 4);
          u32x4 o; o.x = pk2(a[0], a[1]); o.y = pk2(a[2], a[3]); o.z = pk2(b[0], b[1]); o.w = pk2(b[2], b[3]);
          *(u32x4*)(xb + i * 8) = o; } }
    { float* rope = (float*)(ws + WS_ROPE);
      for (int i = gw * 64 + lane; i < SEQ * 32; i += ngw * 64) {
          const int pos = i >> 5, fi = i & 31;
          double inv = 0.15915494309189535;
          if (fi & 1) inv *= 0.7498942093324559; if (fi & 2) inv *= 0.5623413251903491; if (fi & 4) inv *= 0.31622776601683794; if (fi & 8) inv *= 0.1; if (fi & 16) inv *= 0.01;
          const double rev = (double)pos * inv; const float fr = (float)(rev - floor(rev));
          rope[2 * i] = __builtin_amdgcn_cosf(fr); rope[2 * i + 1] = __builtin_amdgcn_sinf(fr); }
      float* lbv = (float*)(ws + WS_LBV);
      for (int i = gw * 64 + lane; i < 1024; i += ngw * 64) { const float l0 = p.lower_bounds[i], l1 = p.lower_bounds[1024 + i]; lbv[i] = 1.f / (1.f + __expf(l0 - l1)); } }
}
__device__ __forceinline__ void prologue_moe(const Params& p, int layer, LAS float* scr, int gw, int ngw, int lane) {
    unsigned char* ws = p.ws;
    constexpr int I_GU = 16 * 16, I_D = 8 * 32;
    constexpr int NITEMS = NEXP * (2 * I_GU + I_D);
    for (int it = gw; it < NITEMS; it += ngw) {
        const int e = it / (2 * I_GU + I_D); int r = it % (2 * I_GU + I_D);
        if (r < 2 * I_GU) { const int sel = r / I_GU; r %= I_GU; const int kb = r / 16, nb = r % 16, n0 = 32 * nb;
            const float* W = (sel ? p.moe_up : p.moe_gate) + ((size_t)layer * NEXP + e) * 1024 * 512;
            transpose_item(W, 512, (bf16_t*)(ws + WS_WGU) + (size_t)e * 1024 * 1024, 1024, 64 * kb, n0, 256 * (n0 >> 7) + 128 * sel + (n0 & 127), scr, lane);
        } else { r -= 2 * I_GU;
            const float* W = p.moe_down + ((size_t)layer * NEXP + e) * 512 * 1024;
            transpose_dense(W, 512, 1024, (bf16_t*)(ws + WS_WD) + (size_t)e * 1024 * 512, r, scr, lane); }
    }
}

__device__ __forceinline__ void ln_rows_store(const f32x4 (&v)[4], const float* lw, const float* lb, float* orow, bf16_t* brow, int lane, f32x4 (&h)[4]) {
    float s = 0.f;
#pragma unroll
    for (int j = 0; j < 4; ++j) s += (v[j][0] + v[j][1]) + (v[j][2] + v[j][3]);
    const float mean = wave_sum(s) * (1.f / D); float s2 = 0.f;
#pragma unroll
    for (int j = 0; j < 4; ++j) { const f32x4 d = v[j] - mean; s2 += (d[0] * d[0] + d[1] * d[1]) + (d[2] * d[2] + d[3] * d[3]); }
    const float rstd = 1.f / sqrtf(wave_sum(s2) * (1.f / D) + LN_EPS);
#pragma unroll
    for (int j = 0; j < 4; ++j) { const int c = 4 * lane + 256 * j; const f32x4 w = *(const f32x4*)(lw + c), b = *(const f32x4*)(lb + c);
        h[j] = (v[j] - mean) * rstd * w + b;
        *(f32x4*)(orow + c) = h[j];
        u32x2 o; o.x = pk2(h[j][0], h[j][1]); o.y = pk2(h[j][2], h[j][3]); *(u32x2*)(brow + c) = o; }
}
__device__ __forceinline__ void ln_router_row(const Params& p, int layer, int row, int lane, LAS int* hist) {
    unsigned char* ws = p.ws; float* res = p.out + (size_t)row * D; bf16_t* hb = (bf16_t*)(ws + WS_HB) + (size_t)row * D;
    f32x4 v[4], h[4];
#pragma unroll
    for (int j = 0; j < 4; ++j) v[j] = *(const f32x4*)(res + 4 * lane + 256 * j);
    ln_rows_store(v, p.ln_w + (size_t)(layer * 2 + 0) * D, p.ln_b + (size_t)(layer * 2 + 0) * D, res, hb, lane, h);
    float lg[16];
#pragma unroll
    for (int e = 0; e < 16; ++e) lg[e] = 0.f;
#pragma unroll
    for (int j = 0; j < 4; ++j)
#pragma unroll
        for (int i = 0; i < 4; ++i) { const float* rw = p.router_w + (size_t)(4 * lane + 256 * j + i) * 16; const float hv = h[j][i];
#pragma unroll
            for (int q = 0; q < 4; ++q) { const f32x4 w = *(const f32x4*)(rw + 4 * q); lg[4 * q] += hv * w[0]; lg[4 * q + 1] += hv * w[1]; lg[4 * q + 2] += hv * w[2]; lg[4 * q + 3] += hv * w[3]; } }
#pragma unroll
    for (int e = 0; e < 16; ++e) lg[e] = wave_sum(lg[e]);
    float mx = lg[0];
#pragma unroll
    for (int e = 1; e < 16; ++e) mx = fmaxf(mx, lg[e]);
    float pr[16], sum = 0.f;
#pragma unroll
    for (int e = 0; e < 16; ++e) { pr[e] = __expf(lg[e] - mx); sum += pr[e]; }
    const float inv = 1.f / sum;
#pragma unroll
    for (int e = 0; e < 16; ++e) pr[e] *= inv;
    float best = -1.f; int be0 = 0, be1 = 1; float bv0 = 0.f, bv1 = 0.f;
#pragma unroll
    for (int g = 0; g < 4; ++g) {
        int i1 = 0; float v1 = pr[4 * g];
#pragma unroll
        for (int i = 1; i < 4; ++i) if (pr[4 * g + i] > v1) { v1 = pr[4 * g + i]; i1 = i; }
        int i2 = -1; float v2 = -1.f;
#pragma unroll
        for (int i = 0; i < 4; ++i) if (i != i1 && pr[4 * g + i] > v2) { v2 = pr[4 * g + i]; i2 = i; }
        const float sc = v1 + v2;
        if (sc > best) { best = sc; be0 = 4 * g + i1; be1 = 4 * g + i2; bv0 = v1; bv1 = v2; }
    }
    if (lane == 0) {
        int* te = (int*)(ws + WS_TOK + TOK_E); float* tg = (float*)(ws + WS_TOK + TOK_G);
        te[2 * row] = be0; te[2 * row + 1] = be1; const float gs = 1.f / (bv0 + bv1); tg[2 * row] = bv0 * gs; tg[2 * row + 1] = bv1 * gs;
        atomicAdd((int*)&hist[be0], 1); atomicAdd((int*)&hist[be1], 1);
    }
}
__device__ __forceinline__ void combine_ln_row(const Params& p, int layer, int row, int lane) {
    unsigned char* ws = p.ws; float* res = p.out + (size_t)row * D; bf16_t* hb = (bf16_t*)(ws + WS_HB) + (size_t)row * D;
    const int* tsl = (const int*)(ws + WS_TOK + TOK_SLOT); const float* tg = (const float*)(ws + WS_TOK + TOK_G);
    const int s0 = tsl[2 * row], s1 = tsl[2 * row + 1]; const float g0 = tg[2 * row], g1 = tg[2 * row + 1];
    const bf16_t* y0 = (const bf16_t*)(ws + WS_XS) + (size_t)s0 * D; const bf16_t* y1 = (const bf16_t*)(ws + WS_XS) + (size_t)s1 * D;
    f32x4 v[4], h[4];
#pragma unroll
    for (int j = 0; j < 4; ++j) { const int c = 4 * lane + 256 * j; const f32x4 r = *(const f32x4*)(res + c);
        const u32x2 a = *(const u32x2*)(y0 + c), b = *(const u32x2*)(y1 + c);
        v[j][0] = DN_ALPHA * r[0] + g0 * bflo(a.x) + g1 * bflo(b.x); v[j][1] = DN_ALPHA * r[1] + g0 * bfhi(a.x) + g1 * bfhi(b.x);
        v[j][2] = DN_ALPHA * r[2] + g0 * bflo(a.y) + g1 * bflo(b.y); v[j][3] = DN_ALPHA * r[3] + g0 * bfhi(a.y) + g1 * bfhi(b.y); }
    ln_rows_store(v, p.ln_w + (size_t)(layer * 2 + 1) * D, p.ln_b + (size_t)(layer * 2 + 1) * D, res, hb, lane, h);
}
#define XB_TMO      128
#define XB_XCNT(j)  (256  + 64 * (j))
#define XB_XSUB(j)  (1280 + 64 * (j))
#define XB_XGEN(j)  (2304 + 64 * (j))
#define XB_TOP      3328
#define XB_TOPGEN   3392
#define XCD_BAR_WORDS 3456
#define XB_SPIN_CAP (1u << 18)

__device__ __forceinline__ unsigned xb_ld(unsigned* p)              { return __hip_atomic_load(p, __ATOMIC_RELAXED, __HIP_MEMORY_SCOPE_AGENT); }
__device__ __forceinline__ unsigned xb_add(unsigned* p, unsigned v) { return __hip_atomic_fetch_add(p, v, __ATOMIC_RELAXED, __HIP_MEMORY_SCOPE_AGENT); }
__device__ __forceinline__ unsigned xb_xcc_id() { return (unsigned)__builtin_amdgcn_s_getreg((3 << 11) | 20) & 0xFu; }
#define XB_SPIN(cond, bar) do { unsigned _sp = 0; while (cond) { __builtin_amdgcn_s_sleep(1); \
    if ((++_sp & 255u) == 0u) { if (xb_ld(&(bar)[XB_TMO])) break; if (_sp > XB_SPIN_CAP) { atomicAdd(&(bar)[XB_TMO], 1u); break; } } } } while (0)

struct XcdBarrier {
    unsigned* bar; unsigned x;
    volatile LAS unsigned* st;
};

__device__ __forceinline__ XcdBarrier xcd_barrier_post(unsigned* bar, volatile LAS unsigned* st) {
    XcdBarrier b; b.bar = bar; b.x = xb_xcc_id(); b.st = st;
    if (threadIdx.x == 0) (void)xb_add(&bar[XB_XCNT(b.x)], 1u);
    return b;
}
__device__ __forceinline__ void xcd_barrier_complete(unsigned* bar, unsigned x, unsigned& nloc, unsigned& nx) {
    const unsigned G = gridDim.x * gridDim.y * gridDim.z;
    unsigned sum, cnt, mine, sp = 0u;
    for (;;) {
        sum = 0u; cnt = 0u; mine = 0u;
#pragma unroll
        for (unsigned j = 0; j < 16; ++j) { const unsigned c = xb_ld(&bar[XB_XCNT(j)]); sum += c; cnt += (c > 0u) ? 1u : 0u; mine = (j == x) ? c : mine; }
        if (sum == G) break;
        __builtin_amdgcn_s_sleep(1);
        if ((++sp & 255u) == 0u) { if (xb_ld(&bar[XB_TMO])) break; if (sp > XB_SPIN_CAP) { atomicAdd(&bar[XB_TMO], 1u); break; } }
    }
    nloc = mine > 0u ? mine : 1u; nx = cnt > 0u ? cnt : 1u;
}

__device__ __forceinline__ void xcd_barrier(const XcdBarrier& b) {
    asm volatile("s_waitcnt vmcnt(0)" ::: "memory");
    __syncthreads();
    if (threadIdx.x == 0) {
        unsigned* bar = b.bar;
        __builtin_amdgcn_s_waitcnt(0);
        unsigned nloc = b.st[0], nx = b.st[1];
        if (nloc == 0u) { xcd_barrier_complete(bar, b.x, nloc, nx); b.st[0] = nloc; b.st[1] = nx; }
        const unsigned old = xb_add(&bar[XB_XSUB(b.x)], 1u);
        const unsigned gen = old / nloc;
        if (old + 1u == (gen + 1u) * nloc) {
            __builtin_amdgcn_fence(__ATOMIC_RELEASE, "agent");
            asm volatile("s_waitcnt vmcnt(0)" ::: "memory");
            const unsigned og = xb_add(&bar[XB_TOP], 1u);
            const unsigned tg = og / nx;
            if (og + 1u == (tg + 1u) * nx) xb_add(&bar[XB_TOPGEN], 1u);
            else XB_SPIN(xb_ld(&bar[XB_TOPGEN]) == tg, bar);
            __builtin_amdgcn_fence(__ATOMIC_ACQUIRE, "agent");
            xb_add(&bar[XB_XGEN(b.x)], 1u);
            asm volatile("s_waitcnt vmcnt(0)" ::: "memory");
        } else {
            XB_SPIN(xb_ld(&bar[XB_XGEN(b.x)]) == gen, bar);
            __builtin_amdgcn_fence(__ATOMIC_ACQUIRE, "agent");
            asm volatile("s_waitcnt vmcnt(0)" ::: "memory");
        }
    }
    __syncthreads();
}

constexpr int STAGE_LDS = 131072;
constexpr int MISC_OFF = STAGE_LDS + 320;
constexpr int LDS_BYTES = 147456;
constexpr int CW_BAR = 4096;

__device__ __forceinline__ void ph_inproj0(const Params& p, PG8_LAS unsigned char* lds, int bid, int nb) {
    pg8::Gemm g{(const bf16_t*)(p.ws + WS_HB), (const bf16_t*)(p.ws + WS_WINE), T, EVEN_IN, D};
    pg8::StaticOrder S; S.init(T, EVEN_IN, D, nb, bid);
    EpiInproj0 E{(bf16_t*)(p.ws + WS_PROJ), (const float*)(p.ws + WS_ROPE)};
    pg8::gemm_phase<EpiInproj0, pg8::StaticOrder, true, true>(lds, g, S, E);
}
__device__ __forceinline__ void ph_inproj1(const Params& p, PG8_LAS unsigned char* lds, int bid, int nb) {
    pg8::Gemm g{(const bf16_t*)(p.ws + WS_HB), (const bf16_t*)(p.ws + WS_WINO), T, ODD_IN, D};
    pg8::StaticOrder S; S.init(T, ODD_IN, D, nb, bid);
    EpiInproj1 E{(bf16_t*)(p.ws + WS_PROJ), (const float*)(p.ws + WS_LBV)};
    pg8::gemm_phase<EpiInproj1, pg8::StaticOrder, true, true>(lds, g, S, E);
}
__device__ __forceinline__ void ph_outproj(const Params& p, int layer, PG8_LAS unsigned char* lds, int bid, int nb) {
    pg8::Gemm g{(const bf16_t*)(p.ws + WS_HB), (const bf16_t*)(p.ws + (layer ? WS_WOUTO : WS_WOUTE)), T, D, D};
    pg8::StaticOrder S; S.init(T, D, D, nb, bid);
    EpiResid E{layer ? (const float*)p.out : p.x, p.out};
    pg8::gemm_phase<EpiResid, pg8::StaticOrder, true, true>(lds, g, S, E);
}
__device__ __forceinline__ void ph_moe_gateup(const Params& p, int layer, PG8_LAS unsigned char* lds, int bid, int nb) {
    const unsigned* ctl = (const unsigned*)(p.ws + WS_CTL);
    pg8::Gemm g{(const bf16_t*)(p.ws + WS_XS), (const bf16_t*)(p.ws + WS_WGU), PMAX, 1024, D};
    pg8::GroupedOrder S; S.tile_e = (const int*)(ctl + CW_TILEE + 256 * layer); S.ntiles = __builtin_amdgcn_readfirstlane((int)ctl[CW_NTILES + layer]); S.nN = 4; S.G = nb; S.c = bid;
    EpiGateUp E{(bf16_t*)(p.ws + WS_HID)};
    pg8::gemm_phase<EpiGateUp, pg8::GroupedOrder, true, true>(lds, g, S, E);
}
__device__ __forceinline__ void ph_moe_down(const Params& p, int layer, PG8_LAS unsigned char* lds, int bid, int nb) {
    const unsigned* ctl = (const unsigned*)(p.ws + WS_CTL);
    pg8::Gemm g{(const bf16_t*)(p.ws + WS_HID), (const bf16_t*)(p.ws + WS_WD), PMAX, 1024, DEXP};
    pg8::GroupedOrder S; S.tile_e = (const int*)(ctl + CW_TILEE + 256 * layer); S.ntiles = __builtin_amdgcn_readfirstlane((int)ctl[CW_NTILES + layer]); S.nN = 4; S.G = nb; S.c = bid;
    EpiBf16 E{(bf16_t*)(p.ws + WS_XS), D};
    pg8::gemm_phase<EpiBf16, pg8::GroupedOrder, true, true>(lds, g, S, E);
}

__device__ __forceinline__ void ph_ret_naive(const Params& p, int tid, int bid) {
    const int vb = bid * 4 + (tid >> 7); if (vb >= 16) return;
    const int dir = vb & 1, bh = vb >> 1, b = bh >> 2, h = bh & 3, e = tid & 127;
    const bf16_t* proj = (const bf16_t*)(p.ws + WS_PROJ);
    float* O = (float*)(p.ws + WS_SCR) + (size_t)dir * T * 512;
    const float gamma = 1.f - exp2f(-5.f - (float)h);
    float S[64];
#pragma unroll
    for (int d = 0; d < 64; ++d) S[d] = 0.f;
    for (int step = 0; step < SEQ; ++step) {
        const int t = dir ? SEQ - 1 - step : step; const size_t row = (size_t)b * SEQ + t;
        const bf16_t* pr = proj + row * EVEN_IN;
        const float v = bf2f(pr[512 + h * 128 + e]);
        float o = 0.f;
#pragma unroll
        for (int c = 0; c < 8; ++c) {
            const u32x4 qq = *(const u32x4*)(pr + h * 64 + 8 * c), kk = *(const u32x4*)(pr + 256 + h * 64 + 8 * c);
            const unsigned qa[4] = {qq.x, qq.y, qq.z, qq.w}, ka[4] = {kk.x, kk.y, kk.z, kk.w};
#pragma unroll
            for (int j = 0; j < 4; ++j) {
                const float q0 = bflo(qa[j]), q1 = bfhi(qa[j]), k0 = bflo(ka[j]), k1 = bfhi(ka[j]);
                const int d = 8 * c + 2 * j;
                if (dir == 0) { S[d] = gamma * S[d] + k0 * v; o += q0 * S[d]; S[d + 1] = gamma * S[d + 1] + k1 * v; o += q1 * S[d + 1]; }
                else { const float s0 = gamma * S[d], s1 = gamma * S[d + 1]; o += q0 * s0 + q1 * s1; S[d] = s0 + k0 * v; S[d + 1] = s1 + k1 * v; }
            }
        }
        O[row * 512 + h * 128 + e] = o;
    }
}
__device__ __forceinline__ void ph_ret_norm(const Params& p, int tid, int bid, int nb) {
    const int lane = tid & 63;
    const float* Of = (const float*)(p.ws + WS_SCR); const float* Ob = Of + (size_t)T * 512;
    const bf16_t* proj = (const bf16_t*)(p.ws + WS_PROJ); bf16_t* mix = (bf16_t*)(p.ws + WS_HB);
    for (int gwv = bid * 8 + (tid >> 6); gwv < T * 4; gwv += nb * 8) {
        const int row = gwv >> 2, h = gwv & 3;
        const size_t o = (size_t)row * 512 + h * 128 + 2 * lane;
        const float a0 = Of[o] + Ob[o], a1 = Of[o + 1] + Ob[o + 1];
        const float mean = wave_sum(a0 + a1) * (1.f / 128.f); const float d0 = a0 - mean, d1 = a1 - mean;
        const float rstd = 1.f / sqrtf(wave_sum(d0 * d0 + d1 * d1) * (1.f / 128.f) + LN_EPS);
        const unsigned gg = *(const unsigned*)(proj + (size_t)row * EVEN_IN + 1024 + h * 128 + 2 * lane);
        *(unsigned*)(mix + (size_t)row * D + h * 128 + 2 * lane) = pk2(d0 * rstd * silu(bflo(gg)), d1 * rstd * silu(bfhi(gg)));
    }
}
__device__ __forceinline__ void ph_lru_ab(const Params& p, int tid, LAS float* xc_s, int bid, int nb) {
    const int w = tid;
    const bf16_t* proj = (const bf16_t*)(p.ws + WS_PROJ);
    float* LA = (float*)(p.ws + WS_SCR); float* BV = LA + (size_t)2 * T * 512;
    for (int item = bid; item < T / 8; item += nb) {
        const int t0 = item * 8;
        __syncthreads();
        for (int tt = 0; tt < 8; ++tt) { const int t = t0 + tt, s = t & (SEQ - 1); float a = p.conv_b[w];
#pragma unroll
            for (int j = 0; j < 4; ++j) { const int ss = s + j - 2; if (ss >= 0 && ss < SEQ) a += p.conv_w[j * 512 + w] * bf2f(proj[(size_t)(t + j - 2) * EVEN_IN + 1536 + w]); }
            xc_s[tt * 512 + w] = a; }
        __syncthreads();
        const int n = w >> 7, d = w & 127;
        float g[4][8];
#pragma unroll
        for (int zg = 0; zg < 4; ++zg)
#pragma unroll
            for (int tt = 0; tt < 8; ++tt) g[zg][tt] = 0.f;
        for (int c = 0; c < 128; ++c) {
            float wv[4];
#pragma unroll
            for (int zg = 0; zg < 4; ++zg) wv[zg] = p.gate_w[((size_t)(zg * 4 + n) * 128 + c) * 128 + d];
#pragma unroll
            for (int tt = 0; tt < 8; ++tt) { const float xv = xc_s[tt * 512 + n * 128 + c];
#pragma unroll
                for (int zg = 0; zg < 4; ++zg) g[zg][tt] += xv * wv[zg]; }
        }
#pragma unroll
        for (int z = 0; z < 2; ++z) {
            const float sp = __logf(1.f + __expf(-p.lam[z * 512 + w]));
            const float br = p.gate_b[((z * 2 + 0) * 4 + n) * 128 + d], bi = p.gate_b[((z * 2 + 1) * 4 + n) * 128 + d];
#pragma unroll
            for (int tt = 0; tt < 8; ++tt) {
                const float r = sigm(g[z * 2][tt] + br), ig = sigm(g[z * 2 + 1][tt] + bi);
                const float la = -8.f * r * sp;
                const size_t idx = ((size_t)z * T + t0 + tt) * 512 + w;
                LA[idx] = la; BV[idx] = sqrtf(1.f - __expf(2.f * la)) * ig * xc_s[tt * 512 + w];
            }
        }
    }
}
__device__ __forceinline__ void ph_lru_scan(const Params& p, int tid, int bid) {
    const int gid = bid * 512 + tid; if (gid >= 2048) return;
    const int w = gid & 511, z = (gid >> 9) & 1, b = gid >> 10;
    const float* LA = (const float*)(p.ws + WS_SCR); float* BV = (float*)(p.ws + WS_SCR) + (size_t)2 * T * 512;
    float h = 0.f;
    for (int step = 0; step < SEQ; step += 8) {
        float la[8], bv[8]; size_t idx[8];
#pragma unroll
        for (int i = 0; i < 8; ++i) { const int t = z ? SEQ - 1 - (step + i) : step + i; idx[i] = ((size_t)z * T + (size_t)b * SEQ + t) * 512 + w; la[i] = LA[idx[i]]; bv[i] = BV[idx[i]]; }
#pragma unroll
        for (int i = 0; i < 8; ++i) { h = __expf(la[i]) * h + bv[i]; BV[idx[i]] = h; }
    }
}
__device__ __forceinline__ void ph_lru_out(const Params& p, int tid, int bid, int nb) {
    const int w = tid;
    const float* HS = (const float*)(p.ws + WS_SCR) + (size_t)2 * T * 512;
    const bf16_t* proj = (const bf16_t*)(p.ws + WS_PROJ); bf16_t* mix = (bf16_t*)(p.ws + WS_HB);
    for (int row = bid; row < T; row += nb) {
        const float hs = HS[(size_t)row * 512 + w] + HS[((size_t)T + row) * 512 + w];
        const float gr = bf2f(proj[(size_t)row * EVEN_IN + 2048 + w]);
        mix[(size_t)row * D + 512 + w] = (bf16_t)f2bf(hs * gelu_tanh(gr));
    }
}
__device__ __forceinline__ void ph_gla_naive(const Params& p, int tid, LAS float* sm, int bid) {
    if (bid >= 8) return;
    const int vq = tid >> 7, vb = bid * 4 + vq;
    LAS float* fs = sm + vq * 512; LAS float* qs = fs + 256;
    const int dir = vb & 1, bh = vb >> 1, b = bh >> 3, h = bh & 7, e = tid & 127;
    bf16_t* proj = (bf16_t*)(p.ws + WS_PROJ);
    float S[128];
#pragma unroll
    for (int d = 0; d < 128; ++d) S[d] = 0.f;
    for (int step = 0; step < SEQ; ++step) {
        const int t = dir ? SEQ - 1 - step : step; bf16_t* pr = proj + ((size_t)b * SEQ + t) * ODD_IN;
        const int buf = step & 1;
        fs[buf * 128 + e] = __expf(bf2f(pr[2048 + dir * 1024 + h * 128 + e])); qs[buf * 128 + e] = bf2f(pr[h * 128 + e]);
        const float v = bf2f(pr[1024 + h * 128 + e]);
        __syncthreads();
        float o = 0.f;
#pragma unroll
        for (int d = 0; d < 128; ++d) { const float f = fs[buf * 128 + d]; S[d] = f * S[d] + (1.f - f) * v; o += qs[buf * 128 + d] * S[d]; }
        pr[2048 + dir * 1024 + h * 128 + e] = (bf16_t)f2bf(o);
    }
}
__device__ __forceinline__ void ph_hg_norm(const Params& p, int tid, int bid, int nb) {
    const int lane = tid & 63;
    for (int row = bid * 8 + (tid >> 6); row < T; row += nb * 8) {
        const bf16_t* pr = (const bf16_t*)(p.ws + WS_PROJ) + (size_t)row * ODD_IN; bf16_t* mix = (bf16_t*)(p.ws + WS_HB) + (size_t)row * D;
        f32x4 o[4]; float ss = 0.f;
#pragma unroll
        for (int j = 0; j < 4; ++j) { const int c = 4 * lane + 256 * j; const u32x2 a = *(const u32x2*)(pr + 2048 + c), bb = *(const u32x2*)(pr + 3072 + c);
            o[j][0] = bflo(a.x) + bflo(bb.x); o[j][1] = bfhi(a.x) + bfhi(bb.x); o[j][2] = bflo(a.y) + bflo(bb.y); o[j][3] = bfhi(a.y) + bfhi(bb.y);
            ss += (o[j][0] * o[j][0] + o[j][1] * o[j][1]) + (o[j][2] * o[j][2] + o[j][3] * o[j][3]); }
        const float rstd = 1.f / sqrtf(wave_sum(ss) * (1.f / D) + RMS_EPS);
#pragma unroll
        for (int j = 0; j < 4; ++j) { const int c = 4 * lane + 256 * j; const f32x4 nw = *(const f32x4*)(p.norm_w + c); const u32x2 gg = *(const u32x2*)(pr + 4096 + c);
            u32x2 w; w.x = pk2(o[j][0] * rstd * nw[0] * silu(bflo(gg.x)), o[j][1] * rstd * nw[1] * silu(bfhi(gg.x)));
            w.y = pk2(o[j][2] * rstd * nw[2] * silu(bflo(gg.y)), o[j][3] * rstd * nw[3] * silu(bfhi(gg.y)));
            *(u32x2*)(mix + c) = w; }
    }
}
__device__ __forceinline__ void ph_ln_router(const Params& p, int tid, int layer, LAS int* hist, int bid, int nb) {
    const int wave = tid >> 6, lane = tid & 63;
    for (int tb = bid; tb < T / 64; tb += nb) {
        __syncthreads();
        if (tid < 16) hist[tid] = 0;
        __syncthreads();
        for (int i = 0; i < 8; ++i) ln_router_row(p, layer, tb * 64 + wave * 8 + i, lane, hist);
        __syncthreads();
        if (tid < 16) ((int*)(p.ws + WS_TOK + TOK_BH))[(layer * 256 + tb) * 16 + tid] = hist[tid];
    }
}
__device__ __forceinline__ void ph_slots(const Params& p, int tid, int layer, LAS int* sm, int bid, int nb) {
    LAS int* tot = sm; LAS int* pre = sm + 16; LAS int* base = sm + 32; LAS int* lslot = sm + 64; LAS int* le = sm + 192;
    unsigned char* ws = p.ws; int* ctl = (int*)(ws + WS_CTL);
    const int* bh = (const int*)(ws + WS_TOK + TOK_BH) + layer * 256 * 16;
    const int* te = (const int*)(ws + WS_TOK + TOK_E);
    for (int tb = bid; tb < T / 64; tb += nb) {
        const int t0 = tb * 64;
        __syncthreads();
        if (tid < 16) { int a = 0, b = 0; for (int k = 0; k < 256; ++k) { const int v = bh[k * 16 + tid]; a += v; if (k < tb) b += v; } tot[tid] = a; pre[tid] = b; }
        if (tid < 128) le[tid] = te[2 * t0 + tid];
        __syncthreads();
        if (tid == 0) { int acc = 0; for (int e = 0; e < 16; ++e) { base[e] = acc; acc += (tot[e] + 255) / 256 * 256; }
            if (tb == 0) { int k = 0; for (int e = 0; e < 16; ++e) { const int nt = (tot[e] + 255) / 256; for (int i = 0; i < nt; ++i) ctl[CW_TILEE + 256 * layer + k++] = e; } ctl[CW_NTILES + layer] = k; } }
        __syncthreads();
        if (tid < 128) { const int e = le[tid]; int rank = 0; for (int a = 0; a < tid; ++a) rank += (le[a] == e) ? 1 : 0;
            const int s = base[e] + pre[e] + rank; lslot[tid] = s; ((int*)(ws + WS_TOK + TOK_SLOT))[2 * t0 + tid] = s; }
        __syncthreads();
        const int wave = tid >> 6, lane = tid & 63;
        const bf16_t* hb = (const bf16_t*)(ws + WS_HB); bf16_t* xs = (bf16_t*)(ws + WS_XS);
        for (int i = 0; i < 8; ++i) { const int tl = wave * 8 + i; const size_t row = t0 + tl;
            const u32x4 a = *(const u32x4*)(hb + row * D + 8 * lane), b2 = *(const u32x4*)(hb + row * D + 512 + 8 * lane);
#pragma unroll
            for (int k = 0; k < 2; ++k) { bf16_t* dst = xs + (size_t)lslot[2 * tl + k] * D; *(u32x4*)(dst + 8 * lane) = a; *(u32x4*)(dst + 512 + 8 * lane) = b2; } }
    }
}
__device__ __forceinline__ void ph_combine_ln(const Params& p, int tid, int layer, int bid, int nb) {
    const int lane = tid & 63;
    for (int row = bid * 8 + (tid >> 6); row < T; row += nb * 8) combine_ln_row(p, layer, row, lane);
}

constexpr int ENG_L = 512, ENG_NSC = SEQ / ENG_L, ENG_NC = ENG_L / 64;
struct EngDesc {
    const bf16_t* q; const bf16_t* kg; const bf16_t* v;
    bf16_t* o; int ors; int rs;
    int row0, dir, tau0;
    float lg;
    float* state; float* lgam;
};
typedef unsigned short u16x8 __attribute__((ext_vector_type(8)));
#define MFMA16(a, b, c) __builtin_amdgcn_mfma_f32_16x16x32_bf16((a), (b), (c), 0, 0, 0)

template <int DK, int MODE, int PASS>
__device__ __forceinline__ void engine_unit(const EngDesc& ds, LAS unsigned char* lds, int tid) {
    constexpr int CPW = DK / 8, NG = 64 / CPW, TG = CPW;
    constexpr int QS = (DK + 8) * 2, TS = 144;
    constexpr int OFF_QI = 0, OFF_KI = OFF_QI + 64 * QS, OFF_KT = OFF_KI + 64 * QS, OFF_VT = OFF_KT + DK * TS, OFF_ATT = OFF_VT + 128 * TS, OFF_BL = OFF_ATT + 64 * TS;
    constexpr int NDT = DK / 16, NKS = DK / 32;
    const int w = __builtin_amdgcn_readfirstlane(tid >> 6), l = tid & 63, fr = l & 15, fq = l >> 4;
    const int d1 = CPW * w + (l % CPW), g1 = l / CPW;
    const int e2 = 16 * w + fr, g2 = fq;
    f32x4 S[NDT];
#pragma unroll
    for (int dt = 0; dt < NDT; ++dt) { if (PASS == 1) S[dt] = *(const f32x4*)(ds.state + ((size_t)(w * NDT + dt) * 64 + l) * 4); else S[dt] = (f32x4){0.f, 0.f, 0.f, 0.f}; }
    float lgsum = 0.f;
    unsigned short rq[TG], rk[TG], rv[16];
#define ENG_ROW(tau) ((size_t)(ds.row0 + (ds.dir ? (SEQ - 1 - (tau)) : (tau))))
#define ENG_LOAD_RAW(c) do { const int tb_ = ds.tau0 + 64 * (c); \
        _Pragma("unroll") for (int i = 0; i < TG; ++i) { const size_t r_ = ENG_ROW(tb_ + g1 * TG + i) * ds.rs + d1; \
            if (MODE == 0 || true) rk[i] = ds.kg[r_]; if (PASS == 1) rq[i] = ds.q[r_]; } \
        _Pragma("unroll") for (int i = 0; i < 16; ++i) rv[i] = ds.v[ENG_ROW(tb_ + g2 * 16 + i) * ds.rs + e2]; } while (0)
    ENG_LOAD_RAW(0);
#pragma unroll 1
    for (int c = 0; c < ENG_NC; ++c) {
        __syncthreads();
        {
            float b[TG], bl;
            if (MODE == 1) {
                float run = 0.f;
#pragma unroll
                for (int i = 0; i < TG; ++i) { run += bf2f(rk[i]); b[i] = run; }
                float acc = run;
#pragma unroll
                for (int s = 0; (1 << s) < NG; ++s) { const float t = __shfl_up(acc, CPW << s); if (g1 >= (1 << s)) acc += t; }
                const float excl = acc - run;
                bl = __shfl(acc, (NG - 1) * CPW + (l % CPW));
#pragma unroll
                for (int i = 0; i < TG; ++i) b[i] += excl;
            } else {
#pragma unroll
                for (int i = 0; i < TG; ++i) b[i] = (float)(g1 * TG + i + 1) * ds.lg;
                bl = 64.f * ds.lg;
            }
            lgsum += bl;
            unsigned kt[TG / 2];
#pragma unroll
            for (int i = 0; i < TG; i += 2) {
                float kv0, kv1;
                if (MODE == 1) { kv0 = 1.f - __expf(bf2f(rk[i])); kv1 = 1.f - __expf(bf2f(rk[i + 1])); } else { kv0 = bf2f(rk[i]); kv1 = bf2f(rk[i + 1]); }
                const float x0 = b[i] - bl, x1 = b[i + 1] - bl;
                const float k0 = kv0 * __expf(-x0), k1 = kv1 * __expf(-x1);
                kt[i / 2] = cvtpk(k0, k1);
                if (PASS == 1) {
                    const float q0 = bf2f(rq[i]) * __expf(fminf(x0, 80.f)), q1 = bf2f(rq[i + 1]) * __expf(fminf(x1, 80.f));
                    const unsigned qp = cvtpk(q0, q1);
                    const int tk = g1 * TG + i;
                    *(LAS unsigned short*)(lds + OFF_QI + tk * QS + d1 * 2) = (unsigned short)(qp & 0xffffu); *(LAS unsigned short*)(lds + OFF_QI + (tk + 1) * QS + d1 * 2) = (unsigned short)(qp >> 16);
                    *(LAS unsigned short*)(lds + OFF_KI + tk * QS + d1 * 2) = (unsigned short)(kt[i / 2] & 0xffffu); *(LAS unsigned short*)(lds + OFF_KI + (tk + 1) * QS + d1 * 2) = (unsigned short)(kt[i / 2] >> 16);
                }
            }
#pragma unroll
            for (int i = 0; i < TG / 8; ++i) { u32x4 pk; pk.x = kt[4 * i]; pk.y = kt[4 * i + 1]; pk.z = kt[4 * i + 2]; pk.w = kt[4 * i + 3];
                *(LAS u32x4*)(lds + OFF_KT + d1 * TS + (g1 * TG + 8 * i) * 2) = pk; }
            if (g1 == 0) *(LAS float*)(lds + OFF_BL + d1 * 4) = bl;
#pragma unroll
            for (int i = 0; i < 2; ++i) { u32x4 pk; pk.x = rv[8 * i] | ((unsigned)rv[8 * i + 1] << 16); pk.y = rv[8 * i + 2] | ((unsigned)rv[8 * i + 3] << 16);
                pk.z = rv[8 * i + 4] | ((unsigned)rv[8 * i + 5] << 16); pk.w = rv[8 * i + 6] | ((unsigned)rv[8 * i + 7] << 16);
                *(LAS u32x4*)(lds + OFF_VT + e2 * TS + (g2 * 16 + 8 * i) * 2) = pk; }
        }
        if (c + 1 < ENG_NC) ENG_LOAD_RAW(c + 1);
        __syncthreads();
#pragma unroll
        for (int dt = 0; dt < NDT; ++dt) { const f32x4 bv = *(const LAS f32x4*)(lds + OFF_BL + (16 * dt + 4 * fq) * 4);
            S[dt][0] *= __expf(bv[0]); S[dt][1] *= __expf(bv[1]); S[dt][2] *= __expf(bv[2]); S[dt][3] *= __expf(bv[3]); }
        f32x4 oacc[4];
        if (PASS == 1) {
#pragma unroll
            for (int tt = 0; tt < 2; ++tt) {
                const int t = 2 * w + tt, jt = t >> 2, it = t & 3;
                f32x4 sc = {0.f, 0.f, 0.f, 0.f};
                if (jt <= it) {
#pragma unroll
                    for (int ks = 0; ks < NKS; ++ks) {
                        const bf16x8 a = *(const LAS bf16x8*)(lds + OFF_KI + (16 * jt + fr) * QS + (32 * ks + 8 * fq) * 2);
                        const bf16x8 bq = *(const LAS bf16x8*)(lds + OFF_QI + (16 * it + fr) * QS + (32 * ks + 8 * fq) * 2);
                        sc = MFMA16(a, bq, sc);
                    }
                    if (jt == it) {
#pragma unroll
                        for (int r = 0; r < 4; ++r) if (4 * fq + r > fr) sc[r] = 0.f;
                    }
                }
                u32x2 pk; pk.x = cvtpk(sc[0], sc[1]); pk.y = cvtpk(sc[2], sc[3]);
                *(LAS u32x2*)(lds + OFF_ATT + (16 * it + fr) * TS + (16 * jt + 4 * fq) * 2) = pk;
            }
            bf16x8 sa[NKS];
#pragma unroll
            for (int ks = 0; ks < NKS; ++ks) { u32x4 pk; pk.x = cvtpk(S[2 * ks][0], S[2 * ks][1]); pk.y = cvtpk(S[2 * ks][2], S[2 * ks][3]);
                pk.z = cvtpk(S[2 * ks + 1][0], S[2 * ks + 1][1]); pk.w = cvtpk(S[2 * ks + 1][2], S[2 * ks + 1][3]); sa[ks] = __builtin_bit_cast(bf16x8, pk); }
#pragma unroll
            for (int it = 0; it < 4; ++it) {
                oacc[it] = (f32x4){0.f, 0.f, 0.f, 0.f};
#pragma unroll
                for (int ks = 0; ks < NKS; ++ks) {
                    const u32x2 lo = *(const LAS u32x2*)(lds + OFF_QI + (16 * it + fr) * QS + (32 * ks + 4 * fq) * 2);
                    const u32x2 hi = *(const LAS u32x2*)(lds + OFF_QI + (16 * it + fr) * QS + (32 * ks + 16 + 4 * fq) * 2);
                    u32x4 pk; pk.x = lo.x; pk.y = lo.y; pk.z = hi.x; pk.w = hi.y;
                    oacc[it] = MFMA16(sa[ks], __builtin_bit_cast(bf16x8, pk), oacc[it]);
                }
            }
            __syncthreads();
        }
        bf16x8 vf[2];
#pragma unroll
        for (int ks = 0; ks < 2; ++ks) vf[ks] = *(const LAS bf16x8*)(lds + OFF_VT + (16 * w + fr) * TS + (32 * ks + 8 * fq) * 2);
        if (PASS == 1) {
#pragma unroll
            for (int it = 0; it < 4; ++it)
#pragma unroll
                for (int ks = 0; ks < 2; ++ks) if (ks == 0 || it >= 2) {
                    const bf16x8 ba = *(const LAS bf16x8*)(lds + OFF_ATT + (16 * it + fr) * TS + (32 * ks + 8 * fq) * 2);
                    oacc[it] = MFMA16(vf[ks], ba, oacc[it]);
                }
        }
#pragma unroll
        for (int dt = 0; dt < NDT; ++dt)
#pragma unroll
            for (int ks = 0; ks < 2; ++ks) {
                const bf16x8 a = *(const LAS bf16x8*)(lds + OFF_KT + (16 * dt + fr) * TS + (32 * ks + 8 * fq) * 2);
                S[dt] = MFMA16(a, vf[ks], S[dt]);
            }
        if (PASS == 1) {
#pragma unroll
            for (int it = 0; it < 4; ++it) { u32x2 pk; pk.x = cvtpk(oacc[it][0], oacc[it][1]); pk.y = cvtpk(oacc[it][2], oacc[it][3]);
                *(u32x2*)(ds.o + ENG_ROW(ds.tau0 + 64 * c + 16 * it + fr) * ds.ors + 16 * w + 4 * fq) = pk; }
        }
    }
    if (PASS == 0) {
#pragma unroll
        for (int dt = 0; dt < NDT; ++dt) *(f32x4*)(ds.state + ((size_t)(w * NDT + dt) * 64 + l) * 4) = S[dt];
        if (g1 == 0) ds.lgam[d1] = lgsum;
    }
#undef ENG_ROW
#undef ENG_LOAD_RAW
}
template <int DK>
__device__ __forceinline__ void eng_scan(const float* sloc, float* sin, const float* lgam, int nseq, int gtid, int gthreads) {
    constexpr int NDT = DK / 16, PER_SEQ = 8 * NDT * 64;
    for (int i = gtid; i < nseq * PER_SEQ; i += gthreads) {
        const int seq = i / PER_SEQ, r = i % PER_SEQ, l = r & 63, dt = (r >> 6) % NDT;
        const int d = 16 * dt + 4 * (l >> 4);
        f32x4 cur = {0.f, 0.f, 0.f, 0.f};
        for (int sc = 0; sc < ENG_NSC; ++sc) {
            const size_t so = ((size_t)(seq * ENG_NSC + sc) * PER_SEQ + r) * 4;
            const f32x4 loc = *(const f32x4*)(sloc + so); const f32x4 lg = *(const f32x4*)(lgam + (size_t)(seq * ENG_NSC + sc) * DK + d);
            *(f32x4*)(sin + so) = cur;
            cur[0] = __expf(lg[0]) * cur[0] + loc[0]; cur[1] = __expf(lg[1]) * cur[1] + loc[1]; cur[2] = __expf(lg[2]) * cur[2] + loc[2]; cur[3] = __expf(lg[3]) * cur[3] + loc[3];
        }
    }
}

constexpr size_t WS_RO = WS_SCR;
constexpr size_t WS_ST = 216 * MiB;
constexpr size_t WS_ST_RET = 236 * MiB;
constexpr size_t WS_SIN = 248 * MiB;
constexpr size_t WS_LG = 280 * MiB;

template <int PASS>
__device__ __forceinline__ void ph_ret_pass(const Params& p, int tid, LAS unsigned char* lds, int bid, int nb) {
    bf16_t* proj = (bf16_t*)(p.ws + WS_PROJ);
    for (int u = bid; u < 16 * ENG_NSC; u += nb) {
        const int seq = u / ENG_NSC, sc = u % ENG_NSC, dir = seq & 1, bh = seq >> 1, b = bh >> 2, h = bh & 3;
        EngDesc ds; ds.q = proj + h * 64; ds.kg = proj + 256 + h * 64; ds.v = proj + 512 + h * 128; ds.rs = EVEN_IN;
        ds.o = (bf16_t*)(p.ws + WS_RO) + (size_t)dir * T * 512 + h * 128; ds.ors = 512;
        ds.row0 = b * SEQ; ds.dir = dir; ds.tau0 = sc * ENG_L; ds.lg = log1pf(-exp2f(-5.f - (float)h));
        ds.state = (float*)(p.ws + (PASS ? WS_SIN : WS_ST_RET)) + (size_t)u * (64 * 128); ds.lgam = (float*)(p.ws + WS_LG) + (size_t)u * 64;
        engine_unit<64, 0, PASS>(ds, lds, tid);
    }
}
template <int PASS>
__device__ __forceinline__ void ph_gla_pass(const Params& p, int tid, LAS unsigned char* lds, int bid, int nb) {
    bf16_t* proj = (bf16_t*)(p.ws + WS_PROJ);
    for (int u = bid; u < 32 * ENG_NSC; u += nb) {
        const int seq = u / ENG_NSC, sc = u % ENG_NSC, dir = seq & 1, bh = seq >> 1, b = bh >> 3, h = bh & 7;
        EngDesc ds; ds.q = proj + h * 128; ds.kg = proj + 2048 + dir * 1024 + h * 128; ds.v = proj + 1024 + h * 128; ds.rs = ODD_IN;
        ds.o = proj + 2048 + dir * 1024 + h * 128; ds.ors = ODD_IN;
        ds.row0 = b * SEQ; ds.dir = dir; ds.tau0 = sc * ENG_L; ds.lg = 0.f;
        ds.state = (float*)(p.ws + (PASS ? WS_SIN : WS_ST)) + (size_t)u * (128 * 128); ds.lgam = (float*)(p.ws + WS_LG) + (size_t)u * 128;
        engine_unit<128, 1, PASS>(ds, lds, tid);
    }
}
__device__ __forceinline__ void ph_ret_norm2(const Params& p, int tid, int bid, int nb) {
    const int lane = tid & 63;
    const bf16_t* Of = (const bf16_t*)(p.ws + WS_RO); const bf16_t* Ob = Of + (size_t)T * 512;
    const bf16_t* proj = (const bf16_t*)(p.ws + WS_PROJ); bf16_t* mix = (bf16_t*)(p.ws + WS_HB);
    for (int gwv = bid * 8 + (tid >> 6); gwv < T * 4; gwv += nb * 8) {
        const int row = gwv >> 2, h = gwv & 3;
        const bf16_t* pr = proj + (size_t)row * EVEN_IN;
        const float qk = wave_sum(bf2f(pr[h * 64 + lane]) * bf2f(pr[256 + h * 64 + lane]));
        const size_t o = (size_t)row * 512 + h * 128 + 2 * lane;
        const unsigned uf = *(const unsigned*)(Of + o), ub = *(const unsigned*)(Ob + o), uv = *(const unsigned*)(pr + 512 + h * 128 + 2 * lane);
        const float a0 = bflo(uf) + bflo(ub) - qk * bflo(uv), a1 = bfhi(uf) + bfhi(ub) - qk * bfhi(uv);
        const float mean = wave_sum(a0 + a1) * (1.f / 128.f); const float d0 = a0 - mean, d1 = a1 - mean;
        const float rstd = 1.f / sqrtf(wave_sum(d0 * d0 + d1 * d1) * (1.f / 128.f) + LN_EPS);
        const unsigned gg = *(const unsigned*)(pr + 1024 + h * 128 + 2 * lane);
        *(unsigned*)(mix + (size_t)row * D + h * 128 + 2 * lane) = pk2(d0 * rstd * silu(bflo(gg)), d1 * rstd * silu(bfhi(gg)));
    }
}

constexpr size_t WS_G = WS_SCR + 32 * MiB;
constexpr size_t WS_AGG = 232 * MiB;
constexpr size_t WS_CIN = 234 * MiB;
template <int CTRL> __device__ __forceinline__ float dppf(float old, float x) {
    return __builtin_bit_cast(float, __builtin_amdgcn_update_dpp(__builtin_bit_cast(int, old), __builtin_bit_cast(int, x), CTRL, 0xf, 0xf, false));
}
template <bool FWD> __device__ __forceinline__ void row_scan(float& A, float& B) {
#define LRU_STEP(s) { const float Ap = dppf<(FWD ? 0x110 : 0x100) + s>(1.f, A), Bp = dppf<(FWD ? 0x110 : 0x100) + s>(0.f, B); B = A * Bp + B; A = A * Ap; }
    LRU_STEP(1) LRU_STEP(2) LRU_STEP(4) LRU_STEP(8)
#undef LRU_STEP
}
__device__ __forceinline__ void lru_unit(const Params& p, LAS unsigned char* lds, int tid, int u) {
    constexpr int XS_ = 272;
    const int n = u & 3, c = (u >> 2) & 63, b = u >> 8;
    const int w = __builtin_amdgcn_readfirstlane(tid >> 6), l = tid & 63, fr = l & 15, fq = l >> 4;
    const int row0 = b * SEQ + c * 128;
    const bf16_t* proj = (const bf16_t*)(p.ws + WS_PROJ);
    __syncthreads();
#pragma unroll
    for (int k = 0; k < 4; ++k) {
        const int id = tid + 512 * k, tok = id >> 4, cg = id & 15, ch0 = 128 * n + 8 * cg, s = c * 128 + tok;
        float acc[8];
        { const f32x4 b0 = *(const f32x4*)(p.conv_b + ch0), b1 = *(const f32x4*)(p.conv_b + ch0 + 4);
          acc[0] = b0[0]; acc[1] = b0[1]; acc[2] = b0[2]; acc[3] = b0[3]; acc[4] = b1[0]; acc[5] = b1[1]; acc[6] = b1[2]; acc[7] = b1[3]; }
#pragma unroll
        for (int j = 0; j < 4; ++j) {
            const int ss = s + j - 2;
            if (ss >= 0 && ss < SEQ) {
                const u32x4 xv = *(const u32x4*)(proj + (size_t)(b * SEQ + ss) * EVEN_IN + 1536 + ch0);
                const f32x4 w0 = *(const f32x4*)(p.conv_w + j * 512 + ch0), w1 = *(const f32x4*)(p.conv_w + j * 512 + ch0 + 4);
                acc[0] += w0[0] * bflo(xv.x); acc[1] += w0[1] * bfhi(xv.x); acc[2] += w0[2] * bflo(xv.y); acc[3] += w0[3] * bfhi(xv.y);
                acc[4] += w1[0] * bflo(xv.z); acc[5] += w1[1] * bfhi(xv.z); acc[6] += w1[2] * bflo(xv.w); acc[7] += w1[3] * bfhi(xv.w);
            }
        }
        u32x4 pk; pk.x = cvtpk(acc[0], acc[1]); pk.y = cvtpk(acc[2], acc[3]); pk.z = cvtpk(acc[4], acc[5]); pk.w = cvtpk(acc[6], acc[7]);
        *(LAS u32x4*)(lds + tok * XS_ + cg * 16) = pk;
    }
    __syncthreads();
    const int chl = 16 * w + 4 * fq, ch = 128 * n + chl;
    const bf16_t* lgt = (const bf16_t*)(p.ws + WS_LGT);
    bf16_t* G = (bf16_t*)(p.ws + WS_G);
    float* agg = (float*)(p.ws + WS_AGG) + (size_t)((b * 64 + c) * 2) * 2 * 512;
#pragma unroll
    for (int z = 0; z < 2; ++z) {
        bf16x8 ar[4], ai[4];
#pragma unroll
        for (int ks = 0; ks < 4; ++ks) {
            ar[ks] = *(const bf16x8*)(lgt + ((size_t)((2 * z + 0) * 4 + n) * 128 + 16 * w + fr) * 128 + 32 * ks + 8 * fq);
            ai[ks] = *(const bf16x8*)(lgt + ((size_t)((2 * z + 1) * 4 + n) * 128 + 16 * w + fr) * 128 + 32 * ks + 8 * fq);
        }
        const f32x4 lam4 = *(const f32x4*)(p.lam + z * 512 + ch);
        const f32x4 br4 = *(const f32x4*)(p.gate_b + ((2 * z + 0) * 4 + n) * 128 + chl), bi4 = *(const f32x4*)(p.gate_b + ((2 * z + 1) * 4 + n) * 128 + chl);
        float sp8[4];
#pragma unroll
        for (int r = 0; r < 4; ++r) sp8[r] = -8.f * __logf(1.f + __expf(-lam4[r]));
        float cin[4] = {0.f, 0.f, 0.f, 0.f}, pin[4] = {1.f, 1.f, 1.f, 1.f};
        const int srcl = (l & 48) | (z ? 0 : 15);
#pragma unroll 1
        for (int ti = 0; ti < 8; ++ti) {
            const int tt = z ? 7 - ti : ti;
            f32x4 gr_ = {0.f, 0.f, 0.f, 0.f}, gi_ = {0.f, 0.f, 0.f, 0.f};
#pragma unroll
            for (int ks = 0; ks < 4; ++ks) {
                const bf16x8 xb = *(const LAS bf16x8*)(lds + (16 * tt + fr) * XS_ + (32 * ks + 8 * fq) * 2);
                gr_ = MFMA16(ar[ks], xb, gr_); gi_ = MFMA16(ai[ks], xb, gi_);
            }
            const u32x2 xq = *(const LAS u32x2*)(lds + (16 * tt + fr) * XS_ + chl * 2);
            const float xcv[4] = {bflo(xq.x), bfhi(xq.x), bflo(xq.y), bfhi(xq.y)};
            float hl[4], Pl[4];
#pragma unroll
            for (int r = 0; r < 4; ++r) {
                const float la = sp8[r] * sigm(gr_[r] + br4[r]);
                float A = __expf(la), B = sqrtf(fmaxf(1.f - __expf(2.f * la), 0.f)) * sigm(gi_[r] + bi4[r]) * xcv[r];
                if (z == 0) row_scan<true>(A, B); else row_scan<false>(A, B);
                hl[r] = A * cin[r] + B; Pl[r] = A * pin[r];
                cin[r] = __shfl(hl[r], srcl); pin[r] = __shfl(Pl[r], srcl);
            }
            {
                const size_t row = (size_t)row0 + 16 * tt + fr;
                const u32x2 gq = *(const u32x2*)(proj + row * EVEN_IN + 2048 + ch);
                const float ge[4] = {gelu_tanh(bflo(gq.x)), gelu_tanh(bfhi(gq.x)), gelu_tanh(bflo(gq.y)), gelu_tanh(bfhi(gq.y))};
                u32x2 o1, o2;
                o1.x = cvtpk(hl[0] * ge[0], hl[1] * ge[1]); o1.y = cvtpk(hl[2] * ge[2], hl[3] * ge[3]);
                o2.x = cvtpk(Pl[0] * ge[0], Pl[1] * ge[1]); o2.y = cvtpk(Pl[2] * ge[2], Pl[3] * ge[3]);
                *(u32x2*)(G + ((size_t)(2 * z) * T + row) * 512 + ch) = o1; *(u32x2*)(G + ((size_t)(2 * z + 1) * T + row) * 512 + ch) = o2;
            }
        }
        if (fr == 0) { f32x4 a4 = {pin[0], pin[1], pin[2], pin[3]}, b4 = {cin[0], cin[1], cin[2], cin[3]};
            *(f32x4*)(agg + (size_t)(z * 2 + 0) * 512 + ch) = a4; *(f32x4*)(agg + (size_t)(z * 2 + 1) * 512 + ch) = b4; }
    }
}
__device__ __forceinline__ void lru_carry(const Params& p, int gid) {
    if (gid >= 2048) return;
    const int ch = gid & 511, z = (gid >> 9) & 1, b = gid >> 10;
    const float* agg = (const float*)(p.ws + WS_AGG); float* cinb = (float*)(p.ws + WS_CIN);
    float cur = 0.f;
    for (int step = 0; step < 64; ++step) {
        const int c = z ? 63 - step : step; const size_t idx = (size_t)((b * 64 + c) * 2 + z);
        cinb[idx * 512 + ch] = cur;
        cur = agg[(idx * 2 + 0) * 512 + ch] * cur + agg[(idx * 2 + 1) * 512 + ch];
    }
}
__device__ __forceinline__ void lru_combine(const Params& p, int gid, int gthreads) {
    const bf16_t* G = (const bf16_t*)(p.ws + WS_G); const float* cinb = (const float*)(p.ws + WS_CIN); bf16_t* mix = (bf16_t*)(p.ws + WS_HB);
    for (int i = gid; i < T * 128; i += gthreads) {
        const int row = i >> 7, ch = (i & 127) * 4, b = row >> 13, c = (row & (SEQ - 1)) >> 7;
        const f32x4 cf = *(const f32x4*)(cinb + (size_t)((b * 64 + c) * 2 + 0) * 512 + ch), cb = *(const f32x4*)(cinb + (size_t)((b * 64 + c) * 2 + 1) * 512 + ch);
        const u32x2 g1 = *(const u32x2*)(G + (size_t)row * 512 + ch), g2 = *(const u32x2*)(G + ((size_t)T + row) * 512 + ch);
        const u32x2 g3 = *(const u32x2*)(G + ((size_t)2 * T + row) * 512 + ch), g4 = *(const u32x2*)(G + ((size_t)3 * T + row) * 512 + ch);
        u32x2 o;
        o.x = cvtpk(bflo(g1.x) + bflo(g3.x) + bflo(g2.x) * cf[0] + bflo(g4.x) * cb[0], bfhi(g1.x) + bfhi(g3.x) + bfhi(g2.x) * cf[1] + bfhi(g4.x) * cb[1]);
        o.y = cvtpk(bflo(g1.y) + bflo(g3.y) + bflo(g2.y) * cf[2] + bflo(g4.y) * cb[2], bfhi(g1.y) + bfhi(g3.y) + bfhi(g2.y) * cf[3] + bfhi(g4.y) * cb[3]);
        *(u32x2*)(mix + (size_t)row * D + 512 + ch) = o;
    }
}

__device__ __forceinline__ Params load_params() {
    typedef const float* cfp;
    const volatile __attribute__((address_space(4))) cfp* kp = (const volatile __attribute__((address_space(4))) cfp*)__builtin_amdgcn_kernarg_segment_ptr();
    Params q;
    q.x = kp[0]; q.w_in_even = kp[1]; q.w_out_even = kp[2]; q.conv_w = kp[3]; q.conv_b = kp[4]; q.gate_w = kp[5]; q.gate_b = kp[6]; q.lam = kp[7];
    q.w_in_odd = kp[8]; q.w_out_odd = kp[9]; q.lower_bounds = kp[10]; q.norm_w = kp[11]; q.ln_w = kp[12]; q.ln_b = kp[13]; q.router_w = kp[14];
    q.moe_gate = kp[15]; q.moe_up = kp[16]; q.moe_down = kp[17]; q.out = (float*)kp[18]; q.ws = (unsigned char*)kp[19];
    return q;
}
#define PH_BEGIN { const Params p = load_params(); int tid_ = threadIdx.x; asm volatile("" : "+v"(tid_)); int bid = blockIdx.x, nb = gridDim.x; asm volatile("" : "+s"(bid), "+s"(nb)); \
    const int wave = __builtin_amdgcn_readfirstlane(tid_ >> 6), lane = tid_ & 63; LAS float* scrw = (LAS float*)(lds + wave * 16384); const int gw = bid * 8 + wave, ngw = nb * 8; \
    (void)lane; (void)scrw; (void)gw; (void)ngw;
#define PH_END }
#define GRID_BAR() { XcdBarrier b_; b_.bar = (unsigned*)(load_params().ws + WS_CTL) + CW_BAR; b_.x = xb_xcc_id(); b_.st = MISC + 8; xcd_barrier(b_); }
__global__ void __launch_bounds__(512, 2) mega_fwd(Params p_unused) {
    extern __shared__ __attribute__((aligned(16))) unsigned char shm[];
    PG8_LAS unsigned char* lds = (PG8_LAS unsigned char*)shm;
    volatile LAS unsigned* MISC = (volatile LAS unsigned*)(lds + MISC_OFF);
    for (int u = threadIdx.x; u < (LDS_BYTES - STAGE_LDS) / 4; u += 512) ((LAS unsigned*)(lds + STAGE_LDS))[u] = 0u;
    __syncthreads();
    (void)xcd_barrier_post((unsigned*)(load_params().ws + WS_CTL) + CW_BAR, MISC + 8);

    PH_BEGIN prologue_static(p, scrw, gw, ngw, lane); PH_END
    GRID_BAR();
    PH_BEGIN ph_inproj0(p, lds, bid, nb); PH_END
    GRID_BAR();
    PH_BEGIN ph_ret_pass<0>(p, tid_, lds, bid, nb); PH_END
    GRID_BAR();
    PH_BEGIN eng_scan<64>((const float*)(p.ws + WS_ST_RET), (float*)(p.ws + WS_SIN), (const float*)(p.ws + WS_LG), 16, bid * 512 + tid_, nb * 512); PH_END
    GRID_BAR();
    PH_BEGIN ph_ret_pass<1>(p, tid_, lds, bid, nb); PH_END
    GRID_BAR();
    PH_BEGIN ph_ret_norm2(p, tid_, bid, nb); PH_END
    GRID_BAR();
    PH_BEGIN for (int u = bid; u < 512; u += nb) lru_unit(p, lds, tid_, u); PH_END
    GRID_BAR();
    PH_BEGIN lru_carry(p, bid * 512 + tid_); PH_END
    GRID_BAR();
    PH_BEGIN lru_combine(p, bid * 512 + tid_, nb * 512); PH_END
    GRID_BAR();
    PH_BEGIN ph_outproj(p, 0, lds, bid, nb); PH_END
    GRID_BAR();
    PH_BEGIN prologue_moe(p, 0, scrw, gw, ngw, lane); ph_ln_router(p, tid_, 0, (LAS int*)lds, bid, nb); PH_END
    GRID_BAR();
    PH_BEGIN ph_slots(p, tid_, 0, (LAS int*)lds, bid, nb); PH_END
    GRID_BAR();
    PH_BEGIN ph_moe_gateup(p, 0, lds, bid, nb); PH_END
    GRID_BAR();
    PH_BEGIN ph_moe_down(p, 0, lds, bid, nb); PH_END
    GRID_BAR();
    PH_BEGIN ph_combine_ln(p, tid_, 0, bid, nb); PH_END
    GRID_BAR();
    PH_BEGIN ph_inproj1(p, lds, bid, nb); PH_END
    GRID_BAR();
    PH_BEGIN ph_gla_pass<0>(p, tid_, lds, bid, nb); PH_END
    GRID_BAR();
    PH_BEGIN eng_scan<128>((const float*)(p.ws + WS_ST), (float*)(p.ws + WS_SIN), (const float*)(p.ws + WS_LG), 32, bid * 512 + tid_, nb * 512); PH_END
    GRID_BAR();
    PH_BEGIN ph_gla_pass<1>(p, tid_, lds, bid, nb); PH_END
    GRID_BAR();
    PH_BEGIN ph_hg_norm(p, tid_, bid, nb); PH_END
    GRID_BAR();
    PH_BEGIN ph_outproj(p, 1, lds, bid, nb); PH_END
    GRID_BAR();
    PH_BEGIN prologue_moe(p, 1, scrw, gw, ngw, lane); ph_ln_router(p, tid_, 1, (LAS int*)lds, bid, nb); PH_END
    GRID_BAR();
    PH_BEGIN ph_slots(p, tid_, 1, (LAS int*)lds, bid, nb); PH_END
    GRID_BAR();
    PH_BEGIN ph_moe_gateup(p, 1, lds, bid, nb); PH_END
    GRID_BAR();
    PH_BEGIN ph_moe_down(p, 1, lds, bid, nb); PH_END
    GRID_BAR();
    PH_BEGIN ph_combine_ln(p, tid_, 1, bid, nb); PH_END
}

extern "C" void kernel_launch(void* const* d_in, const int* in_sizes, int n_in, void* d_out, int out_size, void* d_ws, size_t ws_size, hipStream_t stream) {
    static int grid = 0;
    if (grid == 0) {
        if (n_in != 18 || in_sizes[0] != T * D || out_size != T * D || ws_size < WS_END) { fprintf(stderr, "kernel_launch: unexpected shapes (n_in %d, in0 %d, out %d, ws %zu)\n", n_in, n_in > 0 ? in_sizes[0] : -1, out_size, ws_size); grid = -1; return; }
        int dev = 0, cus = 0, per_cu = 0;
        if (hipGetDevice(&dev) != hipSuccess || hipDeviceGetAttribute(&cus, hipDeviceAttributeMultiprocessorCount, dev) != hipSuccess) { grid = -1; return; }
        if (hipFuncSetAttribute((const void*)mega_fwd, hipFuncAttributeMaxDynamicSharedMemorySize, LDS_BYTES) != hipSuccess) { fprintf(stderr, "kernel_launch: hipFuncSetAttribute failed\n"); grid = -1; return; }
        if (hipOccupancyMaxActiveBlocksPerMultiprocessor(&per_cu, (const void*)mega_fwd, 512, LDS_BYTES) != hipSuccess || per_cu < 1) { fprintf(stderr, "kernel_launch: occupancy query says %d workgroups per CU\n", per_cu); }
        (void)hipGetLastError();
        grid = cus > 0 ? cus : 256;
    }
    if (grid < 0) return;
    Params p{};
    p.x = (const float*)d_in[0]; p.w_in_even = (const float*)d_in[1]; p.w_out_even = (const float*)d_in[2]; p.conv_w = (const float*)d_in[3]; p.conv_b = (const float*)d_in[4];
    p.gate_w = (const float*)d_in[5]; p.gate_b = (const float*)d_in[6]; p.lam = (const float*)d_in[7]; p.w_in_odd = (const float*)d_in[8]; p.w_out_odd = (const float*)d_in[9];
    p.lower_bounds = (const float*)d_in[10]; p.norm_w = (const float*)d_in[11]; p.ln_w = (const float*)d_in[12]; p.ln_b = (const float*)d_in[13]; p.router_w = (const float*)d_in[14];
    p.moe_gate = (const float*)d_in[15]; p.moe_up = (const float*)d_in[16]; p.moe_down = (const float*)d_in[17];
    p.out = (float*)d_out; p.ws = (unsigned char*)d_ws;
    if (hipMemsetAsync((char*)d_ws + WS_CTL, 0, CTL_BYTES, stream) != hipSuccess) return;
    hipLaunchKernelGGL(mega_fwd, dim3(grid), dim3(512), LDS_BYTES, stream, p);
}
```

```cpp
#include <hip/hip_runtime.h>
#include <cstdio>
#include <cstdint>

namespace pg8 {
#define PG8_LAS __attribute__((address_space(3)))
typedef unsigned short bf16_t;
typedef short bf16x8 __attribute__((ext_vector_type(8)));
typedef float f32x4 __attribute__((ext_vector_type(4)));
typedef unsigned u32x4 __attribute__((ext_vector_type(4)));
constexpr int BM = 256, BK = 64, HALF = 128, HTB = HALF * BK * 2  , STAGE_BYTES = 8 * HTB, NXCD = 8, WGM = 8;

__host__ __device__ __forceinline__ int lds_byte(int r, int c) { const int st = (r >> 4) * 2 + (c >> 5), rr = r & 15, cc = c & 31, ob = rr * 64 + cc * 2; return st * 1024 + (ob ^ (((ob >> 9) & 1) << 5)); }
__host__ __device__ __forceinline__ void stage_rc(int b, int& R, int& C) { const int st = b / 1024, sb = b % 1024, swz = sb ^ (((sb >> 9) & 1) << 5); R = (st >> 1) * 16 + swz / 64; C = (st & 1) * 32 + (swz % 64) / 2; }
__host__ __device__ __forceinline__ int perm32(int rho) { const int n = rho >> 4, i = rho & 15; return 8 * (i >> 2) + 4 * n + (i & 3); }

struct Unit { int pm, pn, brow; };
struct Gemm { const bf16_t* A; const bf16_t* Bt; int M, N, K; };

struct StaticOrder {
    int nM, nN, nwg, G, c;
    __host__ __device__ void init(int M, int N, int K, int G_, int c_) { nM = M / BM; nN = N / BM; nwg = nM * nN; G = G_; c = c_; }
    __host__ __device__ bool next(int i, Unit& u) const {
        const long L = (long)i * G + c; if (L >= nwg) return false;
        int wgid = (int)L; { const int q = nwg / NXCD, r = nwg % NXCD, xcd = wgid % NXCD, off = wgid / NXCD; wgid = (xcd < r ? xcd * (q + 1) : r * (q + 1) + (xcd - r) * q) + off; }
        const int nig = WGM * nN, gid = wgid / nig, fm = gid * WGM, gsz = (nM - fm) < WGM ? (nM - fm) : WGM;
        u.pm = fm + ((wgid % nig) % gsz); u.pn = (wgid % nig) / gsz; u.brow = u.pn; return true;
    }
    __device__ __forceinline__ void a_ready(const Unit&) const {}
    __device__ __forceinline__ void done(const Unit&) const {}
};
struct GroupedOrder {
    const int* tile_e; int ntiles, nN, G, c;
    __device__ bool next(int i, Unit& u) const {
        const int L = i * G + c; if (L >= ntiles * nN) return false;
        u.pm = L / nN; u.pn = L % nN;
        u.brow = __builtin_amdgcn_readfirstlane(tile_e[u.pm]) * nN + u.pn; return true;
    }
    __device__ __forceinline__ void a_ready(const Unit&) const {}
    __device__ __forceinline__ void done(const Unit&) const {}
};

__device__ __forceinline__ unsigned cvt_pk_bf16(float lo, float hi) { unsigned r; asm volatile("v_cvt_pk_bf16_f32 %0, %1, %2" : "=v"(r) : "v"(lo), "v"(hi)); return r; }

template <class Epi, class Sched, bool ALIGN_EPI = false, bool SP2 = false>
__device__ __forceinline__ void gemm_phase(PG8_LAS unsigned char* lds, const Gemm g, const Sched& S, const Epi& E) {
    int tid_ = threadIdx.x; asm volatile("" : "+v"(tid_));
    const int tid = tid_, wid = __builtin_amdgcn_readfirstlane(tid >> 6), lane = tid & 63, wr = wid >> 2, wc = wid & 3, fr = lane & 15, fq = lane >> 4;
    const int K = g.K, nt = K / BK;
    unsigned voffA[2], voffB[2];
#pragma unroll
    for (int i = 0; i < 2; ++i) { int R, C; stage_rc(tid * 16 + i * 8192, R, C); const int Rb = Epi::PERM ? ((R & ~31) + perm32(R & 31)) : R;
        voffA[i] = (unsigned)(R * K + C) * 2u; voffB[i] = (unsigned)(Rb * K + C) * 2u; }
    const size_t kstep = (size_t)(BK * 2);
    const size_t hstep = (size_t)HALF * K * 2;
    const unsigned ldsw = (unsigned)wid * 1024u;
    const int aoff = lds_byte(wr * 64 + fr, fq * 8), boff = lds_byte(wc * 32 + fr, fq * 8);
#define PG8_SA(b, h) (((b) * 2 + (h)) * HTB)
#define PG8_SB(b, h) ((4 + (b) * 2 + (h)) * HTB)
#define PG8_STAGE(bufoff, gbase, voff) do { _Pragma("unroll") for (int _i = 0; _i < 2; ++_i) \
        __builtin_amdgcn_global_load_lds((const unsigned*)((const char*)(gbase) + (voff)[_i]), (PG8_LAS unsigned*)(lds + (bufoff) + ldsw + _i * 8192), 16, 0, 0); } while (0)
#define PG8_LDA(dst, b, h) do { _Pragma("unroll") for (int m = 0; m < 4; ++m) _Pragma("unroll") for (int k = 0; k < 2; ++k) dst[m][k] = *(const PG8_LAS bf16x8*)(lds + PG8_SA(b, h) + aoff + m * 2048 + k * 1024); } while (0)
#define PG8_LDB(dst, b, h) do { _Pragma("unroll") for (int n = 0; n < 2; ++n) _Pragma("unroll") for (int k = 0; k < 2; ++k) dst[n][k] = *(const PG8_LAS bf16x8*)(lds + PG8_SB(b, h) + boff + n * 2048 + k * 1024); } while (0)
#define PG8_MMA(ai, bj, At, Bt) do { __builtin_amdgcn_s_setprio(1); _Pragma("unroll") for (int m = 0; m < 4; ++m) _Pragma("unroll") for (int n = 0; n < 2; ++n) _Pragma("unroll") for (int k = 0; k < 2; ++k) \
        acc[ai][bj][m][n] = __builtin_amdgcn_mfma_f32_16x16x32_bf16(Bt[n][k], At[m][k], acc[ai][bj][m][n], 0, 0, 0); __builtin_amdgcn_s_setprio(0); } while (0)
#define PG8_WAIT_V(n) asm volatile("s_waitcnt vmcnt(" #n ")" ::: "memory")
#define PG8_WAIT_L(n) asm volatile("s_waitcnt lgkmcnt(" #n ")" ::: "memory")
#define PG8_BAR __builtin_amdgcn_s_barrier()
#define PG8_SCHED __builtin_amdgcn_sched_barrier(0)
    Unit cur, nxt; int ui = 0;
    if (!S.next(0, cur)) return;
    f32x4 acc[2][2][4][2];
#pragma unroll
    for (int a = 0; a < 2; ++a)
#pragma unroll
        for (int b = 0; b < 2; ++b)
#pragma unroll
            for (int m = 0; m < 4; ++m)
#pragma unroll
                for (int n = 0; n < 2; ++n) acc[a][b][m][n] = (f32x4){0.f, 0.f, 0.f, 0.f};
    bf16x8 At[4][2], B0[2][2], B1[2][2];
    const size_t tstep = 2 * hstep;
    const char* cA = (const char*)g.A + (size_t)cur.pm * tstep; const char* cB = (const char*)g.Bt + (size_t)cur.brow * tstep;
    S.a_ready(cur);
    if constexpr (SP2) {
        PG8_STAGE(PG8_SB(0, 0), cB, voffB); PG8_STAGE(PG8_SB(0, 1), cB + hstep, voffB); PG8_STAGE(PG8_SA(0, 0), cA, voffA); PG8_STAGE(PG8_SA(0, 1), cA + hstep, voffA);
        if (wr == 1) PG8_BAR;
        PG8_WAIT_V(2); PG8_BAR;
        PG8_STAGE(PG8_SB(1, 0), cB + kstep, voffB); PG8_STAGE(PG8_SA(1, 0), cA + kstep, voffA); PG8_STAGE(PG8_SB(1, 1), cB + hstep + kstep, voffB);
        PG8_WAIT_V(6); PG8_BAR;
    } else {
        PG8_STAGE(PG8_SB(0, 0), cB, voffB); PG8_STAGE(PG8_SA(0, 0), cA, voffA); PG8_STAGE(PG8_SB(0, 1), cB + hstep, voffB); PG8_STAGE(PG8_SA(0, 1), cA + hstep, voffA);
        if (wr == 1) PG8_BAR;
        PG8_WAIT_V(4); PG8_BAR;
        PG8_STAGE(PG8_SB(1, 0), cB + kstep, voffB); PG8_STAGE(PG8_SA(1, 0), cA + kstep, voffA); PG8_STAGE(PG8_SB(1, 1), cB + hstep + kstep, voffB);
        PG8_WAIT_V(6); PG8_BAR;
    }
    for (;;) {
        const bool has_next = S.next(ui + 1, nxt);
        const char* nA = has_next ? (const char*)g.A + (size_t)nxt.pm * tstep : cA; const char* nB = has_next ? (const char*)g.Bt + (size_t)nxt.brow * tstep : cB;
        for (int t = 0; t < nt; t += 2) {
            const bool last = (t == nt - 2);
            const char* a1 = cA + (size_t)(t + 1) * kstep;
            const char* a2 = last ? nA : cA + (size_t)(t + 2) * kstep; const char* b2 = last ? nB : cB + (size_t)(t + 2) * kstep;
            const char* a3 = a2 + kstep; const char* b3 = b2 + kstep;
            if (last && has_next) S.a_ready(nxt);
            if constexpr (SP2) {
            PG8_LDB(B0, 0, 0); PG8_LDB(B1, 0, 1); PG8_SCHED; PG8_LDA(At, 0, 0); PG8_STAGE(PG8_SA(1, 1), a1 + hstep, voffA);
            PG8_WAIT_V(8); PG8_WAIT_L(0); PG8_BAR; PG8_MMA(0, 0, At, B0); PG8_MMA(0, 1, At, B1); PG8_BAR; PG8_SCHED;
            PG8_LDA(At, 0, 1); PG8_STAGE(PG8_SB(0, 0), b2, voffB); PG8_STAGE(PG8_SB(0, 1), b2 + hstep, voffB); PG8_STAGE(PG8_SA(0, 0), a2, voffA);
            PG8_WAIT_V(8); PG8_WAIT_L(0); PG8_BAR; PG8_MMA(1, 0, At, B0); PG8_MMA(1, 1, At, B1); PG8_BAR; PG8_SCHED;
            PG8_LDB(B0, 1, 0); PG8_LDB(B1, 1, 1); PG8_SCHED; PG8_LDA(At, 1, 0); PG8_STAGE(PG8_SA(0, 1), a2 + hstep, voffA);
            PG8_WAIT_V(8); PG8_WAIT_L(0); PG8_BAR; PG8_MMA(0, 0, At, B0); PG8_MMA(0, 1, At, B1); PG8_BAR; PG8_SCHED;
            PG8_LDA(At, 1, 1); PG8_STAGE(PG8_SB(1, 0), b3, voffB); PG8_STAGE(PG8_SB(1, 1), b3 + hstep, voffB); PG8_STAGE(PG8_SA(1, 0), a3, voffA);
            PG8_WAIT_V(8); PG8_WAIT_L(0); PG8_BAR; PG8_MMA(1, 0, At, B0); PG8_MMA(1, 1, At, B1); PG8_BAR; PG8_SCHED;
            } else {
            PG8_LDB(B0, 0, 0); PG8_SCHED; PG8_LDA(At, 0, 0); PG8_STAGE(PG8_SA(1, 1), a1 + hstep, voffA);
            PG8_WAIT_L(8); PG8_BAR; PG8_WAIT_L(0); PG8_MMA(0, 0, At, B0); PG8_BAR; PG8_SCHED;
            PG8_LDB(B1, 0, 1); PG8_STAGE(PG8_SB(0, 0), b2, voffB);
            PG8_BAR; PG8_WAIT_L(0); PG8_MMA(0, 1, At, B1); PG8_BAR;
            PG8_LDA(At, 0, 1); PG8_STAGE(PG8_SA(0, 0), a2, voffA);
            PG8_BAR; PG8_WAIT_L(0); PG8_MMA(1, 0, At, B0); PG8_BAR; PG8_SCHED;
            PG8_STAGE(PG8_SB(0, 1), b2 + hstep, voffB);
            PG8_WAIT_V(6); PG8_BAR; PG8_MMA(1, 1, At, B1); PG8_BAR;
            PG8_LDB(B0, 1, 0); PG8_SCHED; PG8_LDA(At, 1, 0); PG8_STAGE(PG8_SA(0, 1), a2 + hstep, voffA);
            PG8_WAIT_L(8); PG8_BAR; PG8_WAIT_L(0); PG8_MMA(0, 0, At, B0); PG8_BAR; PG8_SCHED;
            PG8_LDB(B1, 1, 1); PG8_STAGE(PG8_SB(1, 0), b3, voffB);
            PG8_BAR; PG8_WAIT_L(0); PG8_MMA(0, 1, At, B1); PG8_BAR;
            PG8_LDA(At, 1, 1); PG8_STAGE(PG8_SA(1, 0), a3, voffA);
            PG8_BAR; PG8_WAIT_L(0); PG8_MMA(1, 0, At, B0); PG8_BAR; PG8_SCHED;
            PG8_STAGE(PG8_SB(1, 1), b3 + hstep, voffB);
            PG8_WAIT_V(6); PG8_BAR; PG8_MMA(1, 1, At, B1); PG8_BAR;
            }
        }
        if constexpr (ALIGN_EPI) { if (wr == 0) PG8_BAR; }
        if constexpr (!Epi::AFTER_DRAIN) { E(acc, cur, wr, wc, fr, fq); S.done(cur); }
        if (!has_next) break;
#pragma unroll
        for (int a = 0; a < 2; ++a)
#pragma unroll
            for (int b = 0; b < 2; ++b)
#pragma unroll
                for (int m = 0; m < 4; ++m)
#pragma unroll
                    for (int n = 0; n < 2; ++n) acc[a][b][m][n] = (f32x4){0.f, 0.f, 0.f, 0.f};
        cur = nxt; cA = nA; cB = nB; ++ui;
        if constexpr (ALIGN_EPI) { if (wr == 1) PG8_BAR; }
    }
    PG8_WAIT_V(0);
    if constexpr (!ALIGN_EPI) { if (wr == 0) PG8_BAR; }
    PG8_BAR;
    if constexpr (Epi::AFTER_DRAIN) { E.fused(acc, cur, wr, wc, fr, fq, lds, wid, lane); S.done(cur); }
#undef PG8_SA
#undef PG8_SB
#undef PG8_STAGE
#undef PG8_LDA
#undef PG8_LDB
#undef PG8_MMA
#undef PG8_WAIT_V
#undef PG8_WAIT_L
#undef PG8_BAR
#undef PG8_SCHED
}
}

using pg8::bf16_t; using pg8::bf16x8; using pg8::f32x4; using pg8::u32x4; using pg8::Unit;
typedef float f32x2 __attribute__((ext_vector_type(2)));
typedef unsigned u32x2 __attribute__((ext_vector_type(2)));
#define LAS __attribute__((address_space(3)))

constexpr int NB = 2, SEQ = 8192, T = NB * SEQ, D = 1024;
constexpr int EVEN_IN = 2560, ODD_IN = 5120;
constexpr int NEXP = 16, DEXP = 512;
constexpr int PMAX = 36864;
constexpr int MAXTILES = PMAX / 256;
constexpr float DN_ALPHA = 1.41421356237f;
constexpr float LN_EPS = 1e-5f, RMS_EPS = 1e-6f;

constexpr size_t MiB = 1u << 20;
constexpr size_t WS_CTL = 0, CTL_BYTES = 1 * MiB;
constexpr size_t WS_ROPE = 1 * MiB;
constexpr size_t WS_LBV = 3 * MiB;
constexpr size_t WS_WINE = 4 * MiB;
constexpr size_t WS_WOUTE = 9 * MiB;
constexpr size_t WS_WINO = 11 * MiB;
constexpr size_t WS_WOUTO = 21 * MiB;
constexpr size_t WS_LGT = 23 * MiB;
constexpr size_t WS_HB = 24 * MiB;
constexpr size_t WS_PROJ = 56 * MiB;
constexpr size_t WS_XS = WS_PROJ;
constexpr size_t WS_HID = WS_PROJ + 72 * MiB;
constexpr size_t WS_RB = WS_PROJ + 80 * MiB;
constexpr size_t WS_MIX1 = 216 * MiB;
constexpr size_t WS_SCR = WS_PROJ + 80 * MiB;
constexpr size_t WS_WGU = 216 * MiB;
constexpr size_t WS_WD = 248 * MiB;
constexpr size_t WS_TOK = 3 * MiB + 65536;
constexpr size_t WS_END = 282 * MiB;
constexpr int CW_COUNTS = 1024;
constexpr int CW_CURSOR = 1024 + 64;
constexpr int CW_NTILES = 1024 + 128;
constexpr int CW_TILEE = 2048;
constexpr size_t TOK_E = 0, TOK_G = 128 * 1024, TOK_SLOT = 256 * 1024, TOK_BH = 384 * 1024;

struct Params {
    const float* x; const float* w_in_even; const float* w_out_even; const float* conv_w; const float* conv_b; const float* gate_w; const float* gate_b; const float* lam;
    const float* w_in_odd; const float* w_out_odd; const float* lower_bounds; const float* norm_w; const float* ln_w; const float* ln_b; const float* router_w;
    const float* moe_gate; const float* moe_up; const float* moe_down;
    float* out; unsigned char* ws;
};

__device__ __forceinline__ float bf2f(unsigned b) { return __uint_as_float(b << 16); }
__device__ __forceinline__ float bflo(unsigned u) { return __uint_as_float(u << 16); }
__device__ __forceinline__ float bfhi(unsigned u) { return __uint_as_float(u & 0xffff0000u); }
__device__ __forceinline__ unsigned f2bf(float f) { unsigned u = __float_as_uint(f); return (u + 0x7fffu + ((u >> 16) & 1u)) >> 16; }
__device__ __forceinline__ unsigned pk2(float lo, float hi) { return f2bf(lo) | (f2bf(hi) << 16); }
__device__ __forceinline__ float sigm(float x) { return 1.f / (1.f + __expf(-x)); }
__device__ __forceinline__ float silu(float x) { return x / (1.f + __expf(-x)); }
__device__ __forceinline__ float gelu_tanh(float x) { const float u = 0.7978845608028654f * (x + 0.044715f * x * x * x); return x / (1.f + __expf(-2.f * u)); }
__device__ __forceinline__ float wave_sum(float v) {
#pragma unroll
    for (int o = 1; o < 64; o <<= 1) v += __shfl_xor(v, o);
    return v;
}
#define LDS_WAIT() asm volatile("s_waitcnt lgkmcnt(0)" ::: "memory")
typedef __bf16 bf16x2_t __attribute__((ext_vector_type(2)));
__device__ __forceinline__ unsigned cvtpk(float lo, float hi) { const f32x2 v = {lo, hi}; const bf16x2_t b = __builtin_convertvector(v, bf16x2_t); return __builtin_bit_cast(unsigned, b); }

__device__ __forceinline__ void store8bf(bf16_t* p, const f32x4& v0, const f32x4& v1) {
    u32x4 w; w.x = cvtpk(v0[0], v0[1]); w.y = cvtpk(v0[2], v0[3]); w.z = cvtpk(v1[0], v1[1]); w.w = cvtpk(v1[2], v1[3]);
    *(u32x4*)p = w;
}
struct EpiInproj0 {
    static constexpr bool PERM = true, AFTER_DRAIN = false;
    bf16_t* O; const float* rope;
    __device__ __forceinline__ void operator()(const f32x4 (&acc)[2][2][4][2], const Unit& u, int wr, int wc, int fr, int fq) const {
        const int row0 = u.pm * 256 + wr * 64 + fr, colt = u.pn * 256 + wc * 32 + 8 * fq;
#pragma unroll
        for (int ai = 0; ai < 2; ++ai)
#pragma unroll
            for (int m = 0; m < 4; ++m) {
                const int row = row0 + ai * 128 + m * 16; const int pos = row & (SEQ - 1);
#pragma unroll
                for (int bj = 0; bj < 2; ++bj) {
                    const int col = colt + bj * 128;
                    f32x4 v0 = acc[ai][bj][m][0], v1 = acc[ai][bj][m][1];
                    if (u.pn < 2) {
                        const float sc = (col < 256) ? 0.125f : 1.0f;
                        const f32x4* rp = (const f32x4*)(rope + ((size_t)pos * 32 + ((col & 63) >> 1)) * 2);
                        const f32x4 c0 = rp[0], c1 = rp[1];
                        f32x4 r0, r1;
                        r0[0] = (v0[0] * c0[0] - v0[1] * c0[1]) * sc; r0[1] = (v0[0] * c0[1] + v0[1] * c0[0]) * sc;
                        r0[2] = (v0[2] * c0[2] - v0[3] * c0[3]) * sc; r0[3] = (v0[2] * c0[3] + v0[3] * c0[2]) * sc;
                        r1[0] = (v1[0] * c1[0] - v1[1] * c1[1]) * sc; r1[1] = (v1[0] * c1[1] + v1[1] * c1[0]) * sc;
                        r1[2] = (v1[2] * c1[2] - v1[3] * c1[3]) * sc; r1[3] = (v1[2] * c1[3] + v1[3] * c1[2]) * sc;
                        v0 = r0; v1 = r1;
                    }
                    store8bf(O + (size_t)row * EVEN_IN + col, v0, v1);
                }
            }
    }
};
struct EpiInproj1 {
    static constexpr bool PERM = true, AFTER_DRAIN = false;
    bf16_t* O; const float* lbv;
    __device__ __forceinline__ void operator()(const f32x4 (&acc)[2][2][4][2], const Unit& u, int wr, int wc, int fr, int fq) const {
        const int row0 = u.pm * 256 + wr * 64 + fr, colt = u.pn * 256 + wc * 32 + 8 * fq;
        const int seg = u.pn >> 2;
#pragma unroll
        for (int bj = 0; bj < 2; ++bj) {
            const int col = colt + bj * 128;
            f32x4 lb0 = {0.f, 0.f, 0.f, 0.f}, lb1 = {0.f, 0.f, 0.f, 0.f};
            if (seg == 2 || seg == 3) { lb0 = *(const f32x4*)(lbv + (col & 1023)); lb1 = *(const f32x4*)(lbv + (col & 1023) + 4); }
#pragma unroll
            for (int ai = 0; ai < 2; ++ai)
#pragma unroll
                for (int m = 0; m < 4; ++m) {
                    const int row = row0 + ai * 128 + m * 16;
                    f32x4 v0 = acc[ai][bj][m][0], v1 = acc[ai][bj][m][1];
                    if (seg == 0) {
#pragma unroll
                        for (int j = 0; j < 4; ++j) { v0[j] = silu(v0[j]) * 0.08838834764831845f; v1[j] = silu(v1[j]) * 0.08838834764831845f; }
                    } else if (seg == 2 || seg == 3) {
#pragma unroll
                        for (int j = 0; j < 4; ++j) { v0[j] = __logf(lb0[j] + (1.f - lb0[j]) * sigm(v0[j])); v1[j] = __logf(lb1[j] + (1.f - lb1[j]) * sigm(v1[j])); }
                    }
                    store8bf(O + (size_t)row * ODD_IN + col, v0, v1);
                }
        }
    }
};
template <bool RES_BF16> struct EpiResid {
    static constexpr bool PERM = true, AFTER_DRAIN = false;
    const void* res; bf16_t* out;
    __device__ __forceinline__ void operator()(const f32x4 (&acc)[2][2][4][2], const Unit& u, int wr, int wc, int fr, int fq) const {
        const int row0 = u.pm * 256 + wr * 64 + fr, colt = u.pn * 256 + wc * 32 + 8 * fq;
#pragma unroll
        for (int ai = 0; ai < 2; ++ai)
#pragma unroll
            for (int m = 0; m < 4; ++m) {
                const size_t off = (size_t)(row0 + ai * 128 + m * 16) * D + colt;
#pragma unroll
                for (int bj = 0; bj < 2; ++bj) {
                    f32x4 r0, r1;
                    if (RES_BF16) { const u32x4 rv = *(const u32x4*)((const bf16_t*)res + off + bj * 128);
                        r0 = (f32x4){bflo(rv.x), bfhi(rv.x), bflo(rv.y), bfhi(rv.y)}; r1 = (f32x4){bflo(rv.z), bfhi(rv.z), bflo(rv.w), bfhi(rv.w)}; }
                    else { r0 = *(const f32x4*)((const float*)res + off + bj * 128); r1 = *(const f32x4*)((const float*)res + off + bj * 128 + 4); }
                    store8bf(out + off + bj * 128, r0 * DN_ALPHA + acc[ai][bj][m][0], r1 * DN_ALPHA + acc[ai][bj][m][1]);
                }
            }
    }
};
struct EpiGateUp {
    static constexpr bool PERM = true, AFTER_DRAIN = false;
    bf16_t* O;
    __device__ __forceinline__ void operator()(const f32x4 (&acc)[2][2][4][2], const Unit& u, int wr, int wc, int fr, int fq) const {
        const int row0 = u.pm * 256 + wr * 64 + fr, col = u.pn * 128 + wc * 32 + 8 * fq;
#pragma unroll
        for (int ai = 0; ai < 2; ++ai)
#pragma unroll
            for (int m = 0; m < 4; ++m) {
                const int row = row0 + ai * 128 + m * 16;
                f32x4 v0, v1;
#pragma unroll
                for (int j = 0; j < 4; ++j) { v0[j] = silu(acc[ai][0][m][0][j]) * acc[ai][1][m][0][j]; v1[j] = silu(acc[ai][0][m][1][j]) * acc[ai][1][m][1][j]; }
                store8bf(O + (size_t)row * DEXP + col, v0, v1);
            }
    }
};
struct EpiBf16 {
    static constexpr bool PERM = true, AFTER_DRAIN = false;
    bf16_t* O; int ldc;
    __device__ __forceinline__ void operator()(const f32x4 (&acc)[2][2][4][2], const Unit& u, int wr, int wc, int fr, int fq) const {
        const int row0 = u.pm * 256 + wr * 64 + fr, colt = u.pn * 256 + wc * 32 + 8 * fq;
#pragma unroll
        for (int ai = 0; ai < 2; ++ai)
#pragma unroll
            for (int m = 0; m < 4; ++m) {
                const int row = row0 + ai * 128 + m * 16;
#pragma unroll
                for (int bj = 0; bj < 2; ++bj) store8bf(O + (size_t)row * ldc + colt + bj * 128, acc[ai][bj][m][0], acc[ai][bj][m][1]);
            }
    }
};

__device__ __forceinline__ void transpose_item(const float* W, int N, bf16_t* WT, int K, int k0, int n0, int drow0, LAS float* scr, int lane) {
#pragma unroll 8
    for (int i = 0; i < 32; ++i) { const int kk = 2 * i + (lane >> 5); scr[kk * 33 + (lane & 31)] = W[(size_t)(k0 + kk) * N + n0 + (lane & 31)]; }
    LDS_WAIT();
    const int c = lane & 7;
#pragma unroll
    for (int j = 0; j < 4; ++j) { const int n = (lane >> 3) + 8 * j; const LAS float* s = scr + (8 * c) * 33 + n;
        u32x4 o; o.x = pk2(s[0 * 33], s[1 * 33]); o.y = pk2(s[2 * 33], s[3 * 33]); o.z = pk2(s[4 * 33], s[5 * 33]); o.w = pk2(s[6 * 33], s[7 * 33]);
        *(u32x4*)(WT + (size_t)(drow0 + n) * K + k0 + 8 * c) = o; }
    LDS_WAIT();
}
__device__ __forceinline__ void transpose_dense(const float* W, int K, int N, bf16_t* WT, int item, LAS float* scr, int lane) {
    const int nblk = N / 32, kb = item / nblk, nb = item % nblk;
    transpose_item(W, N, WT, K, 64 * kb, 32 * nb, 32 * nb, scr, lane);
}
__device__ __forceinline__ void prologue_static(const Params& p, LAS float* scr, int gw, int ngw, int lane) {
    unsigned char* ws = p.ws;
    constexpr int I_WINE = 16 * 80, I_WOUTE = 16 * 32, I_WINO = 16 * 160, I_WOUTO = 16 * 32, I_LG = 16 * 8;
    constexpr int NITEMS = I_WINE + I_WOUTE + I_WINO + I_WOUTO + I_LG;
    for (int it = gw; it < NITEMS; it += ngw) {
        int r = it;
        if (r < I_WINE) { transpose_dense(p.w_in_even, 1024, EVEN_IN, (bf16_t*)(ws + WS_WINE), r, scr, lane); continue; } r -= I_WINE;
        if (r < I_WOUTE) { transpose_dense(p.w_out_even, 1024, 1024, (bf16_t*)(ws + WS_WOUTE), r, scr, lane); continue; } r -= I_WOUTE;
        if (r < I_WINO) { transpose_dense(p.w_in_odd, 1024, ODD_IN, (bf16_t*)(ws + WS_WINO), r, scr, lane); continue; } r -= I_WINO;
        if (r < I_WOUTO) { transpose_dense(p.w_out_odd, 1024, 1024, (bf16_t*)(ws + WS_WOUTO), r, scr, lane); continue; } r -= I_WOUTO;
        { const int mat = r >> 3, sub = r & 7;
          transpose_dense(p.gate_w + (size_t)mat * 128 * 128, 128, 128, (bf16_t*)(ws + WS_LGT) + (size_t)mat * 128 * 128, sub, scr, lane); }
    }
    { const size_t n8 = (size_t)T * D / 8; bf16_t* xb = (bf16_t*)(ws + WS_HB);
      for (size_t i = (size_t)gw * 64 + lane; i < n8; i += (size_t)ngw * 64) {
          const f32x4 a = *(const f32x4*)(p.x + i * 8), b = *(const f32x4*)(p.x + i * 8 + 4);
          u32x4 o; o.x = pk2(a[0], a[1]); o.y = pk2(a[2], a[3]); o.z = pk2(b[0], b[1]); o.w = pk2(b[2], b[3]);
          *(u32x4*)(xb + i * 8) = o; } }
    { float* rope = (float*)(ws + WS_ROPE);
      for (int i = gw * 64 + lane; i < SEQ * 32; i += ngw * 64) {
          const int pos = i >> 5, fi = i & 31;
          double inv = 0.15915494309189535;
          if (fi & 1) inv *= 0.7498942093324559; if (fi & 2) inv *= 0.5623413251903491; if (fi & 4) inv *= 0.31622776601683794; if (fi & 8) inv *= 0.1; if (fi & 16) inv *= 0.01;
          const double rev = (double)pos * inv; const float fr = (float)(rev - floor(rev));
          rope[2 * i] = __builtin_amdgcn_cosf(fr); rope[2 * i + 1] = __builtin_amdgcn_sinf(fr); }
      float* lbv = (float*)(ws + WS_LBV);
      for (int i = gw * 64 + lane; i < 1024; i += ngw * 64) { const float l0 = p.lower_bounds[i], l1 = p.lower_bounds[1024 + i]; lbv[i] = 1.f / (1.f + __expf(l0 - l1)); } }
}
__device__ __forceinline__ void prologue_moe(const Params& p, int layer, LAS float* scr, int gw, int ngw, int lane) {
    unsigned char* ws = p.ws;
    constexpr int I_GU = 16 * 16, I_D = 8 * 32;
    constexpr int NITEMS = NEXP * (2 * I_GU + I_D);
    for (int it = gw; it < NITEMS; it += ngw) {
        const int e = it / (2 * I_GU + I_D); int r = it % (2 * I_GU + I_D);
        if (r < 2 * I_GU) { const int sel = r / I_GU; r %= I_GU; const int kb = r / 16, nb = r % 16, n0 = 32 * nb;
            const float* W = (sel ? p.moe_up : p.moe_gate) + ((size_t)layer * NEXP + e) * 1024 * 512;
            transpose_item(W, 512, (bf16_t*)(ws + WS_WGU) + (size_t)e * 1024 * 1024, 1024, 64 * kb, n0, 256 * (n0 >> 7) + 128 * sel + (n0 & 127), scr, lane);
        } else { r -= 2 * I_GU;
            const float* W = p.moe_down + ((size_t)layer * NEXP + e) * 512 * 1024;
            transpose_dense(W, 512, 1024, (bf16_t*)(ws + WS_WD) + (size_t)e * 1024 * 512, r, scr, lane); }
    }
}

__device__ __forceinline__ void ln_rows_store(const f32x4 (&v)[4], const float* lw, const float* lb, float* orow, bf16_t* brow, int lane, f32x4 (&h)[4]) {
    float s = 0.f;
#pragma unroll
    for (int j = 0; j < 4; ++j) s += (v[j][0] + v[j][1]) + (v[j][2] + v[j][3]);
    const float mean = wave_sum(s) * (1.f / D); float s2 = 0.f;
#pragma unroll
    for (int j = 0; j < 4; ++j) { const f32x4 d = v[j] - mean; s2 += (d[0] * d[0] + d[1] * d[1]) + (d[2] * d[2] + d[3] * d[3]); }
    const float rstd = 1.f / sqrtf(wave_sum(s2) * (1.f / D) + LN_EPS);
#pragma unroll
    for (int j = 0; j < 4; ++j) { const int c = 4 * lane + 256 * j; const f32x4 w = *(const f32x4*)(lw + c), b = *(const f32x4*)(lb + c);
        h[j] = (v[j] - mean) * rstd * w + b;
        *(f32x4*)(orow + c) = h[j];
        u32x2 o; o.x = pk2(h[j][0], h[j][1]); o.y = pk2(h[j][2], h[j][3]); *(u32x2*)(brow + c) = o; }
}
__device__ __forceinline__ void ln_router_row(const Params& p, int layer, int row, int lane, LAS int* hist) {
    unsigned char* ws = p.ws; float* res = p.out + (size_t)row * D; bf16_t* hb = (bf16_t*)(ws + WS_HB) + (size_t)row * D;
    f32x4 v[4], h[4];
#pragma unroll
    for (int j = 0; j < 4; ++j) v[j] = *(const f32x4*)(res + 4 * lane + 256 * j);
    ln_rows_store(v, p.ln_w + (size_t)(layer * 2 + 0) * D, p.ln_b + (size_t)(layer * 2 + 0) * D, res, hb, lane, h);
    float lg[16];
#pragma unroll
    for (int e = 0; e < 16; ++e) lg[e] = 0.f;
#pragma unroll
    for (int j = 0; j < 4; ++j)
#pragma unroll
        for (int i = 0; i < 4; ++i) { const float* rw = p.router_w + (size_t)(4 * lane + 256 * j + i) * 16; const float hv = h[j][i];
#pragma unroll
            for (int q = 0; q < 4; ++q) { const f32x4 w = *(const f32x4*)(rw + 4 * q); lg[4 * q] += hv * w[0]; lg[4 * q + 1] += hv * w[1]; lg[4 * q + 2] += hv * w[2]; lg[4 * q + 3] += hv * w[3]; } }
#pragma unroll
    for (int e = 0; e < 16; ++e) lg[e] = wave_sum(lg[e]);
    float mx = lg[0];
#pragma unroll
    for (int e = 1; e < 16; ++e) mx = fmaxf(mx, lg[e]);
    float pr[16], sum = 0.f;
#pragma unroll
    for (int e = 0; e < 16; ++e) { pr[e] = __expf(lg[e] - mx); sum += pr[e]; }
    const float inv = 1.f / sum;
#pragma unroll
    for (int e = 0; e < 16; ++e) pr[e] *= inv;
    float best = -1.f; int be0 = 0, be1 = 1; float bv0 = 0.f, bv1 = 0.f;
#pragma unroll
    for (int g = 0; g < 4; ++g) {
        int i1 = 0; float v1 = pr[4 * g];
#pragma unroll
        for (int i = 1; i < 4; ++i) if (pr[4 * g + i] > v1) { v1 = pr[4 * g + i]; i1 = i; }
        int i2 = -1; float v2 = -1.f;
#pragma unroll
        for (int i = 0; i < 4; ++i) if (i != i1 && pr[4 * g + i] > v2) { v2 = pr[4 * g + i]; i2 = i; }
        const float sc = v1 + v2;
        if (sc > best) { best = sc; be0 = 4 * g + i1; be1 = 4 * g + i2; bv0 = v1; bv1 = v2; }
    }
    if (lane == 0) {
        int* te = (int*)(ws + WS_TOK + TOK_E); float* tg = (float*)(ws + WS_TOK + TOK_G);
        te[2 * row] = be0; te[2 * row + 1] = be1; const float gs = 1.f / (bv0 + bv1); tg[2 * row] = bv0 * gs; tg[2 * row + 1] = bv1 * gs;
        atomicAdd((int*)&hist[be0], 1); atomicAdd((int*)&hist[be1], 1);
    }
}
__device__ __forceinline__ void combine_ln_row(const Params& p, int layer, int row, int lane) {
    unsigned char* ws = p.ws; float* res = p.out + (size_t)row * D; bf16_t* hb = (bf16_t*)(ws + WS_HB) + (size_t)row * D;
    const int* tsl = (const int*)(ws + WS_TOK + TOK_SLOT); const float* tg = (const float*)(ws + WS_TOK + TOK_G);
    const int s0 = tsl[2 * row], s1 = tsl[2 * row + 1]; const float g0 = tg[2 * row], g1 = tg[2 * row + 1];
    const bf16_t* y0 = (const bf16_t*)(ws + WS_XS) + (size_t)s0 * D; const bf16_t* y1 = (const bf16_t*)(ws + WS_XS) + (size_t)s1 * D;
    f32x4 v[4], h[4];
#pragma unroll
    for (int j = 0; j < 4; ++j) { const int c = 4 * lane + 256 * j; const f32x4 r = *(const f32x4*)(res + c);
        const u32x2 a = *(const u32x2*)(y0 + c), b = *(const u32x2*)(y1 + c);
        v[j][0] = DN_ALPHA * r[0] + g0 * bflo(a.x) + g1 * bflo(b.x); v[j][1] = DN_ALPHA * r[1] + g0 * bfhi(a.x) + g1 * bfhi(b.x);
        v[j][2] = DN_ALPHA * r[2] + g0 * bflo(a.y) + g1 * bflo(b.y); v[j][3] = DN_ALPHA * r[3] + g0 * bfhi(a.y) + g1 * bfhi(b.y); }
    ln_rows_store(v, p.ln_w + (size_t)(layer * 2 + 1) * D, p.ln_b + (size_t)(layer * 2 + 1) * D, res, hb, lane, h);
}
#define XB_TMO      128
#define XB_XCNT(j)  (256  + 64 * (j))
#define XB_XSUB(j)  (1280 + 64 * (j))
#define XB_XGEN(j)  (2304 + 64 * (j))
#define XB_TOP      3328
#define XB_TOPGEN   3392
#define XCD_BAR_WORDS 3456
#define XB_SPIN_CAP (1u << 18)

__device__ __forceinline__ unsigned xb_ld(unsigned* p)              { return __hip_atomic_load(p, __ATOMIC_RELAXED, __HIP_MEMORY_SCOPE_AGENT); }
__device__ __forceinline__ unsigned xb_add(unsigned* p, unsigned v) { return __hip_atomic_fetch_add(p, v, __ATOMIC_RELAXED, __HIP_MEMORY_SCOPE_AGENT); }
__device__ __forceinline__ unsigned xb_xcc_id() { return (unsigned)__builtin_amdgcn_s_getreg((3 << 11) | 20) & 0xFu; }
#define XB_SPIN(cond, bar) do { unsigned _sp = 0; while (cond) { __builtin_amdgcn_s_sleep(1); \
    if ((++_sp & 255u) == 0u) { if (xb_ld(&(bar)[XB_TMO])) break; if (_sp > XB_SPIN_CAP) { atomicAdd(&(bar)[XB_TMO], 1u); break; } } } } while (0)

struct XcdBarrier {
    unsigned* bar; unsigned x;
    volatile LAS unsigned* st;
};

__device__ __forceinline__ XcdBarrier xcd_barrier_post(unsigned* bar, volatile LAS unsigned* st) {
    XcdBarrier b; b.bar = bar; b.x = xb_xcc_id(); b.st = st;
    if (threadIdx.x == 0) (void)xb_add(&bar[XB_XCNT(b.x)], 1u);
    return b;
}
__device__ __forceinline__ void xcd_barrier_complete(unsigned* bar, unsigned x, unsigned& nloc, unsigned& nx) {
    const unsigned G = gridDim.x * gridDim.y * gridDim.z;
    unsigned sum, cnt, mine, sp = 0u;
    for (;;) {
        sum = 0u; cnt = 0u; mine = 0u;
#pragma unroll
        for (unsigned j = 0; j < 16; ++j) { const unsigned c = xb_ld(&bar[XB_XCNT(j)]); sum += c; cnt += (c > 0u) ? 1u : 0u; mine = (j == x) ? c : mine; }
        if (sum == G) break;
        __builtin_amdgcn_s_sleep(1);
        if ((++sp & 255u) == 0u) { if (xb_ld(&bar[XB_TMO])) break; if (sp > XB_SPIN_CAP) { atomicAdd(&bar[XB_TMO], 1u); break; } }
    }
    nloc = mine > 0u ? mine : 1u; nx = cnt > 0u ? cnt : 1u;
}

__device__ __forceinline__ void xcd_barrier(const XcdBarrier& b) {
    asm volatile("s_waitcnt vmcnt(0)" ::: "memory");
    __syncthreads();
    if (threadIdx.x == 0) {
        unsigned* bar = b.bar;
        __builtin_amdgcn_s_waitcnt(0);
        unsigned nloc = b.st[0], nx = b.st[1];
        if (nloc == 0u) { xcd_barrier_complete(bar, b.x, nloc, nx); b.st[0] = nloc; b.st[1] = nx; }
        const unsigned old = xb_add(&bar[XB_XSUB(b.x)], 1u);
        const unsigned gen = old / nloc;
        if (old + 1u == (gen + 1u) * nloc) {
            __builtin_amdgcn_fence(__ATOMIC_RELEASE, "agent");
            asm volatile("s_waitcnt vmcnt(0)" ::: "memory");
            const unsigned og = xb_add(&bar[XB_TOP], 1u);
            const unsigned tg = og / nx;
            if (og + 1u == (tg + 1u) * nx) xb_add(&bar[XB_TOPGEN], 1u);
            else XB_SPIN(xb_ld(&bar[XB_TOPGEN]) == tg, bar);
            __builtin_amdgcn_fence(__ATOMIC_ACQUIRE, "agent");
            xb_add(&bar[XB_XGEN(b.x)], 1u);
            asm volatile("s_waitcnt vmcnt(0)" ::: "memory");
        } else {
            XB_SPIN(xb_ld(&bar[XB_XGEN(b.x)]) == gen, bar);
            __builtin_amdgcn_fence(__ATOMIC_ACQUIRE, "agent");
            asm volatile("s_waitcnt vmcnt(0)" ::: "memory");
        }
    }
    __syncthreads();
}

template <bool F32OUT> __device__ __forceinline__ void ln_rows_inplace(f32x4 (&v)[4], const float* lw, const float* lb, float* orow, bf16_t* brow, int lane) {
    float s = 0.f;
#pragma unroll
    for (int j = 0; j < 4; ++j) s += (v[j][0] + v[j][1]) + (v[j][2] + v[j][3]);
    const float mean = wave_sum(s) * (1.f / D); float s2 = 0.f;
#pragma unroll
    for (int j = 0; j < 4; ++j) { const f32x4 d = v[j] - mean; s2 += (d[0] * d[0] + d[1] * d[1]) + (d[2] * d[2] + d[3] * d[3]); }
    const float rstd = 1.f / sqrtf(wave_sum(s2) * (1.f / D) + LN_EPS);
#pragma unroll
    for (int j = 0; j < 4; ++j) { const int c = 4 * lane + 256 * j; const f32x4 w = *(const f32x4*)(lw + c), b = *(const f32x4*)(lb + c);
        v[j] = (v[j] - mean) * rstd * w + b;
        if (F32OUT) *(f32x4*)(orow + c) = v[j];
        else { u32x2 o; o.x = cvtpk(v[j][0], v[j][1]); o.y = cvtpk(v[j][2], v[j][3]); *(u32x2*)(brow + c) = o; } }
}
__device__ __forceinline__ float reduce16(const float (&v)[16], int lane) {
    const bool b3 = (lane & 8) != 0, b2 = (lane & 4) != 0, b1 = (lane & 2) != 0, b0 = (lane & 1) != 0;
    float a8[8], a4[4], a2[2];
#pragma unroll
    for (int i = 0; i < 8; ++i) { const float keep = b3 ? v[8 + i] : v[i], send = b3 ? v[i] : v[8 + i]; a8[i] = keep + __shfl_xor(send, 8); }
#pragma unroll
    for (int i = 0; i < 4; ++i) { const float keep = b2 ? a8[4 + i] : a8[i], send = b2 ? a8[i] : a8[4 + i]; a4[i] = keep + __shfl_xor(send, 4); }
#pragma unroll
    for (int i = 0; i < 2; ++i) { const float keep = b1 ? a4[2 + i] : a4[i], send = b1 ? a4[i] : a4[2 + i]; a2[i] = keep + __shfl_xor(send, 2); }
    float a1 = (b0 ? a2[1] : a2[0]) + __shfl_xor(b0 ? a2[0] : a2[1], 1);
    a1 += __shfl_xor(a1, 16); a1 += __shfl_xor(a1, 32);
    return a1;
}
template <int R> __device__ __forceinline__ void ln_router_rows(const Params& p, int layer, int row0, int lane, LAS int* hist) {
    unsigned char* ws = p.ws;
    const float* lw = p.ln_w + (size_t)(layer * 2 + 0) * D; const float* lb = p.ln_b + (size_t)(layer * 2 + 0) * D;
    f32x4 h[R][4];
#pragma unroll
    for (int rr = 0; rr < R; ++rr)
#pragma unroll
        for (int j = 0; j < 4; ++j) { const u32x2 rv = *(const u32x2*)((const bf16_t*)(ws + WS_RB) + (size_t)(row0 + rr) * D + 4 * lane + 256 * j); h[rr][j] = (f32x4){bflo(rv.x), bfhi(rv.x), bflo(rv.y), bfhi(rv.y)}; }
#pragma unroll
    for (int rr = 0; rr < R; ++rr) ln_rows_inplace<false>(h[rr], lw, lb, nullptr, (bf16_t*)(ws + WS_HB) + (size_t)(row0 + rr) * D, lane);
    float lg[R][16];
#pragma unroll
    for (int rr = 0; rr < R; ++rr)
#pragma unroll
        for (int e = 0; e < 16; ++e) lg[rr][e] = 0.f;
#pragma unroll
    for (int j = 0; j < 4; ++j)
#pragma unroll
        for (int i = 0; i < 4; ++i) {
            const float* rw = p.router_w + (size_t)(4 * lane + 256 * j + i) * 16;
            const f32x4 w0 = *(const f32x4*)(rw), w1 = *(const f32x4*)(rw + 4), w2 = *(const f32x4*)(rw + 8), w3 = *(const f32x4*)(rw + 12);
#pragma unroll
            for (int rr = 0; rr < R; ++rr) { const float hv = h[rr][j][i];
                lg[rr][0] += hv * w0[0]; lg[rr][1] += hv * w0[1]; lg[rr][2] += hv * w0[2]; lg[rr][3] += hv * w0[3];
                lg[rr][4] += hv * w1[0]; lg[rr][5] += hv * w1[1]; lg[rr][6] += hv * w1[2]; lg[rr][7] += hv * w1[3];
                lg[rr][8] += hv * w2[0]; lg[rr][9] += hv * w2[1]; lg[rr][10] += hv * w2[2]; lg[rr][11] += hv * w2[3];
                lg[rr][12] += hv * w3[0]; lg[rr][13] += hv * w3[1]; lg[rr][14] += hv * w3[2]; lg[rr][15] += hv * w3[3]; }
        }
    float tot[R];
#pragma unroll
    for (int rr = 0; rr < R; ++rr) tot[rr] = reduce16(lg[rr], lane);
#pragma unroll
    for (int rr = 0; rr < R; ++rr) {
        float lgs[16];
#pragma unroll
        for (int e = 0; e < 16; ++e) lgs[e] = __builtin_bit_cast(float, __builtin_amdgcn_readlane(__builtin_bit_cast(int, tot[rr]), e));
        float mx = lgs[0];
#pragma unroll
        for (int e = 1; e < 16; ++e) mx = fmaxf(mx, lgs[e]);
        float pr[16], sum = 0.f;
#pragma unroll
        for (int e = 0; e < 16; ++e) { pr[e] = __expf(lgs[e] - mx); sum += pr[e]; }
        const float inv = 1.f / sum;
#pragma unroll
        for (int e = 0; e < 16; ++e) pr[e] *= inv;
        float best = -1.f; int be0 = 0, be1 = 1; float bv0 = 0.f, bv1 = 0.f;
#pragma unroll
        for (int g = 0; g < 4; ++g) {
            int i1 = 0; float v1 = pr[4 * g];
#pragma unroll
            for (int i = 1; i < 4; ++i) if (pr[4 * g + i] > v1) { v1 = pr[4 * g + i]; i1 = i; }
            int i2 = -1; float v2 = -1.f;
#pragma unroll
            for (int i = 0; i < 4; ++i) if (i != i1 && pr[4 * g + i] > v2) { v2 = pr[4 * g + i]; i2 = i; }
            const float sc = v1 + v2;
            if (sc > best) { best = sc; be0 = 4 * g + i1; be1 = 4 * g + i2; bv0 = v1; bv1 = v2; }
        }
        if (lane == 0) {
            const int row = row0 + rr;
            int* te = (int*)(ws + WS_TOK + TOK_E); float* tg = (float*)(ws + WS_TOK + TOK_G);
            te[2 * row] = be0; te[2 * row + 1] = be1; const float gs = 1.f / (bv0 + bv1); tg[2 * row] = bv0 * gs; tg[2 * row + 1] = bv1 * gs;
            atomicAdd((int*)&hist[be0], 1); atomicAdd((int*)&hist[be1], 1);
        }
    }
}
template <bool FINAL> __device__ __forceinline__ void combine_ln_rows4(const Params& p, int layer, int row0, int lane) {
    unsigned char* ws = p.ws;
    const int* tsl = (const int*)(ws + WS_TOK + TOK_SLOT); const float* tg = (const float*)(ws + WS_TOK + TOK_G);
    f32x4 v[4][4];
#pragma unroll
    for (int rr = 0; rr < 4; ++rr) {
        const int row = row0 + rr;
        const int s0 = tsl[2 * row], s1 = tsl[2 * row + 1]; const float g0 = tg[2 * row], g1 = tg[2 * row + 1];
        const bf16_t* y0 = (const bf16_t*)(ws + WS_XS) + (size_t)s0 * D; const bf16_t* y1 = (const bf16_t*)(ws + WS_XS) + (size_t)s1 * D;
#pragma unroll
        for (int j = 0; j < 4; ++j) { const int c = 4 * lane + 256 * j; const u32x2 rq = *(const u32x2*)((const bf16_t*)(ws + WS_HB) + (size_t)row * D + c); const f32x4 r = {bflo(rq.x), bfhi(rq.x), bflo(rq.y), bfhi(rq.y)};
            const u32x2 a = *(const u32x2*)(y0 + c), b = *(const u32x2*)(y1 + c);
            v[rr][j][0] = DN_ALPHA * r[0] + g0 * bflo(a.x) + g1 * bflo(b.x); v[rr][j][1] = DN_ALPHA * r[1] + g0 * bfhi(a.x) + g1 * bfhi(b.x);
            v[rr][j][2] = DN_ALPHA * r[2] + g0 * bflo(a.y) + g1 * bflo(b.y); v[rr][j][3] = DN_ALPHA * r[3] + g0 * bfhi(a.y) + g1 * bfhi(b.y); }
    }
#pragma unroll
    for (int rr = 0; rr < 4; ++rr)
        ln_rows_inplace<FINAL>(v[rr], p.ln_w + (size_t)(layer * 2 + 1) * D, p.ln_b + (size_t)(layer * 2 + 1) * D, p.out + (size_t)(row0 + rr) * D, (bf16_t*)(ws + WS_HB) + (size_t)(row0 + rr) * D, lane);
}

constexpr int STAGE_LDS = 131072;
constexpr int MISC_OFF = STAGE_LDS + 320;
constexpr int LDS_BYTES = 147456;
constexpr int CW_BAR = 4096;

__device__ __forceinline__ void ph_inproj0(const Params& p, PG8_LAS unsigned char* lds, int bid, int nb) {
    pg8::Gemm g{(const bf16_t*)(p.ws + WS_HB), (const bf16_t*)(p.ws + WS_WINE), T, EVEN_IN, D};
    pg8::StaticOrder S; S.init(T, EVEN_IN, D, nb, bid);
    EpiInproj0 E{(bf16_t*)(p.ws + WS_PROJ), (const float*)(p.ws + WS_ROPE)};
    pg8::gemm_phase<EpiInproj0, pg8::StaticOrder, true, true>(lds, g, S, E);
}
__device__ __forceinline__ void ph_inproj1(const Params& p, PG8_LAS unsigned char* lds, int bid, int nb) {
    pg8::Gemm g{(const bf16_t*)(p.ws + WS_HB), (const bf16_t*)(p.ws + WS_WINO), T, ODD_IN, D};
    pg8::StaticOrder S; S.init(T, ODD_IN, D, nb, bid);
    EpiInproj1 E{(bf16_t*)(p.ws + WS_PROJ), (const float*)(p.ws + WS_LBV)};
    pg8::gemm_phase<EpiInproj1, pg8::StaticOrder, true, true>(lds, g, S, E);
}
template <int LAYER>
__device__ __forceinline__ void ph_outproj(const Params& p, PG8_LAS unsigned char* lds, int bid, int nb) {
    pg8::Gemm g{(const bf16_t*)(p.ws + (LAYER ? WS_MIX1 : WS_HB)), (const bf16_t*)(p.ws + (LAYER ? WS_WOUTO : WS_WOUTE)), T, D, D};
    pg8::StaticOrder S; S.init(T, D, D, nb, bid);
    EpiResid<LAYER != 0> E{LAYER ? (const void*)(p.ws + WS_HB) : (const void*)p.x, (bf16_t*)(p.ws + WS_RB)};
    pg8::gemm_phase<EpiResid<LAYER != 0>, pg8::StaticOrder, true, true>(lds, g, S, E);
}
__device__ __forceinline__ void ph_moe_gateup(const Params& p, int layer, PG8_LAS unsigned char* lds, int bid, int nb) {
    const unsigned* ctl = (const unsigned*)(p.ws + WS_CTL);
    pg8::Gemm g{(const bf16_t*)(p.ws + WS_XS), (const bf16_t*)(p.ws + WS_WGU), PMAX, 1024, D};
    pg8::GroupedOrder S; S.tile_e = (const int*)(ctl + CW_TILEE + 256 * layer); S.ntiles = __builtin_amdgcn_readfirstlane((int)ctl[CW_NTILES + layer]); S.nN = 4; S.G = nb; S.c = bid;
    EpiGateUp E{(bf16_t*)(p.ws + WS_HID)};
    pg8::gemm_phase<EpiGateUp, pg8::GroupedOrder, true, true>(lds, g, S, E);
}
__device__ __forceinline__ void ph_moe_down(const Params& p, int layer, PG8_LAS unsigned char* lds, int bid, int nb) {
    const unsigned* ctl = (const unsigned*)(p.ws + WS_CTL);
    pg8::Gemm g{(const bf16_t*)(p.ws + WS_HID), (const bf16_t*)(p.ws + WS_WD), PMAX, 1024, DEXP};
    pg8::GroupedOrder S; S.tile_e = (const int*)(ctl + CW_TILEE + 256 * layer); S.ntiles = __builtin_amdgcn_readfirstlane((int)ctl[CW_NTILES + layer]); S.nN = 4; S.G = nb; S.c = bid;
    EpiBf16 E{(bf16_t*)(p.ws + WS_XS), D};
    pg8::gemm_phase<EpiBf16, pg8::GroupedOrder, true, true>(lds, g, S, E);
}

__device__ __forceinline__ void ph_ret_naive(const Params& p, int tid, int bid) {
    const int vb = bid * 4 + (tid >> 7); if (vb >= 16) return;
    const int dir = vb & 1, bh = vb >> 1, b = bh >> 2, h = bh & 3, e = tid & 127;
    const bf16_t* proj = (const bf16_t*)(p.ws + WS_PROJ);
    float* O = (float*)(p.ws + WS_SCR) + (size_t)dir * T * 512;
    const float gamma = 1.f - exp2f(-5.f - (float)h);
    float S[64];
#pragma unroll
    for (int d = 0; d < 64; ++d) S[d] = 0.f;
    for (int step = 0; step < SEQ; ++step) {
        const int t = dir ? SEQ - 1 - step : step; const size_t row = (size_t)b * SEQ + t;
        const bf16_t* pr = proj + row * EVEN_IN;
        const float v = bf2f(pr[512 + h * 128 + e]);
        float o = 0.f;
#pragma unroll
        for (int c = 0; c < 8; ++c) {
            const u32x4 qq = *(const u32x4*)(pr + h * 64 + 8 * c), kk = *(const u32x4*)(pr + 256 + h * 64 + 8 * c);
            const unsigned qa[4] = {qq.x, qq.y, qq.z, qq.w}, ka[4] = {kk.x, kk.y, kk.z, kk.w};
#pragma unroll
            for (int j = 0; j < 4; ++j) {
                const float q0 = bflo(qa[j]), q1 = bfhi(qa[j]), k0 = bflo(ka[j]), k1 = bfhi(ka[j]);
                const int d = 8 * c + 2 * j;
                if (dir == 0) { S[d] = gamma * S[d] + k0 * v; o += q0 * S[d]; S[d + 1] = gamma * S[d + 1] + k1 * v; o += q1 * S[d + 1]; }
                else { const float s0 = gamma * S[d], s1 = gamma * S[d + 1]; o += q0 * s0 + q1 * s1; S[d] = s0 + k0 * v; S[d + 1] = s1 + k1 * v; }
            }
        }
        O[row * 512 + h * 128 + e] = o;
    }
}
__device__ __forceinline__ void ph_ret_norm(const Params& p, int tid, int bid, int nb) {
    const int lane = tid & 63;
    const float* Of = (const float*)(p.ws + WS_SCR); const float* Ob = Of + (size_t)T * 512;
    const bf16_t* proj = (const bf16_t*)(p.ws + WS_PROJ); bf16_t* mix = (bf16_t*)(p.ws + WS_HB);
    for (int gwv = bid * 8 + (tid >> 6); gwv < T * 4; gwv += nb * 8) {
        const int row = gwv >> 2, h = gwv & 3;
        const size_t o = (size_t)row * 512 + h * 128 + 2 * lane;
        const float a0 = Of[o] + Ob[o], a1 = Of[o + 1] + Ob[o + 1];
        const float mean = wave_sum(a0 + a1) * (1.f / 128.f); const float d0 = a0 - mean, d1 = a1 - mean;
        const float rstd = 1.f / sqrtf(wave_sum(d0 * d0 + d1 * d1) * (1.f / 128.f) + LN_EPS);
        const unsigned gg = *(const unsigned*)(proj + (size_t)row * EVEN_IN + 1024 + h * 128 + 2 * lane);
        *(unsigned*)(mix + (size_t)row * D + h * 128 + 2 * lane) = pk2(d0 * rstd * silu(bflo(gg)), d1 * rstd * silu(bfhi(gg)));
    }
}
__device__ __forceinline__ void ph_lru_ab(const Params& p, int tid, LAS float* xc_s, int bid, int nb) {
    const int w = tid;
    const bf16_t* proj = (const bf16_t*)(p.ws + WS_PROJ);
    float* LA = (float*)(p.ws + WS_SCR); float* BV = LA + (size_t)2 * T * 512;
    for (int item = bid; item < T / 8; item += nb) {
        const int t0 = item * 8;
        __syncthreads();
        for (int tt = 0; tt < 8; ++tt) { const int t = t0 + tt, s = t & (SEQ - 1); float a = p.conv_b[w];
#pragma unroll
            for (int j = 0; j < 4; ++j) { const int ss = s + j - 2; if (ss >= 0 && ss < SEQ) a += p.conv_w[j * 512 + w] * bf2f(proj[(size_t)(t + j - 2) * EVEN_IN + 1536 + w]); }
            xc_s[tt * 512 + w] = a; }
        __syncthreads();
        const int n = w >> 7, d = w & 127;
        float g[4][8];
#pragma unroll
        for (int zg = 0; zg < 4; ++zg)
#pragma unroll
            for (int tt = 0; tt < 8; ++tt) g[zg][tt] = 0.f;
        for (int c = 0; c < 128; ++c) {
            float wv[4];
#pragma unroll
            for (int zg = 0; zg < 4; ++zg) wv[zg] = p.gate_w[((size_t)(zg * 4 + n) * 128 + c) * 128 + d];
#pragma unroll
            for (int tt = 0; tt < 8; ++tt) { const float xv = xc_s[tt * 512 + n * 128 + c];
#pragma unroll
                for (int zg = 0; zg < 4; ++zg) g[zg][tt] += xv * wv[zg]; }
        }
#pragma unroll
        for (int z = 0; z < 2; ++z) {
            const float sp = __logf(1.f + __expf(-p.lam[z * 512 + w]));
            const float br = p.gate_b[((z * 2 + 0) * 4 + n) * 128 + d], bi = p.gate_b[((z * 2 + 1) * 4 + n) * 128 + d];
#pragma unroll
            for (int tt = 0; tt < 8; ++tt) {
                const float r = sigm(g[z * 2][tt] + br), ig = sigm(g[z * 2 + 1][tt] + bi);
                const float la = -8.f * r * sp;
                const size_t idx = ((size_t)z * T + t0 + tt) * 512 + w;
                LA[idx] = la; BV[idx] = sqrtf(1.f - __expf(2.f * la)) * ig * xc_s[tt * 512 + w];
            }
        }
    }
}
__device__ __forceinline__ void ph_lru_scan(const Params& p, int tid, int bid) {
    const int gid = bid * 512 + tid; if (gid >= 2048) return;
    const int w = gid & 511, z = (gid >> 9) & 1, b = gid >> 10;
    const float* LA = (const float*)(p.ws + WS_SCR); float* BV = (float*)(p.ws + WS_SCR) + (size_t)2 * T * 512;
    float h = 0.f;
    for (int step = 0; step < SEQ; step += 8) {
        float la[8], bv[8]; size_t idx[8];
#pragma unroll
        for (int i = 0; i < 8; ++i) { const int t = z ? SEQ - 1 - (step + i) : step + i; idx[i] = ((size_t)z * T + (size_t)b * SEQ + t) * 512 + w; la[i] = LA[idx[i]]; bv[i] = BV[idx[i]]; }
#pragma unroll
        for (int i = 0; i < 8; ++i) { h = __expf(la[i]) * h + bv[i]; BV[idx[i]] = h; }
    }
}
__device__ __forceinline__ void ph_lru_out(const Params& p, int tid, int bid, int nb) {
    const int w = tid;
    const float* HS = (const float*)(p.ws + WS_SCR) + (size_t)2 * T * 512;
    const bf16_t* proj = (const bf16_t*)(p.ws + WS_PROJ); bf16_t* mix = (bf16_t*)(p.ws + WS_HB);
    for (int row = bid; row < T; row += nb) {
        const float hs = HS[(size_t)row * 512 + w] + HS[((size_t)T + row) * 512 + w];
        const float gr = bf2f(proj[(size_t)row * EVEN_IN + 2048 + w]);
        mix[(size_t)row * D + 512 + w] = (bf16_t)f2bf(hs * gelu_tanh(gr));
    }
}
__device__ __forceinline__ void ph_gla_naive(const Params& p, int tid, LAS float* sm, int bid) {
    if (bid >= 8) return;
    const int vq = tid >> 7, vb = bid * 4 + vq;
    LAS float* fs = sm + vq * 512; LAS float* qs = fs + 256;
    const int dir = vb & 1, bh = vb >> 1, b = bh >> 3, h = bh & 7, e = tid & 127;
    bf16_t* proj = (bf16_t*)(p.ws + WS_PROJ);
    float S[128];
#pragma unroll
    for (int d = 0; d < 128; ++d) S[d] = 0.f;
    for (int step = 0; step < SEQ; ++step) {
        const int t = dir ? SEQ - 1 - step : step; bf16_t* pr = proj + ((size_t)b * SEQ + t) * ODD_IN;
        const int buf = step & 1;
        fs[buf * 128 + e] = __expf(bf2f(pr[2048 + dir * 1024 + h * 128 + e])); qs[buf * 128 + e] = bf2f(pr[h * 128 + e]);
        const float v = bf2f(pr[1024 + h * 128 + e]);
        __syncthreads();
        float o = 0.f;
#pragma unroll
        for (int d = 0; d < 128; ++d) { const float f = fs[buf * 128 + d]; S[d] = f * S[d] + (1.f - f) * v; o += qs[buf * 128 + d] * S[d]; }
        pr[2048 + dir * 1024 + h * 128 + e] = (bf16_t)f2bf(o);
    }
}
__device__ __forceinline__ void ph_hg_norm(const Params& p, int tid, int bid, int nb) {
    const int lane = tid & 63;
    for (int row = bid * 8 + (tid >> 6); row < T; row += nb * 8) {
        const bf16_t* pr = (const bf16_t*)(p.ws + WS_PROJ) + (size_t)row * ODD_IN; bf16_t* mix = (bf16_t*)(p.ws + WS_MIX1) + (size_t)row * D;
        f32x4 o[4]; float ss = 0.f;
#pragma unroll
        for (int j = 0; j < 4; ++j) { const int c = 4 * lane + 256 * j; const u32x2 a = *(const u32x2*)(pr + 2048 + c), bb = *(const u32x2*)(pr + 3072 + c);
            o[j][0] = bflo(a.x) + bflo(bb.x); o[j][1] = bfhi(a.x) + bfhi(bb.x); o[j][2] = bflo(a.y) + bflo(bb.y); o[j][3] = bfhi(a.y) + bfhi(bb.y);
            ss += (o[j][0] * o[j][0] + o[j][1] * o[j][1]) + (o[j][2] * o[j][2] + o[j][3] * o[j][3]); }
        const float rstd = 1.f / sqrtf(wave_sum(ss) * (1.f / D) + RMS_EPS);
#pragma unroll
        for (int j = 0; j < 4; ++j) { const int c = 4 * lane + 256 * j; const f32x4 nw = *(const f32x4*)(p.norm_w + c); const u32x2 gg = *(const u32x2*)(pr + 4096 + c);
            u32x2 w; w.x = pk2(o[j][0] * rstd * nw[0] * silu(bflo(gg.x)), o[j][1] * rstd * nw[1] * silu(bfhi(gg.x)));
            w.y = pk2(o[j][2] * rstd * nw[2] * silu(bflo(gg.y)), o[j][3] * rstd * nw[3] * silu(bfhi(gg.y)));
            *(u32x2*)(mix + c) = w; }
    }
}
__device__ __forceinline__ void ph_ln_router(const Params& p, int tid, int layer, LAS int* hist, int bid, int nb) {
    const int wave = tid >> 6, lane = tid & 63;
    for (int tb = bid; tb < T / 64; tb += nb) {
        __syncthreads();
        if (tid < 16) hist[tid] = 0;
        __syncthreads();
        for (int i = 0; i < 4; ++i) ln_router_rows<2>(p, layer, tb * 64 + wave * 8 + 2 * i, lane, hist);
        __syncthreads();
        if (tid < 16) ((int*)(p.ws + WS_TOK + TOK_BH))[(layer * 256 + tb) * 16 + tid] = hist[tid];
    }
}
__device__ __forceinline__ void ph_slots(const Params& p, int tid, int layer, LAS int* sm, int bid, int nb) {
    LAS int* tot = sm; LAS int* pre = sm + 16; LAS int* base = sm + 32; LAS int* lslot = sm + 64; LAS int* le = sm + 192;
    unsigned char* ws = p.ws; int* ctl = (int*)(ws + WS_CTL);
    const int* bh = (const int*)(ws + WS_TOK + TOK_BH) + layer * 256 * 16;
    const int* te = (const int*)(ws + WS_TOK + TOK_E);
    for (int tb = bid; tb < T / 64; tb += nb) {
        const int t0 = tb * 64;
        __syncthreads();
        if (tid < 16) { int a = 0, b = 0; for (int k = 0; k < 256; ++k) { const int v = bh[k * 16 + tid]; a += v; if (k < tb) b += v; } tot[tid] = a; pre[tid] = b; }
        if (tid < 128) le[tid] = te[2 * t0 + tid];
        __syncthreads();
        if (tid == 0) { int acc = 0; for (int e = 0; e < 16; ++e) { base[e] = acc; acc += (tot[e] + 255) / 256 * 256; }
            if (tb == 0) { int k = 0; for (int e = 0; e < 16; ++e) { const int nt = (tot[e] + 255) / 256; for (int i = 0; i < nt; ++i) ctl[CW_TILEE + 256 * layer + k++] = e; } ctl[CW_NTILES + layer] = k; } }
        __syncthreads();
        if (tid < 128) { const int e = le[tid]; int rank = 0; for (int a = 0; a < tid; ++a) rank += (le[a] == e) ? 1 : 0;
            const int s = base[e] + pre[e] + rank; lslot[tid] = s; ((int*)(ws + WS_TOK + TOK_SLOT))[2 * t0 + tid] = s; }
        __syncthreads();
        const int wave = tid >> 6, lane = tid & 63;
        const bf16_t* hb = (const bf16_t*)(ws + WS_HB); bf16_t* xs = (bf16_t*)(ws + WS_XS);
        for (int i = 0; i < 8; ++i) { const int tl = wave * 8 + i; const size_t row = t0 + tl;
            const u32x4 a = *(const u32x4*)(hb + row * D + 8 * lane), b2 = *(const u32x4*)(hb + row * D + 512 + 8 * lane);
#pragma unroll
            for (int k = 0; k < 2; ++k) { bf16_t* dst = xs + (size_t)lslot[2 * tl + k] * D; *(u32x4*)(dst + 8 * lane) = a; *(u32x4*)(dst + 512 + 8 * lane) = b2; } }
    }
}
__device__ __forceinline__ void ph_combine_ln(const Params& p, int tid, int layer, int bid, int nb) {
    const int lane = tid & 63;
    for (int row = (bid * 8 + (tid >> 6)) * 4; row < T; row += nb * 8 * 4) { if (layer == 0) combine_ln_rows4<false>(p, 0, row, lane); else combine_ln_rows4<true>(p, 1, row, lane); }
}

constexpr int ENG_L = 512, ENG_NSC = SEQ / ENG_L, ENG_NC = ENG_L / 64;
struct EngDesc {
    const bf16_t* q; const bf16_t* kg; const bf16_t* v;
    bf16_t* o; int ors; int rs;
    int row0, dir, tau0;
    float lg;
    float* state; float* lgam;
};
typedef unsigned short u16x8 __attribute__((ext_vector_type(8)));
#define MFMA16(a, b, c) __builtin_amdgcn_mfma_f32_16x16x32_bf16((a), (b), (c), 0, 0, 0)

template <int DK, int MODE, int PASS>
__device__ __forceinline__ void engine_unit(const EngDesc& ds, LAS unsigned char* lds, int tid) {
    constexpr int CPW = DK / 8, NG = 64 / CPW, TG = CPW;
    constexpr int QS = (DK + 8) * 2, TS = 144;
    constexpr int OFF_QI = 0, OFF_KI = OFF_QI + 64 * QS, OFF_KT = OFF_KI + 64 * QS, OFF_VT = OFF_KT + DK * TS, OFF_ATT = OFF_VT + 128 * TS, OFF_BL = OFF_ATT + 64 * TS;
    constexpr int NDT = DK / 16, NKS = DK / 32;
    const int w = __builtin_amdgcn_readfirstlane(tid >> 6), l = tid & 63, fr = l & 15, fq = l >> 4;
    const int d1 = CPW * w + (l % CPW), g1 = l / CPW;
    const int e2 = 16 * w + fr, g2 = fq;
    f32x4 S[NDT];
#pragma unroll
    for (int dt = 0; dt < NDT; ++dt) { if (PASS == 1) S[dt] = *(const f32x4*)(ds.state + ((size_t)(w * NDT + dt) * 64 + l) * 4); else S[dt] = (f32x4){0.f, 0.f, 0.f, 0.f}; }
    float lgsum = 0.f;
    unsigned short rq[TG], rk[TG], rv[16];
#define ENG_ROW(tau) ((size_t)(ds.row0 + (ds.dir ? (SEQ - 1 - (tau)) : (tau))))
#define ENG_LOAD_RAW(c) do { const int tb_ = ds.tau0 + 64 * (c); \
        _Pragma("unroll") for (int i = 0; i < TG; ++i) { const size_t r_ = ENG_ROW(tb_ + g1 * TG + i) * ds.rs + d1; \
            if (MODE == 0 || true) rk[i] = ds.kg[r_]; if (PASS == 1) rq[i] = ds.q[r_]; } \
        _Pragma("unroll") for (int i = 0; i < 16; ++i) rv[i] = ds.v[ENG_ROW(tb_ + g2 * 16 + i) * ds.rs + e2]; } while (0)
    ENG_LOAD_RAW(0);
#pragma unroll 1
    for (int c = 0; c < ENG_NC; ++c) {
        __syncthreads();
        {
            float b[TG], bl;
            if (MODE == 1) {
                float run = 0.f;
#pragma unroll
                for (int i = 0; i < TG; ++i) { run += bf2f(rk[i]); b[i] = run; }
                float acc = run;
#pragma unroll
                for (int s = 0; (1 << s) < NG; ++s) { const float t = __shfl_up(acc, CPW << s); if (g1 >= (1 << s)) acc += t; }
                const float excl = acc - run;
                bl = __shfl(acc, (NG - 1) * CPW + (l % CPW));
#pragma unroll
                for (int i = 0; i < TG; ++i) b[i] += excl;
            } else {
#pragma unroll
                for (int i = 0; i < TG; ++i) b[i] = (float)(g1 * TG + i + 1) * ds.lg;
                bl = 64.f * ds.lg;
            }
            lgsum += bl;
            unsigned kt[TG / 2];
#pragma unroll
            for (int i = 0; i < TG; i += 2) {
                float kv0, kv1;
                if (MODE == 1) { kv0 = 1.f - __expf(bf2f(rk[i])); kv1 = 1.f - __expf(bf2f(rk[i + 1])); } else { kv0 = bf2f(rk[i]); kv1 = bf2f(rk[i + 1]); }
                const float x0 = b[i] - bl, x1 = b[i + 1] - bl;
                const float k0 = kv0 * __expf(-x0), k1 = kv1 * __expf(-x1);
                kt[i / 2] = cvtpk(k0, k1);
                if (PASS == 1) {
                    const float q0 = bf2f(rq[i]) * __expf(fminf(x0, 80.f)), q1 = bf2f(rq[i + 1]) * __expf(fminf(x1, 80.f));
                    const unsigned qp = cvtpk(q0, q1);
                    const int tk = g1 * TG + i;
                    *(LAS unsigned short*)(lds + OFF_QI + tk * QS + d1 * 2) = (unsigned short)(qp & 0xffffu); *(LAS unsigned short*)(lds + OFF_QI + (tk + 1) * QS + d1 * 2) = (unsigned short)(qp >> 16);
                    *(LAS unsigned short*)(lds + OFF_KI + tk * QS + d1 * 2) = (unsigned short)(kt[i / 2] & 0xffffu); *(LAS unsigned short*)(lds + OFF_KI + (tk + 1) * QS + d1 * 2) = (unsigned short)(kt[i / 2] >> 16);
                }
            }
#pragma unroll
            for (int i = 0; i < TG / 8; ++i) { u32x4 pk; pk.x = kt[4 * i]; pk.y = kt[4 * i + 1]; pk.z = kt[4 * i + 2]; pk.w = kt[4 * i + 3];
                *(LAS u32x4*)(lds + OFF_KT + d1 * TS + (g1 * TG + 8 * i) * 2) = pk; }
            if (g1 == 0) *(LAS float*)(lds + OFF_BL + d1 * 4) = bl;
#pragma unroll
            for (int i = 0; i < 2; ++i) { u32x4 pk; pk.x = rv[8 * i] | ((unsigned)rv[8 * i + 1] << 16); pk.y = rv[8 * i + 2] | ((unsigned)rv[8 * i + 3] << 16);
                pk.z = rv[8 * i + 4] | ((unsigned)rv[8 * i + 5] << 16); pk.w = rv[8 * i + 6] | ((unsigned)rv[8 * i + 7] << 16);
                *(LAS u32x4*)(lds + OFF_VT + e2 * TS + (g2 * 16 + 8 * i) * 2) = pk; }
        }
        if (c + 1 < ENG_NC) ENG_LOAD_RAW(c + 1);
        __syncthreads();
#pragma unroll
        for (int dt = 0; dt < NDT; ++dt) { const f32x4 bv = *(const LAS f32x4*)(lds + OFF_BL + (16 * dt + 4 * fq) * 4);
            S[dt][0] *= __expf(bv[0]); S[dt][1] *= __expf(bv[1]); S[dt][2] *= __expf(bv[2]); S[dt][3] *= __expf(bv[3]); }
        f32x4 oacc[4];
        if (PASS == 1) {
#pragma unroll
            for (int tt = 0; tt < 2; ++tt) {
                const int t = 2 * w + tt, jt = t >> 2, it = t & 3;
                f32x4 sc = {0.f, 0.f, 0.f, 0.f};
                if (jt <= it) {
#pragma unroll
                    for (int ks = 0; ks < NKS; ++ks) {
                        const bf16x8 a = *(const LAS bf16x8*)(lds + OFF_KI + (16 * jt + fr) * QS + (32 * ks + 8 * fq) * 2);
                        const bf16x8 bq = *(const LAS bf16x8*)(lds + OFF_QI + (16 * it + fr) * QS + (32 * ks + 8 * fq) * 2);
                        sc = MFMA16(a, bq, sc);
                    }
                    if (jt == it) {
#pragma unroll
                        for (int r = 0; r < 4; ++r) if (4 * fq + r > fr) sc[r] = 0.f;
                    }
                }
                u32x2 pk; pk.x = cvtpk(sc[0], sc[1]); pk.y = cvtpk(sc[2], sc[3]);
                *(LAS u32x2*)(lds + OFF_ATT + (16 * it + fr) * TS + (16 * jt + 4 * fq) * 2) = pk;
            }
            bf16x8 sa[NKS];
#pragma unroll
            for (int ks = 0; ks < NKS; ++ks) { u32x4 pk; pk.x = cvtpk(S[2 * ks][0], S[2 * ks][1]); pk.y = cvtpk(S[2 * ks][2], S[2 * ks][3]);
                pk.z = cvtpk(S[2 * ks + 1][0], S[2 * ks + 1][1]); pk.w = cvtpk(S[2 * ks + 1][2], S[2 * ks + 1][3]); sa[ks] = __builtin_bit_cast(bf16x8, pk); }
#pragma unroll
            for (int it = 0; it < 4; ++it) {
                oacc[it] = (f32x4){0.f, 0.f, 0.f, 0.f};
#pragma unroll
                for (int ks = 0; ks < NKS; ++ks) {
                    const u32x2 lo = *(const LAS u32x2*)(lds + OFF_QI + (16 * it + fr) * QS + (32 * ks + 4 * fq) * 2);
                    const u32x2 hi = *(const LAS u32x2*)(lds + OFF_QI + (16 * it + fr) * QS + (32 * ks + 16 + 4 * fq) * 2);
                    u32x4 pk; pk.x = lo.x; pk.y = lo.y; pk.z = hi.x; pk.w = hi.y;
                    oacc[it] = MFMA16(sa[ks], __builtin_bit_cast(bf16x8, pk), oacc[it]);
                }
            }
            __syncthreads();
        }
        bf16x8 vf[2];
#pragma unroll
        for (int ks = 0; ks < 2; ++ks) vf[ks] = *(const LAS bf16x8*)(lds + OFF_VT + (16 * w + fr) * TS + (32 * ks + 8 * fq) * 2);
        if (PASS == 1) {
#pragma unroll
            for (int it = 0; it < 4; ++it)
#pragma unroll
                for (int ks = 0; ks < 2; ++ks) if (ks == 0 || it >= 2) {
                    const bf16x8 ba = *(const LAS bf16x8*)(lds + OFF_ATT + (16 * it + fr) * TS + (32 * ks + 8 * fq) * 2);
                    oacc[it] = MFMA16(vf[ks], ba, oacc[it]);
                }
        }
#pragma unroll
        for (int dt = 0; dt < NDT; ++dt)
#pragma unroll
            for (int ks = 0; ks < 2; ++ks) {
                const bf16x8 a = *(const LAS bf16x8*)(lds + OFF_KT + (16 * dt + fr) * TS + (32 * ks + 8 * fq) * 2);
                S[dt] = MFMA16(a, vf[ks], S[dt]);
            }
        if (PASS == 1) {
#pragma unroll
            for (int it = 0; it < 4; ++it) { u32x2 pk; pk.x = cvtpk(oacc[it][0], oacc[it][1]); pk.y = cvtpk(oacc[it][2], oacc[it][3]);
                *(u32x2*)(ds.o + ENG_ROW(ds.tau0 + 64 * c + 16 * it + fr) * ds.ors + 16 * w + 4 * fq) = pk; }
        }
    }
    if (PASS == 0) {
#pragma unroll
        for (int dt = 0; dt < NDT; ++dt) *(f32x4*)(ds.state + ((size_t)(w * NDT + dt) * 64 + l) * 4) = S[dt];
        if (g1 == 0) ds.lgam[d1] = lgsum;
    }
#undef ENG_ROW
#undef ENG_LOAD_RAW
}
template <int DK>
__device__ __forceinline__ void eng_scan(const float* sloc, float* sin, const float* lgam, int nseq, int gtid, int gthreads) {
    constexpr int NDT = DK / 16, PER_SEQ = 8 * NDT * 64;
    for (int i = gtid; i < nseq * PER_SEQ; i += gthreads) {
        const int seq = i / PER_SEQ, r = i % PER_SEQ, l = r & 63, dt = (r >> 6) % NDT;
        const int d = 16 * dt + 4 * (l >> 4);
        f32x4 cur = {0.f, 0.f, 0.f, 0.f};
        for (int sc = 0; sc < ENG_NSC; ++sc) {
            const size_t so = ((size_t)(seq * ENG_NSC + sc) * PER_SEQ + r) * 4;
            const f32x4 loc = *(const f32x4*)(sloc + so); const f32x4 lg = *(const f32x4*)(lgam + (size_t)(seq * ENG_NSC + sc) * DK + d);
            *(f32x4*)(sin + so) = cur;
            cur[0] = __expf(lg[0]) * cur[0] + loc[0]; cur[1] = __expf(lg[1]) * cur[1] + loc[1]; cur[2] = __expf(lg[2]) * cur[2] + loc[2]; cur[3] = __expf(lg[3]) * cur[3] + loc[3];
        }
    }
}

constexpr size_t WS_RO = WS_SCR;
constexpr size_t WS_ST = 216 * MiB;
constexpr size_t WS_ST_RET = 236 * MiB;
constexpr size_t WS_SIN = 248 * MiB;
constexpr size_t WS_LG = 280 * MiB;

template <int PASS>
__device__ __forceinline__ void ph_ret_pass(const Params& p, int tid, LAS unsigned char* lds, int bid, int nb) {
    bf16_t* proj = (bf16_t*)(p.ws + WS_PROJ);
    for (int u = bid; u < 16 * ENG_NSC; u += nb) {
        const int seq = u / ENG_NSC, sc = u % ENG_NSC, dir = seq & 1, bh = seq >> 1, b = bh >> 2, h = bh & 3;
        EngDesc ds; ds.q = proj + h * 64; ds.kg = proj + 256 + h * 64; ds.v = proj + 512 + h * 128; ds.rs = EVEN_IN;
        ds.o = (bf16_t*)(p.ws + WS_RO) + (size_t)dir * T * 512 + h * 128; ds.ors = 512;
        ds.row0 = b * SEQ; ds.dir = dir; ds.tau0 = sc * ENG_L; ds.lg = log1pf(-exp2f(-5.f - (float)h));
        ds.state = (float*)(p.ws + (PASS ? WS_SIN : WS_ST_RET)) + (size_t)u * (64 * 128); ds.lgam = (float*)(p.ws + WS_LG) + (size_t)u * 64;
        engine_unit<64, 0, PASS>(ds, lds, tid);
    }
}
template <int PASS>
__device__ __forceinline__ void ph_gla_pass(const Params& p, int tid, LAS unsigned char* lds, int bid, int nb) {
    bf16_t* proj = (bf16_t*)(p.ws + WS_PROJ);
    for (int u = bid; u < 32 * ENG_NSC; u += nb) {
        const int seq = u / ENG_NSC, sc = u % ENG_NSC, dir = seq & 1, bh = seq >> 1, b = bh >> 3, h = bh & 7;
        EngDesc ds; ds.q = proj + h * 128; ds.kg = proj + 2048 + dir * 1024 + h * 128; ds.v = proj + 1024 + h * 128; ds.rs = ODD_IN;
        ds.o = proj + 2048 + dir * 1024 + h * 128; ds.ors = ODD_IN;
        ds.row0 = b * SEQ; ds.dir = dir; ds.tau0 = sc * ENG_L; ds.lg = 0.f;
        ds.state = (float*)(p.ws + (PASS ? WS_SIN : WS_ST)) + (size_t)u * (128 * 128); ds.lgam = (float*)(p.ws + WS_LG) + (size_t)u * 128;
        engine_unit<128, 1, PASS>(ds, lds, tid);
    }
}
__device__ __forceinline__ void ph_ret_norm2(const Params& p, int tid, int bid, int nb) {
    const int lane = tid & 63;
    const bf16_t* Of = (const bf16_t*)(p.ws + WS_RO); const bf16_t* Ob = Of + (size_t)T * 512;
    const bf16_t* proj = (const bf16_t*)(p.ws + WS_PROJ); bf16_t* mix = (bf16_t*)(p.ws + WS_HB);
    for (int gwv = bid * 8 + (tid >> 6); gwv < T * 4; gwv += nb * 8) {
        const int row = gwv >> 2, h = gwv & 3;
        const bf16_t* pr = proj + (size_t)row * EVEN_IN;
        const float qk = wave_sum(bf2f(pr[h * 64 + lane]) * bf2f(pr[256 + h * 64 + lane]));
        const size_t o = (size_t)row * 512 + h * 128 + 2 * lane;
        const unsigned uf = *(const unsigned*)(Of + o), ub = *(const unsigned*)(Ob + o), uv = *(const unsigned*)(pr + 512 + h * 128 + 2 * lane);
        const float a0 = bflo(uf) + bflo(ub) - qk * bflo(uv), a1 = bfhi(uf) + bfhi(ub) - qk * bfhi(uv);
        const float mean = wave_sum(a0 + a1) * (1.f / 128.f); const float d0 = a0 - mean, d1 = a1 - mean;
        const float rstd = 1.f / sqrtf(wave_sum(d0 * d0 + d1 * d1) * (1.f / 128.f) + LN_EPS);
        const unsigned gg = *(const unsigned*)(pr + 1024 + h * 128 + 2 * lane);
        *(unsigned*)(mix + (size_t)row * D + h * 128 + 2 * lane) = pk2(d0 * rstd * silu(bflo(gg)), d1 * rstd * silu(bfhi(gg)));
    }
}

constexpr size_t WS_G = WS_SCR + 32 * MiB;
constexpr size_t WS_AGG = 232 * MiB;
constexpr size_t WS_CIN = 234 * MiB;
template <int CTRL> __device__ __forceinline__ float dppf(float old, float x) {
    return __builtin_bit_cast(float, __builtin_amdgcn_update_dpp(__builtin_bit_cast(int, old), __builtin_bit_cast(int, x), CTRL, 0xf, 0xf, false));
}
template <bool FWD> __device__ __forceinline__ void row_scan(float& A, float& B) {
#define LRU_STEP(s) { const float Ap = dppf<(FWD ? 0x110 : 0x100) + s>(1.f, A), Bp = dppf<(FWD ? 0x110 : 0x100) + s>(0.f, B); B = A * Bp + B; A = A * Ap; }
    LRU_STEP(1) LRU_STEP(2) LRU_STEP(4) LRU_STEP(8)
#undef LRU_STEP
}
__device__ __forceinline__ void lru_unit(const Params& p, LAS unsigned char* lds, int tid, int u) {
    constexpr int XS_ = 272;
    const int n = u & 3, c = (u >> 2) & 63, b = u >> 8;
    const int w = __builtin_amdgcn_readfirstlane(tid >> 6), l = tid & 63, fr = l & 15, fq = l >> 4;
    const int row0 = b * SEQ + c * 128;
    const bf16_t* proj = (const bf16_t*)(p.ws + WS_PROJ);
    __syncthreads();
#pragma unroll
    for (int k = 0; k < 4; ++k) {
        const int id = tid + 512 * k, tok = id >> 4, cg = id & 15, ch0 = 128 * n + 8 * cg, s = c * 128 + tok;
        float acc[8];
        { const f32x4 b0 = *(const f32x4*)(p.conv_b + ch0), b1 = *(const f32x4*)(p.conv_b + ch0 + 4);
          acc[0] = b0[0]; acc[1] = b0[1]; acc[2] = b0[2]; acc[3] = b0[3]; acc[4] = b1[0]; acc[5] = b1[1]; acc[6] = b1[2]; acc[7] = b1[3]; }
#pragma unroll
        for (int j = 0; j < 4; ++j) {
            const int ss = s + j - 2;
            if (ss >= 0 && ss < SEQ) {
                const u32x4 xv = *(const u32x4*)(proj + (size_t)(b * SEQ + ss) * EVEN_IN + 1536 + ch0);
                const f32x4 w0 = *(const f32x4*)(p.conv_w + j * 512 + ch0), w1 = *(const f32x4*)(p.conv_w + j * 512 + ch0 + 4);
                acc[0] += w0[0] * bflo(xv.x); acc[1] += w0[1] * bfhi(xv.x); acc[2] += w0[2] * bflo(xv.y); acc[3] += w0[3] * bfhi(xv.y);
                acc[4] += w1[0] * bflo(xv.z); acc[5] += w1[1] * bfhi(xv.z); acc[6] += w1[2] * bflo(xv.w); acc[7] += w1[3] * bfhi(xv.w);
            }
        }
        u32x4 pk; pk.x = cvtpk(acc[0], acc[1]); pk.y = cvtpk(acc[2], acc[3]); pk.z = cvtpk(acc[4], acc[5]); pk.w = cvtpk(acc[6], acc[7]);
        *(LAS u32x4*)(lds + tok * XS_ + cg * 16) = pk;
    }
    __syncthreads();
    const int chl = 16 * w + 4 * fq, ch = 128 * n + chl;
    const bf16_t* lgt = (const bf16_t*)(p.ws + WS_LGT);
    bf16_t* G = (bf16_t*)(p.ws + WS_G);
    float* agg = (float*)(p.ws + WS_AGG) + (size_t)((b * 64 + c) * 2) * 2 * 512;
#pragma unroll
    for (int z = 0; z < 2; ++z) {
        bf16x8 ar[4], ai[4];
#pragma unroll
        for (int ks = 0; ks < 4; ++ks) {
            ar[ks] = *(const bf16x8*)(lgt + ((size_t)((2 * z + 0) * 4 + n) * 128 + 16 * w + fr) * 128 + 32 * ks + 8 * fq);
            ai[ks] = *(const bf16x8*)(lgt + ((size_t)((2 * z + 1) * 4 + n) * 128 + 16 * w + fr) * 128 + 32 * ks + 8 * fq);
        }
        const f32x4 lam4 = *(const f32x4*)(p.lam + z * 512 + ch);
        const f32x4 br4 = *(const f32x4*)(p.gate_b + ((2 * z + 0) * 4 + n) * 128 + chl), bi4 = *(const f32x4*)(p.gate_b + ((2 * z + 1) * 4 + n) * 128 + chl);
        float sp8[4];
#pragma unroll
        for (int r = 0; r < 4; ++r) sp8[r] = -8.f * __logf(1.f + __expf(-lam4[r]));
        float cin[4] = {0.f, 0.f, 0.f, 0.f}, pin[4] = {1.f, 1.f, 1.f, 1.f};
        const int srcl = (l & 48) | (z ? 0 : 15);
#pragma unroll 1
        for (int ti = 0; ti < 8; ++ti) {
            const int tt = z ? 7 - ti : ti;
            f32x4 gr_ = {0.f, 0.f, 0.f, 0.f}, gi_ = {0.f, 0.f, 0.f, 0.f};
#pragma unroll
            for (int ks = 0; ks < 4; ++ks) {
                const bf16x8 xb = *(const LAS bf16x8*)(lds + (16 * tt + fr) * XS_ + (32 * ks + 8 * fq) * 2);
                gr_ = MFMA16(ar[ks], xb, gr_); gi_ = MFMA16(ai[ks], xb, gi_);
            }
            const u32x2 xq = *(const LAS u32x2*)(lds + (16 * tt + fr) * XS_ + chl * 2);
            const float xcv[4] = {bflo(xq.x), bfhi(xq.x), bflo(xq.y), bfhi(xq.y)};
            float hl[4], Pl[4];
#pragma unroll
            for (int r = 0; r < 4; ++r) {
                const float la = sp8[r] * sigm(gr_[r] + br4[r]);
                float A = __expf(la), B = sqrtf(fmaxf(1.f - __expf(2.f * la), 0.f)) * sigm(gi_[r] + bi4[r]) * xcv[r];
                if (z == 0) row_scan<true>(A, B); else row_scan<false>(A, B);
                hl[r] = A * cin[r] + B; Pl[r] = A * pin[r];
                cin[r] = __shfl(hl[r], srcl); pin[r] = __shfl(Pl[r], srcl);
            }
            {
                const size_t row = (size_t)row0 + 16 * tt + fr;
                const u32x2 gq = *(const u32x2*)(proj + row * EVEN_IN + 2048 + ch);
                const float ge[4] = {gelu_tanh(bflo(gq.x)), gelu_tanh(bfhi(gq.x)), gelu_tanh(bflo(gq.y)), gelu_tanh(bfhi(gq.y))};
                u32x2 o1, o2;
                o1.x = cvtpk(hl[0] * ge[0], hl[1] * ge[1]); o1.y = cvtpk(hl[2] * ge[2], hl[3] * ge[3]);
                o2.x = cvtpk(Pl[0] * ge[0], Pl[1] * ge[1]); o2.y = cvtpk(Pl[2] * ge[2], Pl[3] * ge[3]);
                *(u32x2*)(G + ((size_t)(2 * z) * T + row) * 512 + ch) = o1; *(u32x2*)(G + ((size_t)(2 * z + 1) * T + row) * 512 + ch) = o2;
            }
        }
        if (fr == 0) { f32x4 a4 = {pin[0], pin[1], pin[2], pin[3]}, b4 = {cin[0], cin[1], cin[2], cin[3]};
            *(f32x4*)(agg + (size_t)(z * 2 + 0) * 512 + ch) = a4; *(f32x4*)(agg + (size_t)(z * 2 + 1) * 512 + ch) = b4; }
    }
}
__device__ __forceinline__ void lru_carry(const Params& p, int gid) {
    if (gid >= 2048) return;
    const int ch = gid & 511, z = (gid >> 9) & 1, b = gid >> 10;
    const float* agg = (const float*)(p.ws + WS_AGG); float* cinb = (float*)(p.ws + WS_CIN);
    float cur = 0.f;
    for (int step = 0; step < 64; ++step) {
        const int c = z ? 63 - step : step; const size_t idx = (size_t)((b * 64 + c) * 2 + z);
        cinb[idx * 512 + ch] = cur;
        cur = agg[(idx * 2 + 0) * 512 + ch] * cur + agg[(idx * 2 + 1) * 512 + ch];
    }
}
__device__ __forceinline__ void lru_combine(const Params& p, int gid, int gthreads) {
    const bf16_t* G = (const bf16_t*)(p.ws + WS_G); const float* cinb = (const float*)(p.ws + WS_CIN); bf16_t* mix = (bf16_t*)(p.ws + WS_HB);
    for (int i = gid; i < T * 128; i += gthreads) {
        const int row = i >> 7, ch = (i & 127) * 4, b = row >> 13, c = (row & (SEQ - 1)) >> 7;
        const f32x4 cf = *(const f32x4*)(cinb + (size_t)((b * 64 + c) * 2 + 0) * 512 + ch), cb = *(const f32x4*)(cinb + (size_t)((b * 64 + c) * 2 + 1) * 512 + ch);
        const u32x2 g1 = *(const u32x2*)(G + (size_t)row * 512 + ch), g2 = *(const u32x2*)(G + ((size_t)T + row) * 512 + ch);
        const u32x2 g3 = *(const u32x2*)(G + ((size_t)2 * T + row) * 512 + ch), g4 = *(const u32x2*)(G + ((size_t)3 * T + row) * 512 + ch);
        u32x2 o;
        o.x = cvtpk(bflo(g1.x) + bflo(g3.x) + bflo(g2.x) * cf[0] + bflo(g4.x) * cb[0], bfhi(g1.x) + bfhi(g3.x) + bfhi(g2.x) * cf[1] + bfhi(g4.x) * cb[1]);
        o.y = cvtpk(bflo(g1.y) + bflo(g3.y) + bflo(g2.y) * cf[2] + bflo(g4.y) * cb[2], bfhi(g1.y) + bfhi(g3.y) + bfhi(g2.y) * cf[3] + bfhi(g4.y) * cb[3]);
        *(u32x2*)(mix + (size_t)row * D + 512 + ch) = o;
    }
}

__device__ __forceinline__ Params load_params() {
    typedef const float* cfp;
    const volatile __attribute__((address_space(4))) cfp* kp = (const volatile __attribute__((address_space(4))) cfp*)__builtin_amdgcn_kernarg_segment_ptr();
    Params q;
    q.x = kp[0]; q.w_in_even = kp[1]; q.w_out_even = kp[2]; q.conv_w = kp[3]; q.conv_b = kp[4]; q.gate_w = kp[5]; q.gate_b = kp[6]; q.lam = kp[7];
    q.w_in_odd = kp[8]; q.w_out_odd = kp[9]; q.lower_bounds = kp[10]; q.norm_w = kp[11]; q.ln_w = kp[12]; q.ln_b = kp[13]; q.router_w = kp[14];
    q.moe_gate = kp[15]; q.moe_up = kp[16]; q.moe_down = kp[17]; q.out = (float*)kp[18]; q.ws = (unsigned char*)kp[19];
    return q;
}
#define PH_BEGIN { const Params p = load_params(); int tid_ = threadIdx.x; asm volatile("" : "+v"(tid_)); int bid = blockIdx.x, nb = gridDim.x; asm volatile("" : "+s"(bid), "+s"(nb)); \
    const int wave = __builtin_amdgcn_readfirstlane(tid_ >> 6), lane = tid_ & 63; LAS float* scrw = (LAS float*)(lds + wave * 16384); const int gw = bid * 8 + wave, ngw = nb * 8; \
    (void)lane; (void)scrw; (void)gw; (void)ngw;
#define PH_END }
#define GRID_BAR() { XcdBarrier b_; b_.bar = (unsigned*)(load_params().ws + WS_CTL) + CW_BAR; b_.x = xb_xcc_id(); b_.st = MISC + 8; xcd_barrier(b_); }
__global__ void __launch_bounds__(512, 2) mega_fwd(Params p_unused) {
    extern __shared__ __attribute__((aligned(16))) unsigned char shm[];
    PG8_LAS unsigned char* lds = (PG8_LAS unsigned char*)shm;
    volatile LAS unsigned* MISC = (volatile LAS unsigned*)(lds + MISC_OFF);
    for (int u = threadIdx.x; u < (LDS_BYTES - STAGE_LDS) / 4; u += 512) ((LAS unsigned*)(lds + STAGE_LDS))[u] = 0u;
    __syncthreads();
    (void)xcd_barrier_post((unsigned*)(load_params().ws + WS_CTL) + CW_BAR, MISC + 8);

    PH_BEGIN prologue_static(p, scrw, gw, ngw, lane); PH_END
    GRID_BAR();
    PH_BEGIN ph_inproj0(p, lds, bid, nb); PH_END
    GRID_BAR();
    PH_BEGIN ph_ret_pass<0>(p, tid_, lds, bid, nb); PH_END
    GRID_BAR();
    PH_BEGIN eng_scan<64>((const float*)(p.ws + WS_ST_RET), (float*)(p.ws + WS_SIN), (const float*)(p.ws + WS_LG), 16, bid * 512 + tid_, nb * 512); PH_END
    GRID_BAR();
    PH_BEGIN ph_ret_pass<1>(p, tid_, lds, bid, nb); PH_END
    GRID_BAR();
    PH_BEGIN ph_ret_norm2(p, tid_, bid, nb); PH_END
    GRID_BAR();
    PH_BEGIN for (int u = bid; u < 512; u += nb) lru_unit(p, lds, tid_, u); PH_END
    GRID_BAR();
    PH_BEGIN lru_carry(p, bid * 512 + tid_); PH_END
    GRID_BAR();
    PH_BEGIN lru_combine(p, bid * 512 + tid_, nb * 512); PH_END
    GRID_BAR();
    PH_BEGIN ph_outproj<0>(p, lds, bid, nb); PH_END
    GRID_BAR();
    PH_BEGIN prologue_moe(p, 0, scrw, gw, ngw, lane); ph_ln_router(p, tid_, 0, (LAS int*)lds, bid, nb); PH_END
    GRID_BAR();
    PH_BEGIN ph_slots(p, tid_, 0, (LAS int*)lds, bid, nb); PH_END
    GRID_BAR();
    PH_BEGIN ph_moe_gateup(p, 0, lds, bid, nb); PH_END
    GRID_BAR();
    PH_BEGIN ph_moe_down(p, 0, lds, bid, nb); PH_END
    GRID_BAR();
    PH_BEGIN ph_combine_ln(p, tid_, 0, bid, nb); PH_END
    GRID_BAR();
    PH_BEGIN ph_inproj1(p, lds, bid, nb); PH_END
    GRID_BAR();
    PH_BEGIN ph_gla_pass<0>(p, tid_, lds, bid, nb); PH_END
    GRID_BAR();
    PH_BEGIN eng_scan<128>((const float*)(p.ws + WS_ST), (float*)(p.ws + WS_SIN), (const float*)(p.ws + WS_LG), 32, bid * 512 + tid_, nb * 512); PH_END
    GRID_BAR();
    PH_BEGIN ph_gla_pass<1>(p, tid_, lds, bid, nb); PH_END
    GRID_BAR();
    PH_BEGIN ph_hg_norm(p, tid_, bid, nb); PH_END
    GRID_BAR();
    PH_BEGIN ph_outproj<1>(p, lds, bid, nb); PH_END
    GRID_BAR();
    PH_BEGIN prologue_moe(p, 1, scrw, gw, ngw, lane); ph_ln_router(p, tid_, 1, (LAS int*)lds, bid, nb); PH_END
    GRID_BAR();
    PH_BEGIN ph_slots(p, tid_, 1, (LAS int*)lds, bid, nb); PH_END
    GRID_BAR();
    PH_BEGIN ph_moe_gateup(p, 1, lds, bid, nb); PH_END
    GRID_BAR();
    PH_BEGIN ph_moe_down(p, 1, lds, bid, nb); PH_END
    GRID_BAR();
    PH_BEGIN ph_combine_ln(p, tid_, 1, bid, nb); PH_END
}

extern "C" void kernel_launch(void* const* d_in, const int* in_sizes, int n_in, void* d_out, int out_size, void* d_ws, size_t ws_size, hipStream_t stream) {
    static int grid = 0;
    if (grid == 0) {
        if (n_in != 18 || in_sizes[0] != T * D || out_size != T * D || ws_size < WS_END) { fprintf(stderr, "kernel_launch: unexpected shapes (n_in %d, in0 %d, out %d, ws %zu)\n", n_in, n_in > 0 ? in_sizes[0] : -1, out_size, ws_size); grid = -1; return; }
        int dev = 0, cus = 0, per_cu = 0;
        if (hipGetDevice(&dev) != hipSuccess || hipDeviceGetAttribute(&cus, hipDeviceAttributeMultiprocessorCount, dev) != hipSuccess) { grid = -1; return; }
        if (hipFuncSetAttribute((const void*)mega_fwd, hipFuncAttributeMaxDynamicSharedMemorySize, LDS_BYTES) != hipSuccess) { fprintf(stderr, "kernel_launch: hipFuncSetAttribute failed\n"); grid = -1; return; }
        if (hipOccupancyMaxActiveBlocksPerMultiprocessor(&per_cu, (const void*)mega_fwd, 512, LDS_BYTES) != hipSuccess || per_cu < 1) { fprintf(stderr, "kernel_launch: occupancy query says %d workgroups per CU\n", per_cu); }
        (void)hipGetLastError();
        grid = cus > 0 ? cus : 256;
    }
    if (grid < 0) return;
    Params p{};
    p.x = (const float*)d_in[0]; p.w_in_even = (const float*)d_in[1]; p.w_out_even = (const float*)d_in[2]; p.conv_w = (const float*)d_in[3]; p.conv_b = (const float*)d_in[4];
    p.gate_w = (const float*)d_in[5]; p.gate_b = (const float*)d_in[6]; p.lam = (const float*)d_in[7]; p.w_in_odd = (const float*)d_in[8]; p.w_out_odd = (const float*)d_in[9];
    p.lower_bounds = (const float*)d_in[10]; p.norm_w = (const float*)d_in[11]; p.ln_w = (const float*)d_in[12]; p.ln_b = (const float*)d_in[13]; p.router_w = (const float*)d_in[14];
    p.moe_gate = (const float*)d_in[15]; p.moe_up = (const float*)d_in[16]; p.moe_down = (const float*)d_in[17];
    p.out = (float*)d_out; p.ws = (unsigned char*)d_ws;
    if (hipMemsetAsync((char*)d_ws + WS_CTL, 0, CTL_BYTES, stream) != hipSuccess) return;
    hipLaunchKernelGGL(mega_fwd, dim3(grid), dim3(512), LDS_BYTES, stream, p);
}
```

```cpp
#include <hip/hip_runtime.h>
#include <cstdio>
#include <cstdint>

namespace pg8 {
#define PG8_LAS __attribute__((address_space(3)))
typedef unsigned short bf16_t;
typedef short bf16x8 __attribute__((ext_vector_type(8)));
typedef float f32x4 __attribute__((ext_vector_type(4)));
typedef unsigned u32x4 __attribute__((ext_vector_type(4)));
constexpr int BM = 256, BK = 64, HALF = 128, HTB = HALF * BK * 2  , STAGE_BYTES = 8 * HTB, NXCD = 8, WGM = 8;

__host__ __device__ __forceinline__ int lds_byte(int r, int c) { const int st = (r >> 4) * 2 + (c >> 5), rr = r & 15, cc = c & 31, ob = rr * 64 + cc * 2; return st * 1024 + (ob ^ (((ob >> 9) & 1) << 5)); }
__host__ __device__ __forceinline__ void stage_rc(int b, int& R, int& C) { const int st = b / 1024, sb = b % 1024, swz = sb ^ (((sb >> 9) & 1) << 5); R = (st >> 1) * 16 + swz / 64; C = (st & 1) * 32 + (swz % 64) / 2; }
__host__ __device__ __forceinline__ int perm32(int rho) { const int n = rho >> 4, i = rho & 15; return 8 * (i >> 2) + 4 * n + (i & 3); }

struct Unit { int pm, pn, brow; };
struct Gemm { const bf16_t* A; const bf16_t* Bt; int M, N, K; };

struct StaticOrder {
    int nM, nN, nwg, G, c;
    __host__ __device__ void init(int M, int N, int K, int G_, int c_) { nM = M / BM; nN = N / BM; nwg = nM * nN; G = G_; c = c_; }
    __host__ __device__ bool next(int i, Unit& u) const {
        const long L = (long)i * G + c; if (L >= nwg) return false;
        int wgid = (int)L; { const int q = nwg / NXCD, r = nwg % NXCD, xcd = wgid % NXCD, off = wgid / NXCD; wgid = (xcd < r ? xcd * (q + 1) : r * (q + 1) + (xcd - r) * q) + off; }
        const int nig = WGM * nN, gid = wgid / nig, fm = gid * WGM, gsz = (nM - fm) < WGM ? (nM - fm) : WGM;
        u.pm = fm + ((wgid % nig) % gsz); u.pn = (wgid % nig) / gsz; u.brow = u.pn; return true;
    }
    __device__ __forceinline__ void a_ready(const Unit&) const {}
    __device__ __forceinline__ void done(const Unit&) const {}
};
struct GroupedOrder {
    const int* tile_e; int ntiles, nN, G, c;
    __device__ bool next(int i, Unit& u) const {
        const int L = i * G + c; if (L >= ntiles * nN) return false;
        u.pm = L / nN; u.pn = L % nN;
        u.brow = __builtin_amdgcn_readfirstlane(tile_e[u.pm]) * nN + u.pn; return true;
    }
    __device__ __forceinline__ void a_ready(const Unit&) const {}
    __device__ __forceinline__ void done(const Unit&) const {}
};

__device__ __forceinline__ unsigned cvt_pk_bf16(float lo, float hi) { unsigned r; asm volatile("v_cvt_pk_bf16_f32 %0, %1, %2" : "=v"(r) : "v"(lo), "v"(hi)); return r; }

template <class Epi, class Sched, bool ALIGN_EPI = false, bool SP2 = false>
__device__ __forceinline__ void gemm_phase(PG8_LAS unsigned char* lds, const Gemm g, const Sched& S, const Epi& E) {
    int tid_ = threadIdx.x; asm volatile("" : "+v"(tid_));
    const int tid = tid_, wid = __builtin_amdgcn_readfirstlane(tid >> 6), lane = tid & 63, wr = wid >> 2, wc = wid & 3, fr = lane & 15, fq = lane >> 4;
    const int K = g.K, nt = K / BK;
    unsigned voffA[2], voffB[2];
#pragma unroll
    for (int i = 0; i < 2; ++i) { int R, C; stage_rc(tid * 16 + i * 8192, R, C); const int Rb = Epi::PERM ? ((R & ~31) + perm32(R & 31)) : R;
        voffA[i] = (unsigned)(R * K + C) * 2u; voffB[i] = (unsigned)(Rb * K + C) * 2u; }
    const size_t kstep = (size_t)(BK * 2);
    const size_t hstep = (size_t)HALF * K * 2;
    const unsigned ldsw = (unsigned)wid * 1024u;
    const int aoff = lds_byte(wr * 64 + fr, fq * 8), boff = lds_byte(wc * 32 + fr, fq * 8);
#define PG8_SA(b, h) (((b) * 2 + (h)) * HTB)
#define PG8_SB(b, h) ((4 + (b) * 2 + (h)) * HTB)
#define PG8_STAGE(bufoff, gbase, voff) do { _Pragma("unroll") for (int _i = 0; _i < 2; ++_i) \
        __builtin_amdgcn_global_load_lds((const unsigned*)((const char*)(gbase) + (voff)[_i]), (PG8_LAS unsigned*)(lds + (bufoff) + ldsw + _i * 8192), 16, 0, 0); } while (0)
#define PG8_LDA(dst, b, h) do { _Pragma("unroll") for (int m = 0; m < 4; ++m) _Pragma("unroll") for (int k = 0; k < 2; ++k) dst[m][k] = *(const PG8_LAS bf16x8*)(lds + PG8_SA(b, h) + aoff + m * 2048 + k * 1024); } while (0)
#define PG8_LDB(dst, b, h) do { _Pragma("unroll") for (int n = 0; n < 2; ++n) _Pragma("unroll") for (int k = 0; k < 2; ++k) dst[n][k] = *(const PG8_LAS bf16x8*)(lds + PG8_SB(b, h) + boff + n * 2048 + k * 1024); } while (0)
#define PG8_MMA(ai, bj, At, Bt) do { __builtin_amdgcn_s_setprio(1); _Pragma("unroll") for (int m = 0; m < 4; ++m) _Pragma("unroll") for (int n = 0; n < 2; ++n) _Pragma("unroll") for (int k = 0; k < 2; ++k) \
        acc[ai][bj][m][n] = __builtin_amdgcn_mfma_f32_16x16x32_bf16(Bt[n][k], At[m][k], acc[ai][bj][m][n], 0, 0, 0); __builtin_amdgcn_s_setprio(0); } while (0)
#define PG8_WAIT_V(n) asm volatile("s_waitcnt vmcnt(" #n ")" ::: "memory")
#define PG8_WAIT_L(n) asm volatile("s_waitcnt lgkmcnt(" #n ")" ::: "memory")
#define PG8_BAR __builtin_amdgcn_s_barrier()
#define PG8_SCHED __builtin_amdgcn_sched_barrier(0)
    Unit cur, nxt; int ui = 0;
    if (!S.next(0, cur)) return;
    f32x4 acc[2][2][4][2];
#pragma unroll
    for (int a = 0; a < 2; ++a)
#pragma unroll
        for (int b = 0; b < 2; ++b)
#pragma unroll
            for (int m = 0; m < 4; ++m)
#pragma unroll
                for (int n = 0; n < 2; ++n) acc[a][b][m][n] = (f32x4){0.f, 0.f, 0.f, 0.f};
    bf16x8 At[4][2], B0[2][2], B1[2][2];
    const size_t tstep = 2 * hstep;
    const char* cA = (const char*)g.A + (size_t)cur.pm * tstep; const char* cB = (const char*)g.Bt + (size_t)cur.brow * tstep;
    S.a_ready(cur);
    if constexpr (SP2) {
        PG8_STAGE(PG8_SB(0, 0), cB, voffB); PG8_STAGE(PG8_SB(0, 1), cB + hstep, voffB); PG8_STAGE(PG8_SA(0, 0), cA, voffA); PG8_STAGE(PG8_SA(0, 1), cA + hstep, voffA);
        if (wr == 1) PG8_BAR;
        PG8_WAIT_V(2); PG8_BAR;
        PG8_STAGE(PG8_SB(1, 0), cB + kstep, voffB); PG8_STAGE(PG8_SA(1, 0), cA + kstep, voffA); PG8_STAGE(PG8_SB(1, 1), cB + hstep + kstep, voffB);
        PG8_WAIT_V(6); PG8_BAR;
    } else {
        PG8_STAGE(PG8_SB(0, 0), cB, voffB); PG8_STAGE(PG8_SA(0, 0), cA, voffA); PG8_STAGE(PG8_SB(0, 1), cB + hstep, voffB); PG8_STAGE(PG8_SA(0, 1), cA + hstep, voffA);
        if (wr == 1) PG8_BAR;
        PG8_WAIT_V(4); PG8_BAR;
        PG8_STAGE(PG8_SB(1, 0), cB + kstep, voffB); PG8_STAGE(PG8_SA(1, 0), cA + kstep, voffA); PG8_STAGE(PG8_SB(1, 1), cB + hstep + kstep, voffB);
        PG8_WAIT_V(6); PG8_BAR;
    }
    for (;;) {
        const bool has_next = S.next(ui + 1, nxt);
        const char* nA = has_next ? (const char*)g.A + (size_t)nxt.pm * tstep : cA; const char* nB = has_next ? (const char*)g.Bt + (size_t)nxt.brow * tstep : cB;
        for (int t = 0; t < nt; t += 2) {
            const bool last = (t == nt - 2);
            const char* a1 = cA + (size_t)(t + 1) * kstep;
            const char* a2 = last ? nA : cA + (size_t)(t + 2) * kstep; const char* b2 = last ? nB : cB + (size_t)(t + 2) * kstep;
            const char* a3 = a2 + kstep; const char* b3 = b2 + kstep;
            if (last && has_next) S.a_ready(nxt);
            if constexpr (SP2) {
            PG8_LDB(B0, 0, 0); PG8_LDB(B1, 0, 1); PG8_SCHED; PG8_LDA(At, 0, 0); PG8_STAGE(PG8_SA(1, 1), a1 + hstep, voffA);
            PG8_WAIT_V(8); PG8_WAIT_L(0); PG8_BAR; PG8_MMA(0, 0, At, B0); PG8_MMA(0, 1, At, B1); PG8_BAR; PG8_SCHED;
            PG8_LDA(At, 0, 1); PG8_STAGE(PG8_SB(0, 0), b2, voffB); PG8_STAGE(PG8_SB(0, 1), b2 + hstep, voffB); PG8_STAGE(PG8_SA(0, 0), a2, voffA);
            PG8_WAIT_V(8); PG8_WAIT_L(0); PG8_BAR; PG8_MMA(1, 0, At, B0); PG8_MMA(1, 1, At, B1); PG8_BAR; PG8_SCHED;
            PG8_LDB(B0, 1, 0); PG8_LDB(B1, 1, 1); PG8_SCHED; PG8_LDA(At, 1, 0); PG8_STAGE(PG8_SA(0, 1), a2 + hstep, voffA);
            PG8_WAIT_V(8); PG8_WAIT_L(0); PG8_BAR; PG8_MMA(0, 0, At, B0); PG8_MMA(0, 1, At, B1); PG8_BAR; PG8_SCHED;
            PG8_LDA(At, 1, 1); PG8_STAGE(PG8_SB(1, 0), b3, voffB); PG8_STAGE(PG8_SB(1, 1), b3 + hstep, voffB); PG8_STAGE(PG8_SA(1, 0), a3, voffA);
            PG8_WAIT_V(8); PG8_WAIT_L(0); PG8_BAR; PG8_MMA(1, 0, At, B0); PG8_MMA(1, 1, At, B1); PG8_BAR; PG8_SCHED;
            } else {
            PG8_LDB(B0, 0, 0); PG8_SCHED; PG8_LDA(At, 0, 0); PG8_STAGE(PG8_SA(1, 1), a1 + hstep, voffA);
            PG8_WAIT_L(8); PG8_BAR; PG8_WAIT_L(0); PG8_MMA(0, 0, At, B0); PG8_BAR; PG8_SCHED;
            PG8_LDB(B1, 0, 1); PG8_STAGE(PG8_SB(0, 0), b2, voffB);
            PG8_BAR; PG8_WAIT_L(0); PG8_MMA(0, 1, At, B1); PG8_BAR;
            PG8_LDA(At, 0, 1); PG8_STAGE(PG8_SA(0, 0), a2, voffA);
            PG8_BAR; PG8_WAIT_L(0); PG8_MMA(1, 0, At, B0); PG8_BAR; PG8_SCHED;
            PG8_STAGE(PG8_SB(0, 1), b2 + hstep, voffB);
            PG8_WAIT_V(6); PG8_BAR; PG8_MMA(1, 1, At, B1); PG8_BAR;
            PG8_LDB(B0, 1, 0); PG8_SCHED; PG8_LDA(At, 1, 0); PG8_STAGE(PG8_SA(0, 1), a2 + hstep, voffA);
            PG8_WAIT_L(8); PG8_BAR; PG8_WAIT_L(0); PG8_MMA(0, 0, At, B0); PG8_BAR; PG8_SCHED;
            PG8_LDB(B1, 1, 1); PG8_STAGE(PG8_SB(1, 0), b3, voffB);
            PG8_BAR; PG8_WAIT_L(0); PG8_MMA(0, 1, At, B1); PG8_BAR;
            PG8_LDA(At, 1, 1); PG8_STAGE(PG8_SA(1, 0), a3, voffA);
            PG8_BAR; PG8_WAIT_L(0); PG8_MMA(1, 0, At, B0); PG8_BAR; PG8_SCHED;
            PG8_STAGE(PG8_SB(1, 1), b3 + hstep, voffB);
            PG8_WAIT_V(6); PG8_BAR; PG8_MMA(1, 1, At, B1); PG8_BAR;
            }
        }
        if constexpr (ALIGN_EPI) { if (wr == 0) PG8_BAR; }
        if constexpr (!Epi::AFTER_DRAIN) { E(acc, cur, wr, wc, fr, fq); S.done(cur); }
        if (!has_next) break;
#pragma unroll
        for (int a = 0; a < 2; ++a)
#pragma unroll
            for (int b = 0; b < 2; ++b)
#pragma unroll
                for (int m = 0; m < 4; ++m)
#pragma unroll
                    for (int n = 0; n < 2; ++n) acc[a][b][m][n] = (f32x4){0.f, 0.f, 0.f, 0.f};
        cur = nxt; cA = nA; cB = nB; ++ui;
        if constexpr (ALIGN_EPI) { if (wr == 1) PG8_BAR; }
    }
    PG8_WAIT_V(0);
    if constexpr (!ALIGN_EPI) { if (wr == 0) PG8_BAR; }
    PG8_BAR;
    if constexpr (Epi::AFTER_DRAIN) { E.fused(acc, cur, wr, wc, fr, fq, lds, wid, lane); S.done(cur); }
#undef PG8_SA
#undef PG8_SB
#undef PG8_STAGE
#undef PG8_LDA
#undef PG8_LDB
#undef PG8_MMA
#undef PG8_WAIT_V
#undef PG8_WAIT_L
#undef PG8_BAR
#undef PG8_SCHED
}
}

using pg8::bf16_t; using pg8::bf16x8; using pg8::f32x4; using pg8::u32x4; using pg8::Unit;
typedef float f32x2 __attribute__((ext_vector_type(2)));
typedef unsigned u32x2 __attribute__((ext_vector_type(2)));
#define LAS __attribute__((address_space(3)))

constexpr int NB = 2, SEQ = 8192, T = NB * SEQ, D = 1024;
constexpr int EVEN_IN = 2560, ODD_IN = 5120;
constexpr int NEXP = 16, DEXP = 512;
constexpr int PMAX = 36864;
constexpr int MAXTILES = PMAX / 256;
constexpr float DN_ALPHA = 1.41421356237f;
constexpr float LN_EPS = 1e-5f, RMS_EPS = 1e-6f;

constexpr size_t MiB = 1u << 20;
constexpr size_t WS_CTL = 0, CTL_BYTES = 1 * MiB;
constexpr size_t WS_ROPE = 1 * MiB;
constexpr size_t WS_LBV = 3 * MiB;
constexpr size_t WS_WINE = 4 * MiB;
constexpr size_t WS_WOUTE = 9 * MiB;
constexpr size_t WS_WINO = 11 * MiB;
constexpr size_t WS_WOUTO = 21 * MiB;
constexpr size_t WS_LGT = 23 * MiB;
constexpr size_t WS_HB = 24 * MiB;
constexpr size_t WS_PROJ = 56 * MiB;
constexpr size_t WS_XS = WS_PROJ;
constexpr size_t WS_HID = WS_PROJ + 72 * MiB;
constexpr size_t WS_RB = WS_PROJ + 80 * MiB;
constexpr size_t WS_MIX1 = 216 * MiB;
constexpr size_t WS_SCR = WS_PROJ + 80 * MiB;
constexpr size_t WS_WGU = 216 * MiB;
constexpr size_t WS_WD = 248 * MiB;
constexpr size_t WS_TOK = 3 * MiB + 65536;
constexpr size_t WS_END = 282 * MiB;
constexpr int CW_COUNTS = 1024;
constexpr int CW_CURSOR = 1024 + 64;
constexpr int CW_NTILES = 1024 + 128;
constexpr int CW_TILEE = 2048;
constexpr size_t TOK_E = 0, TOK_G = 128 * 1024, TOK_SLOT = 256 * 1024, TOK_BH = 384 * 1024;

struct Params {
    const float* x; const float* w_in_even; const float* w_out_even; const float* conv_w; const float* conv_b; const float* gate_w; const float* gate_b; const float* lam;
    const float* w_in_odd; const float* w_out_odd; const float* lower_bounds; const float* norm_w; const float* ln_w; const float* ln_b; const float* router_w;
    const float* moe_gate; const float* moe_up; const float* moe_down;
    float* out; unsigned char* ws;
};

__device__ __forceinline__ float bf2f(unsigned b) { return __uint_as_float(b << 16); }
__device__ __forceinline__ float bflo(unsigned u) { return __uint_as_float(u << 16); }
__device__ __forceinline__ float bfhi(unsigned u) { return __uint_as_float(u & 0xffff0000u); }
__device__ __forceinline__ unsigned f2bf(float f) { unsigned u = __float_as_uint(f); return (u + 0x7fffu + ((u >> 16) & 1u)) >> 16; }
__device__ __forceinline__ unsigned pk2(float lo, float hi) { return f2bf(lo) | (f2bf(hi) << 16); }
__device__ __forceinline__ float sigm(float x) { return 1.f / (1.f + __expf(-x)); }
__device__ __forceinline__ float silu(float x) { return x / (1.f + __expf(-x)); }
__device__ __forceinline__ float gelu_tanh(float x) { const float u = 0.7978845608028654f * (x + 0.044715f * x * x * x); return x / (1.f + __expf(-2.f * u)); }
__device__ __forceinline__ float wave_sum(float v) {
#pragma unroll
    for (int o = 1; o < 64; o <<= 1) v += __shfl_xor(v, o);
    return v;
}
#define LDS_WAIT() asm volatile("s_waitcnt lgkmcnt(0)" ::: "memory")
typedef __bf16 bf16x2_t __attribute__((ext_vector_type(2)));
__device__ __forceinline__ unsigned cvtpk(float lo, float hi) { const f32x2 v = {lo, hi}; const bf16x2_t b = __builtin_convertvector(v, bf16x2_t); return __builtin_bit_cast(unsigned, b); }

__device__ __forceinline__ void store8bf(bf16_t* p, const f32x4& v0, const f32x4& v1) {
    u32x4 w; w.x = cvtpk(v0[0], v0[1]); w.y = cvtpk(v0[2], v0[3]); w.z = cvtpk(v1[0], v1[1]); w.w = cvtpk(v1[2], v1[3]);
    *(u32x4*)p = w;
}
struct EpiInproj0 {
    static constexpr bool PERM = true, AFTER_DRAIN = false;
    bf16_t* O; const float* rope;
    __device__ __forceinline__ void operator()(const f32x4 (&acc)[2][2][4][2], const Unit& u, int wr, int wc, int fr, int fq) const {
        const int row0 = u.pm * 256 + wr * 64 + fr, colt = u.pn * 256 + wc * 32 + 8 * fq;
#pragma unroll
        for (int ai = 0; ai < 2; ++ai)
#pragma unroll
            for (int m = 0; m < 4; ++m) {
                const int row = row0 + ai * 128 + m * 16; const int pos = row & (SEQ - 1);
#pragma unroll
                for (int bj = 0; bj < 2; ++bj) {
                    const int col = colt + bj * 128;
                    f32x4 v0 = acc[ai][bj][m][0], v1 = acc[ai][bj][m][1];
                    if (u.pn < 2) {
                        const float sc = (col < 256) ? 0.125f : 1.0f;
                        const f32x4* rp = (const f32x4*)(rope + ((size_t)pos * 32 + ((col & 63) >> 1)) * 2);
                        const f32x4 c0 = rp[0], c1 = rp[1];
                        f32x4 r0, r1;
                        r0[0] = (v0[0] * c0[0] - v0[1] * c0[1]) * sc; r0[1] = (v0[0] * c0[1] + v0[1] * c0[0]) * sc;
                        r0[2] = (v0[2] * c0[2] - v0[3] * c0[3]) * sc; r0[3] = (v0[2] * c0[3] + v0[3] * c0[2]) * sc;
                        r1[0] = (v1[0] * c1[0] - v1[1] * c1[1]) * sc; r1[1] = (v1[0] * c1[1] + v1[1] * c1[0]) * sc;
                        r1[2] = (v1[2] * c1[2] - v1[3] * c1[3]) * sc; r1[3] = (v1[2] * c1[3] + v1[3] * c1[2]) * sc;
                        v0 = r0; v1 = r1;
                    }
                    store8bf(O + (size_t)row * EVEN_IN + col, v0, v1);
                }
            }
    }
};
struct EpiInproj1 {
    static constexpr bool PERM = true, AFTER_DRAIN = false;
    bf16_t* O; const float* lbv;
    __device__ __forceinline__ void operator()(const f32x4 (&acc)[2][2][4][2], const Unit& u, int wr, int wc, int fr, int fq) const {
        const int row0 = u.pm * 256 + wr * 64 + fr, colt = u.pn * 256 + wc * 32 + 8 * fq;
        const int seg = u.pn >> 2;
#pragma unroll
        for (int bj = 0; bj < 2; ++bj) {
            const int col = colt + bj * 128;
            f32x4 lb0 = {0.f, 0.f, 0.f, 0.f}, lb1 = {0.f, 0.f, 0.f, 0.f};
            if (seg == 2 || seg == 3) { lb0 = *(const f32x4*)(lbv + (col & 1023)); lb1 = *(const f32x4*)(lbv + (col & 1023) + 4); }
#pragma unroll
            for (int ai = 0; ai < 2; ++ai)
#pragma unroll
                for (int m = 0; m < 4; ++m) {
                    const int row = row0 + ai * 128 + m * 16;
                    f32x4 v0 = acc[ai][bj][m][0], v1 = acc[ai][bj][m][1];
                    if (seg == 0) {
#pragma unroll
                        for (int j = 0; j < 4; ++j) { v0[j] = silu(v0[j]) * 0.08838834764831845f; v1[j] = silu(v1[j]) * 0.08838834764831845f; }
                    } else if (seg == 2 || seg == 3) {
#pragma unroll
                        for (int j = 0; j < 4; ++j) { v0[j] = __logf(lb0[j] + (1.f - lb0[j]) * sigm(v0[j])); v1[j] = __logf(lb1[j] + (1.f - lb1[j]) * sigm(v1[j])); }
                    }
                    store8bf(O + (size_t)row * ODD_IN + col, v0, v1);
                }
        }
    }
};
template <bool RES_BF16> struct EpiResid {
    static constexpr bool PERM = true, AFTER_DRAIN = false;
    const void* res; bf16_t* out;
    __device__ __forceinline__ void operator()(const f32x4 (&acc)[2][2][4][2], const Unit& u, int wr, int wc, int fr, int fq) const {
        const int row0 = u.pm * 256 + wr * 64 + fr, colt = u.pn * 256 + wc * 32 + 8 * fq;
#pragma unroll
        for (int ai = 0; ai < 2; ++ai)
#pragma unroll
            for (int m = 0; m < 4; ++m) {
                const size_t off = (size_t)(row0 + ai * 128 + m * 16) * D + colt;
#pragma unroll
                for (int bj = 0; bj < 2; ++bj) {
                    f32x4 r0, r1;
                    if (RES_BF16) { const u32x4 rv = *(const u32x4*)((const bf16_t*)res + off + bj * 128);
                        r0 = (f32x4){bflo(rv.x), bfhi(rv.x), bflo(rv.y), bfhi(rv.y)}; r1 = (f32x4){bflo(rv.z), bfhi(rv.z), bflo(rv.w), bfhi(rv.w)}; }
                    else { r0 = *(const f32x4*)((const float*)res + off + bj * 128); r1 = *(const f32x4*)((const float*)res + off + bj * 128 + 4); }
                    store8bf(out + off + bj * 128, r0 * DN_ALPHA + acc[ai][bj][m][0], r1 * DN_ALPHA + acc[ai][bj][m][1]);
                }
            }
    }
};
struct EpiGateUp {
    static constexpr bool PERM = true, AFTER_DRAIN = false;
    bf16_t* O;
    __device__ __forceinline__ void operator()(const f32x4 (&acc)[2][2][4][2], const Unit& u, int wr, int wc, int fr, int fq) const {
        const int row0 = u.pm * 256 + wr * 64 + fr, col = u.pn * 128 + wc * 32 + 8 * fq;
#pragma unroll
        for (int ai = 0; ai < 2; ++ai)
#pragma unroll
            for (int m = 0; m < 4; ++m) {
                const int row = row0 + ai * 128 + m * 16;
                f32x4 v0, v1;
#pragma unroll
                for (int j = 0; j < 4; ++j) { v0[j] = silu(acc[ai][0][m][0][j]) * acc[ai][1][m][0][j]; v1[j] = silu(acc[ai][0][m][1][j]) * acc[ai][1][m][1][j]; }
                store8bf(O + (size_t)row * DEXP + col, v0, v1);
            }
    }
};
struct EpiBf16 {
    static constexpr bool PERM = true, AFTER_DRAIN = false;
    bf16_t* O; int ldc;
    __device__ __forceinline__ void operator()(const f32x4 (&acc)[2][2][4][2], const Unit& u, int wr, int wc, int fr, int fq) const {
        const int row0 = u.pm * 256 + wr * 64 + fr, colt = u.pn * 256 + wc * 32 + 8 * fq;
#pragma unroll
        for (int ai = 0; ai < 2; ++ai)
#pragma unroll
            for (int m = 0; m < 4; ++m) {
                const int row = row0 + ai * 128 + m * 16;
#pragma unroll
                for (int bj = 0; bj < 2; ++bj) store8bf(O + (size_t)row * ldc + colt + bj * 128, acc[ai][bj][m][0], acc[ai][bj][m][1]);
            }
    }
};

__device__ __forceinline__ void transpose_item(const float* W, int N, bf16_t* WT, int K, int k0, int n0, int drow0, LAS float* scr, int lane) {
#pragma unroll 8
    for (int i = 0; i < 32; ++i) { const int kk = 2 * i + (lane >> 5); scr[kk * 33 + (lane & 31)] = W[(size_t)(k0 + kk) * N + n0 + (lane & 31)]; }
    LDS_WAIT();
    const int c = lane & 7;
#pragma unroll
    for (int j = 0; j < 4; ++j) { const int n = (lane >> 3) + 8 * j; const LAS float* s = scr + (8 * c) * 33 + n;
        u32x4 o; o.x = pk2(s[0 * 33], s[1 * 33]); o.y = pk2(s[2 * 33], s[3 * 33]); o.z = pk2(s[4 * 33], s[5 * 33]); o.w = pk2(s[6 * 33], s[7 * 33]);
        *(u32x4*)(WT + (size_t)(drow0 + n) * K + k0 + 8 * c) = o; }
    LDS_WAIT();
}
__device__ __forceinline__ void transpose_dense(const float* W, int K, int N, bf16_t* WT, int item, LAS float* scr, int lane) {
    const int nblk = N / 32, kb = item / nblk, nb = item % nblk;
    transpose_item(W, N, WT, K, 64 * kb, 32 * nb, 32 * nb, scr, lane);
}
__device__ __forceinline__ void prologue_static(const Params& p, LAS float* scr, int gw, int ngw, int lane) {
    unsigned char* ws = p.ws;
    constexpr int I_WINE = 16 * 80, I_WOUTE = 16 * 32, I_WINO = 16 * 160, I_WOUTO = 16 * 32, I_LG = 16 * 8;
    constexpr int NITEMS = I_WINE + I_WOUTE + I_WINO + I_WOUTO + I_LG;
    for (int it = gw; it < NITEMS; it += ngw) {
        int r = it;
        if (r < I_WINE) { transpose_dense(p.w_in_even, 1024, EVEN_IN, (bf16_t*)(ws + WS_WINE), r, scr, lane); continue; } r -= I_WINE;
        if (r < I_WOUTE) { transpose_dense(p.w_out_even, 1024, 1024, (bf16_t*)(ws + WS_WOUTE), r, scr, lane); continue; } r -= I_WOUTE;
        if (r < I_WINO) { transpose_dense(p.w_in_odd, 1024, ODD_IN, (bf16_t*)(ws + WS_WINO), r, scr, lane); continue; } r -= I_WINO;
        if (r < I_WOUTO) { transpose_dense(p.w_out_odd, 1024, 1024, (bf16_t*)(ws + WS_WOUTO), r, scr, lane); continue; } r -= I_WOUTO;
        { const int mat = r >> 3, sub = r & 7;
          transpose_dense(p.gate_w + (size_t)mat * 128 * 128, 128, 128, (bf16_t*)(ws + WS_LGT) + (size_t)mat * 128 * 128, sub, scr, lane); }
    }
    { const size_t n8 = (size_t)T * D / 8; bf16_t* xb = (bf16_t*)(ws + WS_HB);
      for (size_t i = (size_t)gw * 64 + lane; i < n8; i += (size_t)ngw * 64) {
          const f32x4 a = *(const f32x4*)(p.x + i * 8), b = *(const f32x4*)(p.x + i * 8 + 4);
          u32x4 o; o.x = pk2(a[0], a[1]); o.y = pk2(a[2], a[3]); o.z = pk2(b[0], b[1]); o.w = pk2(b[2], b[3]);
          *(u32x4*)(xb + i * 8) = o; } }
    { float* rope = (float*)(ws + WS_ROPE);
      for (int i = gw * 64 + lane; i < SEQ * 32; i += ngw * 64) {
          const int pos = i >> 5, fi = i & 31;
          double inv = 0.15915494309189535;
          if (fi & 1) inv *= 0.7498942093324559; if (fi & 2) inv *= 0.5623413251903491; if (fi & 4) inv *= 0.31622776601683794; if (fi & 8) inv *= 0.1; if (fi & 16) inv *= 0.01;
          const double rev = (double)pos * inv; const float fr = (float)(rev - floor(rev));
          rope[2 * i] = __builtin_amdgcn_cosf(fr); rope[2 * i + 1] = __builtin_amdgcn_sinf(fr); }
      float* lbv = (float*)(ws + WS_LBV);
      for (int i = gw * 64 + lane; i < 1024; i += ngw * 64) { const float l0 = p.lower_bounds[i], l1 = p.lower_bounds[1024 + i]; lbv[i] = 1.f / (1.f + __expf(l0 - l1)); } }
}
__device__ __forceinline__ void prologue_moe(const Params& p, int layer, LAS float* scr, int gw, int ngw, int lane) {
    unsigned char* ws = p.ws;
    constexpr int I_GU = 16 * 16, I_D = 8 * 32;
    constexpr int NITEMS = NEXP * (2 * I_GU + I_D);
    for (int it = gw; it < NITEMS; it += ngw) {
        const int e = it / (2 * I_GU + I_D); int r = it % (2 * I_GU + I_D);
        if (r < 2 * I_GU) { const int sel = r / I_GU; r %= I_GU; const int kb = r / 16, nb = r % 16, n0 = 32 * nb;
            const float* W = (sel ? p.moe_up : p.moe_gate) + ((size_t)layer * NEXP + e) * 1024 * 512;
            transpose_item(W, 512, (bf16_t*)(ws + WS_WGU) + (size_t)e * 1024 * 1024, 1024, 64 * kb, n0, 256 * (n0 >> 7) + 128 * sel + (n0 & 127), scr, lane);
        } else { r -= 2 * I_GU;
            const float* W = p.moe_down + ((size_t)layer * NEXP + e) * 512 * 1024;
            transpose_dense(W, 512, 1024, (bf16_t*)(ws + WS_WD) + (size_t)e * 1024 * 512, r, scr, lane); }
    }
}

__device__ __forceinline__ void ln_rows_store(const f32x4 (&v)[4], const float* lw, const float* lb, float* orow, bf16_t* brow, int lane, f32x4 (&h)[4]) {
    float s = 0.f;
#pragma unroll
    for (int j = 0; j < 4; ++j) s += (v[j][0] + v[j][1]) + (v[j][2] + v[j][3]);
    const float mean = wave_sum(s) * (1.f / D); float s2 = 0.f;
#pragma unroll
    for (int j = 0; j < 4; ++j) { const f32x4 d = v[j] - mean; s2 += (d[0] * d[0] + d[1] * d[1]) + (d[2] * d[2] + d[3] * d[3]); }
    const float rstd = 1.f / sqrtf(wave_sum(s2) * (1.f / D) + LN_EPS);
#pragma unroll
    for (int j = 0; j < 4; ++j) { const int c = 4 * lane + 256 * j; const f32x4 w = *(const f32x4*)(lw + c), b = *(const f32x4*)(lb + c);
        h[j] = (v[j] - mean) * rstd * w + b;
        *(f32x4*)(orow + c) = h[j];
        u32x2 o; o.x = pk2(h[j][0], h[j][1]); o.y = pk2(h[j][2], h[j][3]); *(u32x2*)(brow + c) = o; }
}
__device__ __forceinline__ void ln_router_row(const Params& p, int layer, int row, int lane, LAS int* hist) {
    unsigned char* ws = p.ws; float* res = p.out + (size_t)row * D; bf16_t* hb = (bf16_t*)(ws + WS_HB) + (size_t)row * D;
    f32x4 v[4], h[4];
#pragma unroll
    for (int j = 0; j < 4; ++j) v[j] = *(const f32x4*)(res + 4 * lane + 256 * j);
    ln_rows_store(v, p.ln_w + (size_t)(layer * 2 + 0) * D, p.ln_b + (size_t)(layer * 2 + 0) * D, res, hb, lane, h);
    float lg[16];
#pragma unroll
    for (int e = 0; e < 16; ++e) lg[e] = 0.f;
#pragma unroll
    for (int j = 0; j < 4; ++j)
#pragma unroll
        for (int i = 0; i < 4; ++i) { const float* rw = p.router_w + (size_t)(4 * lane + 256 * j + i) * 16; const float hv = h[j][i];
#pragma unroll
            for (int q = 0; q < 4; ++q) { const f32x4 w = *(const f32x4*)(rw + 4 * q); lg[4 * q] += hv * w[0]; lg[4 * q + 1] += hv * w[1]; lg[4 * q + 2] += hv * w[2]; lg[4 * q + 3] += hv * w[3]; } }
#pragma unroll
    for (int e = 0; e < 16; ++e) lg[e] = wave_sum(lg[e]);
    float mx = lg[0];
#pragma unroll
    for (int e = 1; e < 16; ++e) mx = fmaxf(mx, lg[e]);
    float pr[16], sum = 0.f;
#pragma unroll
    for (int e = 0; e < 16; ++e) { pr[e] = __expf(lg[e] - mx); sum += pr[e]; }
    const float inv = 1.f / sum;
#pragma unroll
    for (int e = 0; e < 16; ++e) pr[e] *= inv;
    float best = -1.f; int be0 = 0, be1 = 1; float bv0 = 0.f, bv1 = 0.f;
#pragma unroll
    for (int g = 0; g < 4; ++g) {
        int i1 = 0; float v1 = pr[4 * g];
#pragma unroll
        for (int i = 1; i < 4; ++i) if (pr[4 * g + i] > v1) { v1 = pr[4 * g + i]; i1 = i; }
        int i2 = -1; float v2 = -1.f;
#pragma unroll
        for (int i = 0; i < 4; ++i) if (i != i1 && pr[4 * g + i] > v2) { v2 = pr[4 * g + i]; i2 = i; }
        const float sc = v1 + v2;
        if (sc > best) { best = sc; be0 = 4 * g + i1; be1 = 4 * g + i2; bv0 = v1; bv1 = v2; }
    }
    if (lane == 0) {
        int* te = (int*)(ws + WS_TOK + TOK_E); float* tg = (float*)(ws + WS_TOK + TOK_G);
        te[2 * row] = be0; te[2 * row + 1] = be1; const float gs = 1.f / (bv0 + bv1); tg[2 * row] = bv0 * gs; tg[2 * row + 1] = bv1 * gs;
        atomicAdd((int*)&hist[be0], 1); atomicAdd((int*)&hist[be1], 1);
    }
}
__device__ __forceinline__ void combine_ln_row(const Params& p, int layer, int row, int lane) {
    unsigned char* ws = p.ws; float* res = p.out + (size_t)row * D; bf16_t* hb = (bf16_t*)(ws + WS_HB) + (size_t)row * D;
    const int* tsl = (const int*)(ws + WS_TOK + TOK_SLOT); const float* tg = (const float*)(ws + WS_TOK + TOK_G);
    const int s0 = tsl[2 * row], s1 = tsl[2 * row + 1]; const float g0 = tg[2 * row], g1 = tg[2 * row + 1];
    const bf16_t* y0 = (const bf16_t*)(ws + WS_XS) + (size_t)s0 * D; const bf16_t* y1 = (const bf16_t*)(ws + WS_XS) + (size_t)s1 * D;
    f32x4 v[4], h[4];
#pragma unroll
    for (int j = 0; j < 4; ++j) { const int c = 4 * lane + 256 * j; const f32x4 r = *(const f32x4*)(res + c);
        const u32x2 a = *(const u32x2*)(y0 + c), b = *(const u32x2*)(y1 + c);
        v[j][0] = DN_ALPHA * r[0] + g0 * bflo(a.x) + g1 * bflo(b.x); v[j][1] = DN_ALPHA * r[1] + g0 * bfhi(a.x) + g1 * bfhi(b.x);
        v[j][2] = DN_ALPHA * r[2] + g0 * bflo(a.y) + g1 * bflo(b.y); v[j][3] = DN_ALPHA * r[3] + g0 * bfhi(a.y) + g1 * bfhi(b.y); }
    ln_rows_store(v, p.ln_w + (size_t)(layer * 2 + 1) * D, p.ln_b + (size_t)(layer * 2 + 1) * D, res, hb, lane, h);
}
#define XB_TMO      128
#define XB_XCNT(j)  (256  + 64 * (j))
#define XB_XSUB(j)  (1280 + 64 * (j))
#define XB_XGEN(j)  (2304 + 64 * (j))
#define XB_TOP      3328
#define XB_TOPGEN   3392
#define XCD_BAR_WORDS 3456
#define XB_SPIN_CAP (1u << 18)

__device__ __forceinline__ unsigned xb_ld(unsigned* p)              { return __hip_atomic_load(p, __ATOMIC_RELAXED, __HIP_MEMORY_SCOPE_AGENT); }
__device__ __forceinline__ unsigned xb_add(unsigned* p, unsigned v) { return __hip_atomic_fetch_add(p, v, __ATOMIC_RELAXED, __HIP_MEMORY_SCOPE_AGENT); }
__device__ __forceinline__ unsigned xb_xcc_id() { return (unsigned)__builtin_amdgcn_s_getreg((3 << 11) | 20) & 0xFu; }
#define XB_SPIN(cond, bar) do { unsigned _sp = 0; while (cond) { __builtin_amdgcn_s_sleep(1); \
    if ((++_sp & 255u) == 0u) { if (xb_ld(&(bar)[XB_TMO])) break; if (_sp > XB_SPIN_CAP) { atomicAdd(&(bar)[XB_TMO], 1u); break; } } } } while (0)

struct XcdBarrier {
    unsigned* bar; unsigned x;
    volatile LAS unsigned* st;
};

__device__ __forceinline__ XcdBarrier xcd_barrier_post(unsigned* bar, volatile LAS unsigned* st) {
    XcdBarrier b; b.bar = bar; b.x = xb_xcc_id(); b.st = st;
    if (threadIdx.x == 0) (void)xb_add(&bar[XB_XCNT(b.x)], 1u);
    return b;
}
__device__ __forceinline__ void xcd_barrier_complete(unsigned* bar, unsigned x, unsigned& nloc, unsigned& nx) {
    const unsigned G = gridDim.x * gridDim.y * gridDim.z;
    unsigned sum, cnt, mine, sp = 0u;
    for (;;) {
        sum = 0u; cnt = 0u; mine = 0u;
#pragma unroll
        for (unsigned j = 0; j < 16; ++j) { const unsigned c = xb_ld(&bar[XB_XCNT(j)]); sum += c; cnt += (c > 0u) ? 1u : 0u; mine = (j == x) ? c : mine; }
        if (sum == G) break;
        __builtin_amdgcn_s_sleep(1);
        if ((++sp & 255u) == 0u) { if (xb_ld(&bar[XB_TMO])) break; if (sp > XB_SPIN_CAP) { atomicAdd(&bar[XB_TMO], 1u); break; } }
    }
    nloc = mine > 0u ? mine : 1u; nx = cnt > 0u ? cnt : 1u;
}

__device__ __forceinline__ void xcd_barrier(const XcdBarrier& b) {
    asm volatile("s_waitcnt vmcnt(0)" ::: "memory");
    __syncthreads();
    if (threadIdx.x == 0) {
        unsigned* bar = b.bar;
        __builtin_amdgcn_s_waitcnt(0);
        unsigned nloc = b.st[0], nx = b.st[1];
        if (nloc == 0u) { xcd_barrier_complete(bar, b.x, nloc, nx); b.st[0] = nloc; b.st[1] = nx; }
        const unsigned old = xb_add(&bar[XB_XSUB(b.x)], 1u);
        const unsigned gen = old / nloc;
        if (old + 1u == (gen + 1u) * nloc) {
            __builtin_amdgcn_fence(__ATOMIC_RELEASE, "agent");
            asm volatile("s_waitcnt vmcnt(0)" ::: "memory");
            const unsigned og = xb_add(&bar[XB_TOP], 1u);
            const unsigned tg = og / nx;
            if (og + 1u == (tg + 1u) * nx) xb_add(&bar[XB_TOPGEN], 1u);
            else XB_SPIN(xb_ld(&bar[XB_TOPGEN]) == tg, bar);
            __builtin_amdgcn_fence(__ATOMIC_ACQUIRE, "agent");
            xb_add(&bar[XB_XGEN(b.x)], 1u);
            asm volatile("s_waitcnt vmcnt(0)" ::: "memory");
        } else {
            XB_SPIN(xb_ld(&bar[XB_XGEN(b.x)]) == gen, bar);
            __builtin_amdgcn_fence(__ATOMIC_ACQUIRE, "agent");
            asm volatile("s_waitcnt vmcnt(0)" ::: "memory");
        }
    }
    __syncthreads();
}

template <bool F32OUT> __device__ __forceinline__ void ln_rows_inplace(f32x4 (&v)[4], const float* lw, const float* lb, float* orow, bf16_t* brow, int lane) {
    float s = 0.f;
#pragma unroll
    for (int j = 0; j < 4; ++j) s += (v[j][0] + v[j][1]) + (v[j][2] + v[j][3]);
    const float mean = wave_sum(s) * (1.f / D); float s2 = 0.f;
#pragma unroll
    for (int j = 0; j < 4; ++j) { const f32x4 d = v[j] - mean; s2 += (d[0] * d[0] + d[1] * d[1]) + (d[2] * d[2] + d[3] * d[3]); }
    const float rstd = 1.f / sqrtf(wave_sum(s2) * (1.f / D) + LN_EPS);
#pragma unroll
    for (int j = 0; j < 4; ++j) { const int c = 4 * lane + 256 * j; const f32x4 w = *(const f32x4*)(lw + c), b = *(const f32x4*)(lb + c);
        v[j] = (v[j] - mean) * rstd * w + b;
        if (F32OUT) *(f32x4*)(orow + c) = v[j];
        else { u32x2 o; o.x = cvtpk(v[j][0], v[j][1]); o.y = cvtpk(v[j][2], v[j][3]); *(u32x2*)(brow + c) = o; } }
}
__device__ __forceinline__ float reduce16(const float (&v)[16], int lane) {
    const bool b3 = (lane & 8) != 0, b2 = (lane & 4) != 0, b1 = (lane & 2) != 0, b0 = (lane & 1) != 0;
    float a8[8], a4[4], a2[2];
#pragma unroll
    for (int i = 0; i < 8; ++i) { const float keep = b3 ? v[8 + i] : v[i], send = b3 ? v[i] : v[8 + i]; a8[i] = keep + __shfl_xor(send, 8); }
#pragma unroll
    for (int i = 0; i < 4; ++i) { const float keep = b2 ? a8[4 + i] : a8[i], send = b2 ? a8[i] : a8[4 + i]; a4[i] = keep + __shfl_xor(send, 4); }
#pragma unroll
    for (int i = 0; i < 2; ++i) { const float keep = b1 ? a4[2 + i] : a4[i], send = b1 ? a4[i] : a4[2 + i]; a2[i] = keep + __shfl_xor(send, 2); }
    float a1 = (b0 ? a2[1] : a2[0]) + __shfl_xor(b0 ? a2[0] : a2[1], 1);
    a1 += __shfl_xor(a1, 16); a1 += __shfl_xor(a1, 32);
    return a1;
}
template <int R> __device__ __forceinline__ void ln_router_rows(const Params& p, int layer, int row0, int lane, LAS int* hist) {
    unsigned char* ws = p.ws;
    const float* lw = p.ln_w + (size_t)(layer * 2 + 0) * D; const float* lb = p.ln_b + (size_t)(layer * 2 + 0) * D;
    f32x4 h[R][4];
#pragma unroll
    for (int rr = 0; rr < R; ++rr)
#pragma unroll
        for (int j = 0; j < 4; ++j) { const u32x2 rv = *(const u32x2*)((const bf16_t*)(ws + WS_RB) + (size_t)(row0 + rr) * D + 4 * lane + 256 * j); h[rr][j] = (f32x4){bflo(rv.x), bfhi(rv.x), bflo(rv.y), bfhi(rv.y)}; }
#pragma unroll
    for (int rr = 0; rr < R; ++rr) ln_rows_inplace<false>(h[rr], lw, lb, nullptr, (bf16_t*)(ws + WS_HB) + (size_t)(row0 + rr) * D, lane);
    float lg[R][16];
#pragma unroll
    for (int rr = 0; rr < R; ++rr)
#pragma unroll
        for (int e = 0; e < 16; ++e) lg[rr][e] = 0.f;
#pragma unroll
    for (int j = 0; j < 4; ++j)
#pragma unroll
        for (int i = 0; i < 4; ++i) {
            const float* rw = p.router_w + (size_t)(4 * lane + 256 * j + i) * 16;
            const f32x4 w0 = *(const f32x4*)(rw), w1 = *(const f32x4*)(rw + 4), w2 = *(const f32x4*)(rw + 8), w3 = *(const f32x4*)(rw + 12);
#pragma unroll
            for (int rr = 0; rr < R; ++rr) { const float hv = h[rr][j][i];
                lg[rr][0] += hv * w0[0]; lg[rr][1] += hv * w0[1]; lg[rr][2] += hv * w0[2]; lg[rr][3] += hv * w0[3];
                lg[rr][4] += hv * w1[0]; lg[rr][5] += hv * w1[1]; lg[rr][6] += hv * w1[2]; lg[rr][7] += hv * w1[3];
                lg[rr][8] += hv * w2[0]; lg[rr][9] += hv * w2[1]; lg[rr][10] += hv * w2[2]; lg[rr][11] += hv * w2[3];
                lg[rr][12] += hv * w3[0]; lg[rr][13] += hv * w3[1]; lg[rr][14] += hv * w3[2]; lg[rr][15] += hv * w3[3]; }
        }
    float tot[R];
#pragma unroll
    for (int rr = 0; rr < R; ++rr) tot[rr] = reduce16(lg[rr], lane);
#pragma unroll
    for (int rr = 0; rr < R; ++rr) {
        float lgs[16];
#pragma unroll
        for (int e = 0; e < 16; ++e) lgs[e] = __builtin_bit_cast(float, __builtin_amdgcn_readlane(__builtin_bit_cast(int, tot[rr]), e));
        float mx = lgs[0];
#pragma unroll
        for (int e = 1; e < 16; ++e) mx = fmaxf(mx, lgs[e]);
        float pr[16], sum = 0.f;
#pragma unroll
        for (int e = 0; e < 16; ++e) { pr[e] = __expf(lgs[e] - mx); sum += pr[e]; }
        const float inv = 1.f / sum;
#pragma unroll
        for (int e = 0; e < 16; ++e) pr[e] *= inv;
        float best = -1.f; int be0 = 0, be1 = 1; float bv0 = 0.f, bv1 = 0.f;
#pragma unroll
        for (int g = 0; g < 4; ++g) {
            int i1 = 0; float v1 = pr[4 * g];
#pragma unroll
            for (int i = 1; i < 4; ++i) if (pr[4 * g + i] > v1) { v1 = pr[4 * g + i]; i1 = i; }
            int i2 = -1; float v2 = -1.f;
#pragma unroll
            for (int i = 0; i < 4; ++i) if (i != i1 && pr[4 * g + i] > v2) { v2 = pr[4 * g + i]; i2 = i; }
            const float sc = v1 + v2;
            if (sc > best) { best = sc; be0 = 4 * g + i1; be1 = 4 * g + i2; bv0 = v1; bv1 = v2; }
        }
        if (lane == 0) {
            const int row = row0 + rr;
            int* te = (int*)(ws + WS_TOK + TOK_E); float* tg = (float*)(ws + WS_TOK + TOK_G);
            te[2 * row] = be0; te[2 * row + 1] = be1; const float gs = 1.f / (bv0 + bv1); tg[2 * row] = bv0 * gs; tg[2 * row + 1] = bv1 * gs;
            atomicAdd((int*)&hist[be0], 1); atomicAdd((int*)&hist[be1], 1);
        }
    }
}
template <bool FINAL> __device__ __forceinline__ void combine_ln_rows4(const Params& p, int layer, int row0, int lane) {
    unsigned char* ws = p.ws;
    const int* tsl = (const int*)(ws + WS_TOK + TOK_SLOT); const float* tg = (const float*)(ws + WS_TOK + TOK_G);
    f32x4 v[4][4];
#pragma unroll
    for (int rr = 0; rr < 4; ++rr) {
        const int row = row0 + rr;
        const int s0 = tsl[2 * row], s1 = tsl[2 * row + 1]; const float g0 = tg[2 * row], g1 = tg[2 * row + 1];
        const bf16_t* y0 = (const bf16_t*)(ws + WS_XS) + (size_t)s0 * D; const bf16_t* y1 = (const bf16_t*)(ws + WS_XS) + (size_t)s1 * D;
#pragma unroll
        for (int j = 0; j < 4; ++j) { const int c = 4 * lane + 256 * j; const u32x2 rq = *(const u32x2*)((const bf16_t*)(ws + WS_HB) + (size_t)row * D + c); const f32x4 r = {bflo(rq.x), bfhi(rq.x), bflo(rq.y), bfhi(rq.y)};
            const u32x2 a = *(const u32x2*)(y0 + c), b = *(const u32x2*)(y1 + c);
            v[rr][j][0] = DN_ALPHA * r[0] + g0 * bflo(a.x) + g1 * bflo(b.x); v[rr][j][1] = DN_ALPHA * r[1] + g0 * bfhi(a.x) + g1 * bfhi(b.x);
            v[rr][j][2] = DN_ALPHA * r[2] + g0 * bflo(a.y) + g1 * bflo(b.y); v[rr][j][3] = DN_ALPHA * r[3] + g0 * bfhi(a.y) + g1 * bfhi(b.y); }
    }
#pragma unroll
    for (int rr = 0; rr < 4; ++rr)
        ln_rows_inplace<FINAL>(v[rr], p.ln_w + (size_t)(layer * 2 + 1) * D, p.ln_b + (size_t)(layer * 2 + 1) * D, p.out + (size_t)(row0 + rr) * D, (bf16_t*)(ws + WS_HB) + (size_t)(row0 + rr) * D, lane);
}

constexpr int STAGE_LDS = 131072;
constexpr int MISC_OFF = STAGE_LDS + 320;
constexpr int LDS_BYTES = 147456;
constexpr int CW_BAR = 4096;

__device__ __forceinline__ void ph_inproj0(const Params& p, PG8_LAS unsigned char* lds, int bid, int nb) {
    pg8::Gemm g{(const bf16_t*)(p.ws + WS_HB), (const bf16_t*)(p.ws + WS_WINE), T, EVEN_IN, D};
    pg8::StaticOrder S; S.init(T, EVEN_IN, D, nb, bid);
    EpiInproj0 E{(bf16_t*)(p.ws + WS_PROJ), (const float*)(p.ws + WS_ROPE)};
    pg8::gemm_phase<EpiInproj0, pg8::StaticOrder, true, true>(lds, g, S, E);
}
__device__ __forceinline__ void ph_inproj1(const Params& p, PG8_LAS unsigned char* lds, int bid, int nb) {
    pg8::Gemm g{(const bf16_t*)(p.ws + WS_HB), (const bf16_t*)(p.ws + WS_WINO), T, ODD_IN, D};
    pg8::StaticOrder S; S.init(T, ODD_IN, D, nb, bid);
    EpiInproj1 E{(bf16_t*)(p.ws + WS_PROJ), (const float*)(p.ws + WS_LBV)};
    pg8::gemm_phase<EpiInproj1, pg8::StaticOrder, true, true>(lds, g, S, E);
}
template <int LAYER>
__device__ __forceinline__ void ph_outproj(const Params& p, PG8_LAS unsigned char* lds, int bid, int nb) {
    pg8::Gemm g{(const bf16_t*)(p.ws + (LAYER ? WS_MIX1 : WS_HB)), (const bf16_t*)(p.ws + (LAYER ? WS_WOUTO : WS_WOUTE)), T, D, D};
    pg8::StaticOrder S; S.init(T, D, D, nb, bid);
    EpiResid<LAYER != 0> E{LAYER ? (const void*)(p.ws + WS_HB) : (const void*)p.x, (bf16_t*)(p.ws + WS_RB)};
    pg8::gemm_phase<EpiResid<LAYER != 0>, pg8::StaticOrder, true, true>(lds, g, S, E);
}
__device__ __forceinline__ void ph_moe_gateup(const Params& p, int layer, PG8_LAS unsigned char* lds, int bid, int nb) {
    const unsigned* ctl = (const unsigned*)(p.ws + WS_CTL);
    pg8::Gemm g{(const bf16_t*)(p.ws + WS_XS), (const bf16_t*)(p.ws + WS_WGU), PMAX, 1024, D};
    pg8::GroupedOrder S; S.tile_e = (const int*)(ctl + CW_TILEE + 256 * layer); S.ntiles = __builtin_amdgcn_readfirstlane((int)ctl[CW_NTILES + layer]); S.nN = 4; S.G = nb; S.c = bid;
    EpiGateUp E{(bf16_t*)(p.ws + WS_HID)};
    pg8::gemm_phase<EpiGateUp, pg8::GroupedOrder, true, true>(lds, g, S, E);
}
__device__ __forceinline__ void ph_moe_down(const Params& p, int layer, PG8_LAS unsigned char* lds, int bid, int nb) {
    const unsigned* ctl = (const unsigned*)(p.ws + WS_CTL);
    pg8::Gemm g{(const bf16_t*)(p.ws + WS_HID), (const bf16_t*)(p.ws + WS_WD), PMAX, 1024, DEXP};
    pg8::GroupedOrder S; S.tile_e = (const int*)(ctl + CW_TILEE + 256 * layer); S.ntiles = __builtin_amdgcn_readfirstlane((int)ctl[CW_NTILES + layer]); S.nN = 4; S.G = nb; S.c = bid;
    EpiBf16 E{(bf16_t*)(p.ws + WS_XS), D};
    pg8::gemm_phase<EpiBf16, pg8::GroupedOrder, true, true>(lds, g, S, E);
}

__device__ __forceinline__ void ph_ret_naive(const Params& p, int tid, int bid) {
    const int vb = bid * 4 + (tid >> 7); if (vb >= 16) return;
    const int dir = vb & 1, bh = vb >> 1, b = bh >> 2, h = bh & 3, e = tid & 127;
    const bf16_t* proj = (const bf16_t*)(p.ws + WS_PROJ);
    float* O = (float*)(p.ws + WS_SCR) + (size_t)dir * T * 512;
    const float gamma = 1.f - exp2f(-5.f - (float)h);
    float S[64];
#pragma unroll
    for (int d = 0; d < 64; ++d) S[d] = 0.f;
    for (int step = 0; step < SEQ; ++step) {
        const int t = dir ? SEQ - 1 - step : step; const size_t row = (size_t)b * SEQ + t;
        const bf16_t* pr = proj + row * EVEN_IN;
        const float v = bf2f(pr[512 + h * 128 + e]);
        float o = 0.f;
#pragma unroll
        for (int c = 0; c < 8; ++c) {
            const u32x4 qq = *(const u32x4*)(pr + h * 64 + 8 * c), kk = *(const u32x4*)(pr + 256 + h * 64 + 8 * c);
            const unsigned qa[4] = {qq.x, qq.y, qq.z, qq.w}, ka[4] = {kk.x, kk.y, kk.z, kk.w};
#pragma unroll
            for (int j = 0; j < 4; ++j) {
                const float q0 = bflo(qa[j]), q1 = bfhi(qa[j]), k0 = bflo(ka[j]), k1 = bfhi(ka[j]);
                const int d = 8 * c + 2 * j;
                if (dir == 0) { S[d] = gamma * S[d] + k0 * v; o += q0 * S[d]; S[d + 1] = gamma * S[d + 1] + k1 * v; o += q1 * S[d + 1]; }
                else { const float s0 = gamma * S[d], s1 = gamma * S[d + 1]; o += q0 * s0 + q1 * s1; S[d] = s0 + k0 * v; S[d + 1] = s1 + k1 * v; }
            }
        }
        O[row * 512 + h * 128 + e] = o;
    }
}
__device__ __forceinline__ void ph_ret_norm(const Params& p, int tid, int bid, int nb) {
    const int lane = tid & 63;
    const float* Of = (const float*)(p.ws + WS_SCR); const float* Ob = Of + (size_t)T * 512;
    const bf16_t* proj = (const bf16_t*)(p.ws + WS_PROJ); bf16_t* mix = (bf16_t*)(p.ws + WS_HB);
    for (int gwv = bid * 8 + (tid >> 6); gwv < T * 4; gwv += nb * 8) {
        const int row = gwv >> 2, h = gwv & 3;
        const size_t o = (size_t)row * 512 + h * 128 + 2 * lane;
        const float a0 = Of[o] + Ob[o], a1 = Of[o + 1] + Ob[o + 1];
        const float mean = wave_sum(a0 + a1) * (1.f / 128.f); const float d0 = a0 - mean, d1 = a1 - mean;
        const float rstd = 1.f / sqrtf(wave_sum(d0 * d0 + d1 * d1) * (1.f / 128.f) + LN_EPS);
        const unsigned gg = *(const unsigned*)(proj + (size_t)row * EVEN_IN + 1024 + h * 128 + 2 * lane);
        *(unsigned*)(mix + (size_t)row * D + h * 128 + 2 * lane) = pk2(d0 * rstd * silu(bflo(gg)), d1 * rstd * silu(bfhi(gg)));
    }
}
__device__ __forceinline__ void ph_lru_ab(const Params& p, int tid, LAS float* xc_s, int bid, int nb) {
    const int w = tid;
    const bf16_t* proj = (const bf16_t*)(p.ws + WS_PROJ);
    float* LA = (float*)(p.ws + WS_SCR); float* BV = LA + (size_t)2 * T * 512;
    for (int item = bid; item < T / 8; item += nb) {
        const int t0 = item * 8;
        __syncthreads();
        for (int tt = 0; tt < 8; ++tt) { const int t = t0 + tt, s = t & (SEQ - 1); float a = p.conv_b[w];
#pragma unroll
            for (int j = 0; j < 4; ++j) { const int ss = s + j - 2; if (ss >= 0 && ss < SEQ) a += p.conv_w[j * 512 + w] * bf2f(proj[(size_t)(t + j - 2) * EVEN_IN + 1536 + w]); }
            xc_s[tt * 512 + w] = a; }
        __syncthreads();
        const int n = w >> 7, d = w & 127;
        float g[4][8];
#pragma unroll
        for (int zg = 0; zg < 4; ++zg)
#pragma unroll
            for (int tt = 0; tt < 8; ++tt) g[zg][tt] = 0.f;
        for (int c = 0; c < 128; ++c) {
            float wv[4];
#pragma unroll
            for (int zg = 0; zg < 4; ++zg) wv[zg] = p.gate_w[((size_t)(zg * 4 + n) * 128 + c) * 128 + d];
#pragma unroll
            for (int tt = 0; tt < 8; ++tt) { const float xv = xc_s[tt * 512 + n * 128 + c];
#pragma unroll
                for (int zg = 0; zg < 4; ++zg) g[zg][tt] += xv * wv[zg]; }
        }
#pragma unroll
        for (int z = 0; z < 2; ++z) {
            const float sp = __logf(1.f + __expf(-p.lam[z * 512 + w]));
            const float br = p.gate_b[((z * 2 + 0) * 4 + n) * 128 + d], bi = p.gate_b[((z * 2 + 1) * 4 + n) * 128 + d];
#pragma unroll
            for (int tt = 0; tt < 8; ++tt) {
                const float r = sigm(g[z * 2][tt] + br), ig = sigm(g[z * 2 + 1][tt] + bi);
                const float la = -8.f * r * sp;
                const size_t idx = ((size_t)z * T + t0 + tt) * 512 + w;
                LA[idx] = la; BV[idx] = sqrtf(1.f - __expf(2.f * la)) * ig * xc_s[tt * 512 + w];
            }
        }
    }
}
__device__ __forceinline__ void ph_lru_scan(const Params& p, int tid, int bid) {
    const int gid = bid * 512 + tid; if (gid >= 2048) return;
    const int w = gid & 511, z = (gid >> 9) & 1, b = gid >> 10;
    const float* LA = (const float*)(p.ws + WS_SCR); float* BV = (float*)(p.ws + WS_SCR) + (size_t)2 * T * 512;
    float h = 0.f;
    for (int step = 0; step < SEQ; step += 8) {
        float la[8], bv[8]; size_t idx[8];
#pragma unroll
        for (int i = 0; i < 8; ++i) { const int t = z ? SEQ - 1 - (step + i) : step + i; idx[i] = ((size_t)z * T + (size_t)b * SEQ + t) * 512 + w; la[i] = LA[idx[i]]; bv[i] = BV[idx[i]]; }
#pragma unroll
        for (int i = 0; i < 8; ++i) { h = __expf(la[i]) * h + bv[i]; BV[idx[i]] = h; }
    }
}
__device__ __forceinline__ void ph_lru_out(const Params& p, int tid, int bid, int nb) {
    const int w = tid;
    const float* HS = (const float*)(p.ws + WS_SCR) + (size_t)2 * T * 512;
    const bf16_t* proj = (const bf16_t*)(p.ws + WS_PROJ); bf16_t* mix = (bf16_t*)(p.ws + WS_HB);
    for (int row = bid; row < T; row += nb) {
        const float hs = HS[(size_t)row * 512 + w] + HS[((size_t)T + row) * 512 + w];
        const float gr = bf2f(proj[(size_t)row * EVEN_IN + 2048 + w]);
        mix[(size_t)row * D + 512 + w] = (bf16_t)f2bf(hs * gelu_tanh(gr));
    }
}
__device__ __forceinline__ void ph_gla_naive(const Params& p, int tid, LAS float* sm, int bid) {
    if (bid >= 8) return;
    const int vq = tid >> 7, vb = bid * 4 + vq;
    LAS float* fs = sm + vq * 512; LAS float* qs = fs + 256;
    const int dir = vb & 1, bh = vb >> 1, b = bh >> 3, h = bh & 7, e = tid & 127;
    bf16_t* proj = (bf16_t*)(p.ws + WS_PROJ);
    float S[128];
#pragma unroll
    for (int d = 0; d < 128; ++d) S[d] = 0.f;
    for (int step = 0; step < SEQ; ++step) {
        const int t = dir ? SEQ - 1 - step : step; bf16_t* pr = proj + ((size_t)b * SEQ + t) * ODD_IN;
        const int buf = step & 1;
        fs[buf * 128 + e] = __expf(bf2f(pr[2048 + dir * 1024 + h * 128 + e])); qs[buf * 128 + e] = bf2f(pr[h * 128 + e]);
        const float v = bf2f(pr[1024 + h * 128 + e]);
        __syncthreads();
        float o = 0.f;
#pragma unroll
        for (int d = 0; d < 128; ++d) { const float f = fs[buf * 128 + d]; S[d] = f * S[d] + (1.f - f) * v; o += qs[buf * 128 + d] * S[d]; }
        pr[2048 + dir * 1024 + h * 128 + e] = (bf16_t)f2bf(o);
    }
}
__device__ __forceinline__ void ph_hg_norm(const Params& p, int tid, int bid, int nb) {
    const int lane = tid & 63;
    for (int row = bid * 8 + (tid >> 6); row < T; row += nb * 8) {
        const bf16_t* pr = (const bf16_t*)(p.ws + WS_PROJ) + (size_t)row * ODD_IN; bf16_t* mix = (bf16_t*)(p.ws + WS_MIX1) + (size_t)row * D;
        f32x4 o[4]; float ss = 0.f;
#pragma unroll
        for (int j = 0; j < 4; ++j) { const int c = 4 * lane + 256 * j; const u32x2 a = *(const u32x2*)(pr + 2048 + c), bb = *(const u32x2*)(pr + 3072 + c);
            o[j][0] = bflo(a.x) + bflo(bb.x); o[j][1] = bfhi(a.x) + bfhi(bb.x); o[j][2] = bflo(a.y) + bflo(bb.y); o[j][3] = bfhi(a.y) + bfhi(bb.y);
            ss += (o[j][0] * o[j][0] + o[j][1] * o[j][1]) + (o[j][2] * o[j][2] + o[j][3] * o[j][3]); }
        const float rstd = 1.f / sqrtf(wave_sum(ss) * (1.f / D) + RMS_EPS);
#pragma unroll
        for (int j = 0; j < 4; ++j) { const int c = 4 * lane + 256 * j; const f32x4 nw = *(const f32x4*)(p.norm_w + c); const u32x2 gg = *(const u32x2*)(pr + 4096 + c);
            u32x2 w; w.x = pk2(o[j][0] * rstd * nw[0] * silu(bflo(gg.x)), o[j][1] * rstd * nw[1] * silu(bfhi(gg.x)));
            w.y = pk2(o[j][2] * rstd * nw[2] * silu(bflo(gg.y)), o[j][3] * rstd * nw[3] * silu(bfhi(gg.y)));
            *(u32x2*)(mix + c) = w; }
    }
}
__device__ __forceinline__ void ph_ln_router(const Params& p, int tid, int layer, LAS int* hist, int bid, int nb) {
    const int wave = tid >> 6, lane = tid & 63;
    for (int tb = bid; tb < T / 64; tb += nb) {
        __syncthreads();
        if (tid < 16) hist[tid] = 0;
        __syncthreads();
        for (int i = 0; i < 4; ++i) ln_router_rows<2>(p, layer, tb * 64 + wave * 8 + 2 * i, lane, hist);
        __syncthreads();
        if (tid < 16) ((int*)(p.ws + WS_TOK + TOK_BH))[(layer * 256 + tb) * 16 + tid] = hist[tid];
    }
}
__device__ __forceinline__ void ph_slots(const Params& p, int tid, int layer, LAS int* sm, int bid, int nb) {
    LAS int* tot = sm; LAS int* pre = sm + 16; LAS int* base = sm + 32; LAS int* lslot = sm + 64; LAS int* le = sm + 192;
    unsigned char* ws = p.ws; int* ctl = (int*)(ws + WS_CTL);
    const int* bh = (const int*)(ws + WS_TOK + TOK_BH) + layer * 256 * 16;
    const int* te = (const int*)(ws + WS_TOK + TOK_E);
    for (int tb = bid; tb < T / 64; tb += nb) {
        const int t0 = tb * 64;
        __syncthreads();
        if (tid < 16) { int a = 0, b = 0; for (int k = 0; k < 256; ++k) { const int v = bh[k * 16 + tid]; a += v; if (k < tb) b += v; } tot[tid] = a; pre[tid] = b; }
        if (tid < 128) le[tid] = te[2 * t0 + tid];
        __syncthreads();
        if (tid == 0) { int acc = 0; for (int e = 0; e < 16; ++e) { base[e] = acc; acc += (tot[e] + 255) / 256 * 256; }
            if (tb == 0) { int k = 0; for (int e = 0; e < 16; ++e) { const int nt = (tot[e] + 255) / 256; for (int i = 0; i < nt; ++i) ctl[CW_TILEE + 256 * layer + k++] = e; } ctl[CW_NTILES + layer] = k; } }
        __syncthreads();
        if (tid < 128) { const int e = le[tid]; int rank = 0; for (int a = 0; a < tid; ++a) rank += (le[a] == e) ? 1 : 0;
            const int s = base[e] + pre[e] + rank; lslot[tid] = s; ((int*)(ws + WS_TOK + TOK_SLOT))[2 * t0 + tid] = s; }
        __syncthreads();
        const int wave = tid >> 6, lane = tid & 63;
        const bf16_t* hb = (const bf16_t*)(ws + WS_HB); bf16_t* xs = (bf16_t*)(ws + WS_XS);
        for (int i = 0; i < 8; ++i) { const int tl = wave * 8 + i; const size_t row = t0 + tl;
            const u32x4 a = *(const u32x4*)(hb + row * D + 8 * lane), b2 = *(const u32x4*)(hb + row * D + 512 + 8 * lane);
#pragma unroll
            for (int k = 0; k < 2; ++k) { bf16_t* dst = xs + (size_t)lslot[2 * tl + k] * D; *(u32x4*)(dst + 8 * lane) = a; *(u32x4*)(dst + 512 + 8 * lane) = b2; } }
    }
}
__device__ __forceinline__ void ph_combine_ln(const Params& p, int tid, int layer, int bid, int nb) {
    const int lane = tid & 63;
    for (int row = (bid * 8 + (tid >> 6)) * 4; row < T; row += nb * 8 * 4) { if (layer == 0) combine_ln_rows4<false>(p, 0, row, lane); else combine_ln_rows4<true>(p, 1, row, lane); }
}

constexpr int ENG_L = 512, ENG_NSC = SEQ / ENG_L, ENG_NC = ENG_L / 64;
struct EngDesc {
    const bf16_t* q; const bf16_t* kg; const bf16_t* v;
    bf16_t* o; int ors; int rs;
    int row0, dir, tau0;
    float lg;
    float* state; float* lgam;
};
typedef unsigned short u16x8 __attribute__((ext_vector_type(8)));
#define MFMA16(a, b, c) __builtin_amdgcn_mfma_f32_16x16x32_bf16((a), (b), (c), 0, 0, 0)

template <int DK, int MODE, int PASS>
__device__ __forceinline__ void engine_unit(const EngDesc& ds, LAS unsigned char* lds, int tid) {
    constexpr int CPW = DK / 8, NG = 64 / CPW, TG = CPW;
    constexpr int QS = (DK + 8) * 2, TS = 144;
    constexpr int OFF_QI = 0, OFF_KI = OFF_QI + 64 * QS, OFF_KT = OFF_KI + 64 * QS, OFF_VT = OFF_KT + DK * TS, OFF_ATT = OFF_VT + 128 * TS, OFF_BL = OFF_ATT + 64 * TS;
    constexpr int NDT = DK / 16, NKS = DK / 32;
    const int w = __builtin_amdgcn_readfirstlane(tid >> 6), l = tid & 63, fr = l & 15, fq = l >> 4;
    const int d1 = CPW * w + (l % CPW), g1 = l / CPW;
    const int e2 = 16 * w + fr, g2 = fq;
    f32x4 S[NDT];
#pragma unroll
    for (int dt = 0; dt < NDT; ++dt) { if (PASS == 1) S[dt] = *(const f32x4*)(ds.state + ((size_t)(w * NDT + dt) * 64 + l) * 4); else S[dt] = (f32x4){0.f, 0.f, 0.f, 0.f}; }
    float lgsum = 0.f;
    unsigned short rq[TG], rk[TG], rv[16];
#define ENG_ROW(tau) ((size_t)(ds.row0 + (ds.dir ? (SEQ - 1 - (tau)) : (tau))))
#define ENG_LOAD_RAW(c) do { const int tb_ = ds.tau0 + 64 * (c); \
        _Pragma("unroll") for (int i = 0; i < TG; ++i) { const size_t r_ = ENG_ROW(tb_ + g1 * TG + i) * ds.rs + d1; \
            if (MODE == 0 || true) rk[i] = ds.kg[r_]; if (PASS == 1) rq[i] = ds.q[r_]; } \
        _Pragma("unroll") for (int i = 0; i < 16; ++i) rv[i] = ds.v[ENG_ROW(tb_ + g2 * 16 + i) * ds.rs + e2]; } while (0)
    ENG_LOAD_RAW(0);
#pragma unroll 1
    for (int c = 0; c < ENG_NC; ++c) {
        __syncthreads();
        {
            float b[TG], bl;
            if (MODE == 1) {
                float run = 0.f;
#pragma unroll
                for (int i = 0; i < TG; ++i) { run += bf2f(rk[i]); b[i] = run; }
                float acc = run;
#pragma unroll
                for (int s = 0; (1 << s) < NG; ++s) { const float t = __shfl_up(acc, CPW << s); if (g1 >= (1 << s)) acc += t; }
                const float excl = acc - run;
                bl = __shfl(acc, (NG - 1) * CPW + (l % CPW));
#pragma unroll
                for (int i = 0; i < TG; ++i) b[i] += excl;
            } else {
#pragma unroll
                for (int i = 0; i < TG; ++i) b[i] = (float)(g1 * TG + i + 1) * ds.lg;
                bl = 64.f * ds.lg;
            }
            lgsum += bl;
            unsigned kt[TG / 2];
#pragma unroll
            for (int i = 0; i < TG; i += 2) {
                float kv0, kv1;
                if (MODE == 1) { kv0 = 1.f - __expf(bf2f(rk[i])); kv1 = 1.f - __expf(bf2f(rk[i + 1])); } else { kv0 = bf2f(rk[i]); kv1 = bf2f(rk[i + 1]); }
                const float x0 = b[i] - bl, x1 = b[i + 1] - bl;
                const float k0 = kv0 * __expf(-x0), k1 = kv1 * __expf(-x1);
                kt[i / 2] = cvtpk(k0, k1);
                if (PASS == 1) {
                    const float q0 = bf2f(rq[i]) * __expf(fminf(x0, 80.f)), q1 = bf2f(rq[i + 1]) * __expf(fminf(x1, 80.f));
                    const unsigned qp = cvtpk(q0, q1);
                    const int tk = g1 * TG + i;
                    *(LAS unsigned short*)(lds + OFF_QI + tk * QS + d1 * 2) = (unsigned short)(qp & 0xffffu); *(LAS unsigned short*)(lds + OFF_QI + (tk + 1) * QS + d1 * 2) = (unsigned short)(qp >> 16);
                    *(LAS unsigned short*)(lds + OFF_KI + tk * QS + d1 * 2) = (unsigned short)(kt[i / 2] & 0xffffu); *(LAS unsigned short*)(lds + OFF_KI + (tk + 1) * QS + d1 * 2) = (unsigned short)(kt[i / 2] >> 16);
                }
            }
#pragma unroll
            for (int i = 0; i < TG / 8; ++i) { u32x4 pk; pk.x = kt[4 * i]; pk.y = kt[4 * i + 1]; pk.z = kt[4 * i + 2]; pk.w = kt[4 * i + 3];
                *(LAS u32x4*)(lds + OFF_KT + d1 * TS + (g1 * TG + 8 * i) * 2) = pk; }
            if (g1 == 0) *(LAS float*)(lds + OFF_BL + d1 * 4) = bl;
#pragma unroll
            for (int i = 0; i < 2; ++i) { u32x4 pk; pk.x = rv[8 * i] | ((unsigned)rv[8 * i + 1] << 16); pk.y = rv[8 * i + 2] | ((unsigned)rv[8 * i + 3] << 16);
                pk.z = rv[8 * i + 4] | ((unsigned)rv[8 * i + 5] << 16); pk.w = rv[8 * i + 6] | ((unsigned)rv[8 * i + 7] << 16);
                *(LAS u32x4*)(lds + OFF_VT + e2 * TS + (g2 * 16 + 8 * i) * 2) = pk; }
        }
        if (c + 1 < ENG_NC) ENG_LOAD_RAW(c + 1);
        __syncthreads();
#pragma unroll
        for (int dt = 0; dt < NDT; ++dt) { const f32x4 bv = *(const LAS f32x4*)(lds + OFF_BL + (16 * dt + 4 * fq) * 4);
            S[dt][0] *= __expf(bv[0]); S[dt][1] *= __expf(bv[1]); S[dt][2] *= __expf(bv[2]); S[dt][3] *= __expf(bv[3]); }
        f32x4 oacc[4];
        if (PASS == 1) {
#pragma unroll
            for (int tt = 0; tt < 2; ++tt) {
                const int t = 2 * w + tt, jt = t >> 2, it = t & 3;
                f32x4 sc = {0.f, 0.f, 0.f, 0.f};
                if (jt <= it) {
#pragma unroll
                    for (int ks = 0; ks < NKS; ++ks) {
                        const bf16x8 a = *(const LAS bf16x8*)(lds + OFF_KI + (16 * jt + fr) * QS + (32 * ks + 8 * fq) * 2);
                        const bf16x8 bq = *(const LAS bf16x8*)(lds + OFF_QI + (16 * it + fr) * QS + (32 * ks + 8 * fq) * 2);
                        sc = MFMA16(a, bq, sc);
                    }
                    if (jt == it) {
#pragma unroll
                        for (int r = 0; r < 4; ++r) if (4 * fq + r > fr) sc[r] = 0.f;
                    }
                }
                u32x2 pk; pk.x = cvtpk(sc[0], sc[1]); pk.y = cvtpk(sc[2], sc[3]);
                *(LAS u32x2*)(lds + OFF_ATT + (16 * it + fr) * TS + (16 * jt + 4 * fq) * 2) = pk;
            }
            bf16x8 sa[NKS];
#pragma unroll
            for (int ks = 0; ks < NKS; ++ks) { u32x4 pk; pk.x = cvtpk(S[2 * ks][0], S[2 * ks][1]); pk.y = cvtpk(S[2 * ks][2], S[2 * ks][3]);
                pk.z = cvtpk(S[2 * ks + 1][0], S[2 * ks + 1][1]); pk.w = cvtpk(S[2 * ks + 1][2], S[2 * ks + 1][3]); sa[ks] = __builtin_bit_cast(bf16x8, pk); }
#pragma unroll
            for (int it = 0; it < 4; ++it) {
                oacc[it] = (f32x4){0.f, 0.f, 0.f, 0.f};
#pragma unroll
                for (int ks = 0; ks < NKS; ++ks) {
                    const u32x2 lo = *(const LAS u32x2*)(lds + OFF_QI + (16 * it + fr) * QS + (32 * ks + 4 * fq) * 2);
                    const u32x2 hi = *(const LAS u32x2*)(lds + OFF_QI + (16 * it + fr) * QS + (32 * ks + 16 + 4 * fq) * 2);
                    u32x4 pk; pk.x = lo.x; pk.y = lo.y; pk.z = hi.x; pk.w = hi.y;
                    oacc[it] = MFMA16(sa[ks], __builtin_bit_cast(bf16x8, pk), oacc[it]);
                }
            }
            __syncthreads();
        }
        bf16x8 vf[2];
#pragma unroll
        for (int ks = 0; ks < 2; ++ks) vf[ks] = *(const LAS bf16x8*)(lds + OFF_VT + (16 * w + fr) * TS + (32 * ks + 8 * fq) * 2);
        if (PASS == 1) {
#pragma unroll
            for (int it = 0; it < 4; ++it)
#pragma unroll
                for (int ks = 0; ks < 2; ++ks) if (ks == 0 || it >= 2) {
                    const bf16x8 ba = *(const LAS bf16x8*)(lds + OFF_ATT + (16 * it + fr) * TS + (32 * ks + 8 * fq) * 2);
                    oacc[it] = MFMA16(vf[ks], ba, oacc[it]);
                }
        }
#pragma unroll
        for (int dt = 0; dt < NDT; ++dt)
#pragma unroll
            for (int ks = 0; ks < 2; ++ks) {
                const bf16x8 a = *(const LAS bf16x8*)(lds + OFF_KT + (16 * dt + fr) * TS + (32 * ks + 8 * fq) * 2);
                S[dt] = MFMA16(a, vf[ks], S[dt]);
            }
        if (PASS == 1) {
#pragma unroll
            for (int it = 0; it < 4; ++it) { u32x2 pk; pk.x = cvtpk(oacc[it][0], oacc[it][1]); pk.y = cvtpk(oacc[it][2], oacc[it][3]);
                *(u32x2*)(ds.o + ENG_ROW(ds.tau0 + 64 * c + 16 * it + fr) * ds.ors + 16 * w + 4 * fq) = pk; }
        }
    }
    if (PASS == 0) {
#pragma unroll
        for (int dt = 0; dt < NDT; ++dt) *(f32x4*)(ds.state + ((size_t)(w * NDT + dt) * 64 + l) * 4) = S[dt];
        if (g1 == 0) ds.lgam[d1] = lgsum;
    }
#undef ENG_ROW
#undef ENG_LOAD_RAW
}
template <int DK>
__device__ __forceinline__ void eng_scan(const float* sloc, float* sin, const float* lgam, int nseq, int gtid, int gthreads) {
    constexpr int NDT = DK / 16, PER_SEQ = 8 * NDT * 64;
    for (int i = gtid; i < nseq * PER_SEQ; i += gthreads) {
        const int seq = i / PER_SEQ, r = i % PER_SEQ, l = r & 63, dt = (r >> 6) % NDT;
        const int d = 16 * dt + 4 * (l >> 4);
        f32x4 cur = {0.f, 0.f, 0.f, 0.f};
#pragma unroll 1
        for (int s0 = 0; s0 < ENG_NSC; s0 += 8) {
            f32x4 loc[8], lg[8];
#pragma unroll
            for (int k = 0; k < 8; ++k) { const int sc = s0 + k; loc[k] = *(const f32x4*)(sloc + ((size_t)(seq * ENG_NSC + sc) * PER_SEQ + r) * 4); lg[k] = *(const f32x4*)(lgam + (size_t)(seq * ENG_NSC + sc) * DK + d); }
#pragma unroll
            for (int k = 0; k < 8; ++k) { const int sc = s0 + k;
                *(f32x4*)(sin + ((size_t)(seq * ENG_NSC + sc) * PER_SEQ + r) * 4) = cur;
                cur[0] = __expf(lg[k][0]) * cur[0] + loc[k][0]; cur[1] = __expf(lg[k][1]) * cur[1] + loc[k][1]; cur[2] = __expf(lg[k][2]) * cur[2] + loc[k][2]; cur[3] = __expf(lg[k][3]) * cur[3] + loc[k][3]; }
        }
    }
}

constexpr size_t WS_RO = WS_SCR;
constexpr size_t WS_ST = 216 * MiB;
constexpr size_t WS_ST_RET = 236 * MiB;
constexpr size_t WS_SIN = 248 * MiB;
constexpr size_t WS_LG = 280 * MiB;

template <int PASS>
__device__ __forceinline__ void ph_ret_pass(const Params& p, int tid, LAS unsigned char* lds, int bid, int nb) {
    bf16_t* proj = (bf16_t*)(p.ws + WS_PROJ);
    for (int u = bid; u < 16 * ENG_NSC; u += nb) {
        const int seq = u / ENG_NSC, sc = u % ENG_NSC, dir = seq & 1, bh = seq >> 1, b = bh >> 2, h = bh & 3;
        EngDesc ds; ds.q = proj + h * 64; ds.kg = proj + 256 + h * 64; ds.v = proj + 512 + h * 128; ds.rs = EVEN_IN;
        ds.o = (bf16_t*)(p.ws + WS_RO) + (size_t)dir * T * 512 + h * 128; ds.ors = 512;
        ds.row0 = b * SEQ; ds.dir = dir; ds.tau0 = sc * ENG_L; ds.lg = log1pf(-exp2f(-5.f - (float)h));
        ds.state = (float*)(p.ws + (PASS ? WS_SIN : WS_ST_RET)) + (size_t)u * (64 * 128); ds.lgam = (float*)(p.ws + WS_LG) + (size_t)u * 64;
        engine_unit<64, 0, PASS>(ds, lds, tid);
    }
}
template <int PASS>
__device__ __forceinline__ void ph_gla_pass(const Params& p, int tid, LAS unsigned char* lds, int bid, int nb) {
    bf16_t* proj = (bf16_t*)(p.ws + WS_PROJ);
    for (int u = bid; u < 32 * ENG_NSC; u += nb) {
        const int seq = u / ENG_NSC, sc = u % ENG_NSC, dir = seq & 1, bh = seq >> 1, b = bh >> 3, h = bh & 7;
        EngDesc ds; ds.q = proj + h * 128; ds.kg = proj + 2048 + dir * 1024 + h * 128; ds.v = proj + 1024 + h * 128; ds.rs = ODD_IN;
        ds.o = proj + 2048 + dir * 1024 + h * 128; ds.ors = ODD_IN;
        ds.row0 = b * SEQ; ds.dir = dir; ds.tau0 = sc * ENG_L; ds.lg = 0.f;
        ds.state = (float*)(p.ws + (PASS ? WS_SIN : WS_ST)) + (size_t)u * (128 * 128); ds.lgam = (float*)(p.ws + WS_LG) + (size_t)u * 128;
        engine_unit<128, 1, PASS>(ds, lds, tid);
    }
}
__device__ __forceinline__ void ph_ret_norm2(const Params& p, int tid, int bid, int nb) {
    const int lane = tid & 63;
    const bf16_t* Of = (const bf16_t*)(p.ws + WS_RO); const bf16_t* Ob = Of + (size_t)T * 512;
    const bf16_t* proj = (const bf16_t*)(p.ws + WS_PROJ); bf16_t* mix = (bf16_t*)(p.ws + WS_HB);
    for (int gwv = bid * 8 + (tid >> 6); gwv < T * 4; gwv += nb * 8) {
        const int row = gwv >> 2, h = gwv & 3;
        const bf16_t* pr = proj + (size_t)row * EVEN_IN;
        const float qk = wave_sum(bf2f(pr[h * 64 + lane]) * bf2f(pr[256 + h * 64 + lane]));
        const size_t o = (size_t)row * 512 + h * 128 + 2 * lane;
        const unsigned uf = *(const unsigned*)(Of + o), ub = *(const unsigned*)(Ob + o), uv = *(const unsigned*)(pr + 512 + h * 128 + 2 * lane);
        const float a0 = bflo(uf) + bflo(ub) - qk * bflo(uv), a1 = bfhi(uf) + bfhi(ub) - qk * bfhi(uv);
        const float mean = wave_sum(a0 + a1) * (1.f / 128.f); const float d0 = a0 - mean, d1 = a1 - mean;
        const float rstd = 1.f / sqrtf(wave_sum(d0 * d0 + d1 * d1) * (1.f / 128.f) + LN_EPS);
        const unsigned gg = *(const unsigned*)(pr + 1024 + h * 128 + 2 * lane);
        *(unsigned*)(mix + (size_t)row * D + h * 128 + 2 * lane) = pk2(d0 * rstd * silu(bflo(gg)), d1 * rstd * silu(bfhi(gg)));
    }
}

constexpr size_t WS_G = WS_SCR + 32 * MiB;
constexpr size_t WS_AGG = 232 * MiB;
constexpr size_t WS_CIN = 234 * MiB;
template <int CTRL> __device__ __forceinline__ float dppf(float old, float x) {
    return __builtin_bit_cast(float, __builtin_amdgcn_update_dpp(__builtin_bit_cast(int, old), __builtin_bit_cast(int, x), CTRL, 0xf, 0xf, false));
}
template <bool FWD> __device__ __forceinline__ void row_scan(float& A, float& B) {
#define LRU_STEP(s) { const float Ap = dppf<(FWD ? 0x110 : 0x100) + s>(1.f, A), Bp = dppf<(FWD ? 0x110 : 0x100) + s>(0.f, B); B = A * Bp + B; A = A * Ap; }
    LRU_STEP(1) LRU_STEP(2) LRU_STEP(4) LRU_STEP(8)
#undef LRU_STEP
}
__device__ __forceinline__ void lru_unit(const Params& p, LAS unsigned char* lds, int tid, int u) {
    constexpr int XS_ = 272;
    const int n = u & 3, c = (u >> 2) & 63, b = u >> 8;
    const int w = __builtin_amdgcn_readfirstlane(tid >> 6), l = tid & 63, fr = l & 15, fq = l >> 4;
    const int row0 = b * SEQ + c * 128;
    const bf16_t* proj = (const bf16_t*)(p.ws + WS_PROJ);
    __syncthreads();
#pragma unroll
    for (int k = 0; k < 4; ++k) {
        const int id = tid + 512 * k, tok = id >> 4, cg = id & 15, ch0 = 128 * n + 8 * cg, s = c * 128 + tok;
        float acc[8];
        { const f32x4 b0 = *(const f32x4*)(p.conv_b + ch0), b1 = *(const f32x4*)(p.conv_b + ch0 + 4);
          acc[0] = b0[0]; acc[1] = b0[1]; acc[2] = b0[2]; acc[3] = b0[3]; acc[4] = b1[0]; acc[5] = b1[1]; acc[6] = b1[2]; acc[7] = b1[3]; }
#pragma unroll
        for (int j = 0; j < 4; ++j) {
            const int ss = s + j - 2;
            if (ss >= 0 && ss < SEQ) {
                const u32x4 xv = *(const u32x4*)(proj + (size_t)(b * SEQ + ss) * EVEN_IN + 1536 + ch0);
                const f32x4 w0 = *(const f32x4*)(p.conv_w + j * 512 + ch0), w1 = *(const f32x4*)(p.conv_w + j * 512 + ch0 + 4);
                acc[0] += w0[0] * bflo(xv.x); acc[1] += w0[1] * bfhi(xv.x); acc[2] += w0[2] * bflo(xv.y); acc[3] += w0[3] * bfhi(xv.y);
                acc[4] += w1[0] * bflo(xv.z); acc[5] += w1[1] * bfhi(xv.z); acc[6] += w1[2] * bflo(xv.w); acc[7] += w1[3] * bfhi(xv.w);
            }
        }
        u32x4 pk; pk.x = cvtpk(acc[0], acc[1]); pk.y = cvtpk(acc[2], acc[3]); pk.z = cvtpk(acc[4], acc[5]); pk.w = cvtpk(acc[6], acc[7]);
        *(LAS u32x4*)(lds + tok * XS_ + cg * 16) = pk;
    }
    __syncthreads();
    const int chl = 16 * w + 4 * fq, ch = 128 * n + chl;
    const bf16_t* lgt = (const bf16_t*)(p.ws + WS_LGT);
    bf16_t* G = (bf16_t*)(p.ws + WS_G);
    float* agg = (float*)(p.ws + WS_AGG) + (size_t)((b * 64 + c) * 2) * 2 * 512;
#pragma unroll
    for (int z = 0; z < 2; ++z) {
        bf16x8 ar[4], ai[4];
#pragma unroll
        for (int ks = 0; ks < 4; ++ks) {
            ar[ks] = *(const bf16x8*)(lgt + ((size_t)((2 * z + 0) * 4 + n) * 128 + 16 * w + fr) * 128 + 32 * ks + 8 * fq);
            ai[ks] = *(const bf16x8*)(lgt + ((size_t)((2 * z + 1) * 4 + n) * 128 + 16 * w + fr) * 128 + 32 * ks + 8 * fq);
        }
        const f32x4 lam4 = *(const f32x4*)(p.lam + z * 512 + ch);
        const f32x4 br4 = *(const f32x4*)(p.gate_b + ((2 * z + 0) * 4 + n) * 128 + chl), bi4 = *(const f32x4*)(p.gate_b + ((2 * z + 1) * 4 + n) * 128 + chl);
        float sp8[4];
#pragma unroll
        for (int r = 0; r < 4; ++r) sp8[r] = -8.f * __logf(1.f + __expf(-lam4[r]));
        float cin[4] = {0.f, 0.f, 0.f, 0.f}, pin[4] = {1.f, 1.f, 1.f, 1.f};
        const int srcl = (l & 48) | (z ? 0 : 15);
#pragma unroll 1
        for (int ti = 0; ti < 8; ++ti) {
            const int tt = z ? 7 - ti : ti;
            f32x4 gr_ = {0.f, 0.f, 0.f, 0.f}, gi_ = {0.f, 0.f, 0.f, 0.f};
#pragma unroll
            for (int ks = 0; ks < 4; ++ks) {
                const bf16x8 xb = *(const LAS bf16x8*)(lds + (16 * tt + fr) * XS_ + (32 * ks + 8 * fq) * 2);
                gr_ = MFMA16(ar[ks], xb, gr_); gi_ = MFMA16(ai[ks], xb, gi_);
            }
            const u32x2 xq = *(const LAS u32x2*)(lds + (16 * tt + fr) * XS_ + chl * 2);
            const float xcv[4] = {bflo(xq.x), bfhi(xq.x), bflo(xq.y), bfhi(xq.y)};
            float hl[4], Pl[4];
#pragma unroll
            for (int r = 0; r < 4; ++r) {
                const float la = sp8[r] * sigm(gr_[r] + br4[r]);
                float A = __expf(la), B = sqrtf(fmaxf(1.f - __expf(2.f * la), 0.f)) * sigm(gi_[r] + bi4[r]) * xcv[r];
                if (z == 0) row_scan<true>(A, B); else row_scan<false>(A, B);
                hl[r] = A * cin[r] + B; Pl[r] = A * pin[r];
                cin[r] = __shfl(hl[r], srcl); pin[r] = __shfl(Pl[r], srcl);
            }
            {
                const size_t row = (size_t)row0 + 16 * tt + fr;
                const u32x2 gq = *(const u32x2*)(proj + row * EVEN_IN + 2048 + ch);
                const float ge[4] = {gelu_tanh(bflo(gq.x)), gelu_tanh(bfhi(gq.x)), gelu_tanh(bflo(gq.y)), gelu_tanh(bfhi(gq.y))};
                u32x2 o1, o2;
                o1.x = cvtpk(hl[0] * ge[0], hl[1] * ge[1]); o1.y = cvtpk(hl[2] * ge[2], hl[3] * ge[3]);
                o2.x = cvtpk(Pl[0] * ge[0], Pl[1] * ge[1]); o2.y = cvtpk(Pl[2] * ge[2], Pl[3] * ge[3]);
                *(u32x2*)(G + ((size_t)(2 * z) * T + row) * 512 + ch) = o1; *(u32x2*)(G + ((size_t)(2 * z + 1) * T + row) * 512 + ch) = o2;
            }
        }
        if (fr == 0) { f32x4 a4 = {pin[0], pin[1], pin[2], pin[3]}, b4 = {cin[0], cin[1], cin[2], cin[3]};
            *(f32x4*)(agg + (size_t)(z * 2 + 0) * 512 + ch) = a4; *(f32x4*)(agg + (size_t)(z * 2 + 1) * 512 + ch) = b4; }
    }
}
__device__ __forceinline__ void lru_carry(const Params& p, int gid) {
    if (gid >= 2048) return;
    const int ch = gid & 511, z = (gid >> 9) & 1, b = gid >> 10;
    const float* agg = (const float*)(p.ws + WS_AGG); float* cinb = (float*)(p.ws + WS_CIN);
    float cur = 0.f;
#pragma unroll 1
    for (int s0 = 0; s0 < 64; s0 += 16) {
        float a[16], bb[16];
#pragma unroll
        for (int k = 0; k < 16; ++k) { const int c = z ? 63 - (s0 + k) : s0 + k; const size_t idx = (size_t)((b * 64 + c) * 2 + z);
            a[k] = agg[(idx * 2 + 0) * 512 + ch]; bb[k] = agg[(idx * 2 + 1) * 512 + ch]; }
#pragma unroll
        for (int k = 0; k < 16; ++k) { const int c = z ? 63 - (s0 + k) : s0 + k; const size_t idx = (size_t)((b * 64 + c) * 2 + z);
            cinb[idx * 512 + ch] = cur; cur = a[k] * cur + bb[k]; }
    }
}
__device__ __forceinline__ void lru_combine(const Params& p, int gid, int gthreads) {
    const bf16_t* G = (const bf16_t*)(p.ws + WS_G); const float* cinb = (const float*)(p.ws + WS_CIN); bf16_t* mix = (bf16_t*)(p.ws + WS_HB);
    for (int i = gid; i < T * 128; i += gthreads) {
        const int row = i >> 7, ch = (i & 127) * 4, b = row >> 13, c = (row & (SEQ - 1)) >> 7;
        const f32x4 cf = *(const f32x4*)(cinb + (size_t)((b * 64 + c) * 2 + 0) * 512 + ch), cb = *(const f32x4*)(cinb + (size_t)((b * 64 + c) * 2 + 1) * 512 + ch);
        const u32x2 g1 = *(const u32x2*)(G + (size_t)row * 512 + ch), g2 = *(const u32x2*)(G + ((size_t)T + row) * 512 + ch);
        const u32x2 g3 = *(const u32x2*)(G + ((size_t)2 * T + row) * 512 + ch), g4 = *(const u32x2*)(G + ((size_t)3 * T + row) * 512 + ch);
        u32x2 o;
        o.x = cvtpk(bflo(g1.x) + bflo(g3.x) + bflo(g2.x) * cf[0] + bflo(g4.x) * cb[0], bfhi(g1.x) + bfhi(g3.x) + bfhi(g2.x) * cf[1] + bfhi(g4.x) * cb[1]);
        o.y = cvtpk(bflo(g1.y) + bflo(g3.y) + bflo(g2.y) * cf[2] + bflo(g4.y) * cb[2], bfhi(g1.y) + bfhi(g3.y) + bfhi(g2.y) * cf[3] + bfhi(g4.y) * cb[3]);
        *(u32x2*)(mix + (size_t)row * D + 512 + ch) = o;
    }
}

__device__ __forceinline__ Params load_params() {
    typedef const float* cfp;
    const volatile __attribute__((address_space(4))) cfp* kp = (const volatile __attribute__((address_space(4))) cfp*)__builtin_amdgcn_kernarg_segment_ptr();
    Params q;
    q.x = kp[0]; q.w_in_even = kp[1]; q.w_out_even = kp[2]; q.conv_w = kp[3]; q.conv_b = kp[4]; q.gate_w = kp[5]; q.gate_b = kp[6]; q.lam = kp[7];
    q.w_in_odd = kp[8]; q.w_out_odd = kp[9]; q.lower_bounds = kp[10]; q.norm_w = kp[11]; q.ln_w = kp[12]; q.ln_b = kp[13]; q.router_w = kp[14];
    q.moe_gate = kp[15]; q.moe_up = kp[16]; q.moe_down = kp[17]; q.out = (float*)kp[18]; q.ws = (unsigned char*)kp[19];
    return q;
}
#define PH_BEGIN { const Params p = load_params(); int tid_ = threadIdx.x; asm volatile("" : "+v"(tid_)); int bid = blockIdx.x, nb = gridDim.x; asm volatile("" : "+s"(bid), "+s"(nb)); \
    const int wave = __builtin_amdgcn_readfirstlane(tid_ >> 6), lane = tid_ & 63; LAS float* scrw = (LAS float*)(lds + wave * 16384); const int gw = bid * 8 + wave, ngw = nb * 8; \
    (void)lane; (void)scrw; (void)gw; (void)ngw;
#define PH_END }
#define GRID_BAR() { XcdBarrier b_; b_.bar = (unsigned*)(load_params().ws + WS_CTL) + CW_BAR; b_.x = xb_xcc_id(); b_.st = MISC + 8; xcd_barrier(b_); }
__global__ void __launch_bounds__(512, 2) mega_fwd(Params p_unused) {
    extern __shared__ __attribute__((aligned(16))) unsigned char shm[];
    PG8_LAS unsigned char* lds = (PG8_LAS unsigned char*)shm;
    volatile LAS unsigned* MISC = (volatile LAS unsigned*)(lds + MISC_OFF);
    for (int u = threadIdx.x; u < (LDS_BYTES - STAGE_LDS) / 4; u += 512) ((LAS unsigned*)(lds + STAGE_LDS))[u] = 0u;
    __syncthreads();
    (void)xcd_barrier_post((unsigned*)(load_params().ws + WS_CTL) + CW_BAR, MISC + 8);

    PH_BEGIN prologue_static(p, scrw, gw, ngw, lane); PH_END
    GRID_BAR();
    PH_BEGIN ph_inproj0(p, lds, bid, nb); PH_END
    GRID_BAR();
    PH_BEGIN ph_ret_pass<0>(p, tid_, lds, bid, nb); for (int u = bid; u < 512; u += nb) lru_unit(p, lds, tid_, u); PH_END
    GRID_BAR();
    PH_BEGIN eng_scan<64>((const float*)(p.ws + WS_ST_RET), (float*)(p.ws + WS_SIN), (const float*)(p.ws + WS_LG), 16, bid * 512 + tid_, nb * 512); lru_carry(p, (nb - 1 - bid) * 512 + tid_); PH_END
    GRID_BAR();
    PH_BEGIN ph_ret_pass<1>(p, tid_, lds, bid, nb); lru_combine(p, bid * 512 + tid_, nb * 512); PH_END
    GRID_BAR();
    PH_BEGIN ph_ret_norm2(p, tid_, bid, nb); PH_END
    GRID_BAR();
    PH_BEGIN ph_outproj<0>(p, lds, bid, nb); PH_END
    GRID_BAR();
    PH_BEGIN prologue_moe(p, 0, scrw, gw, ngw, lane); ph_ln_router(p, tid_, 0, (LAS int*)lds, bid, nb); PH_END
    GRID_BAR();
    PH_BEGIN ph_slots(p, tid_, 0, (LAS int*)lds, bid, nb); PH_END
    GRID_BAR();
    PH_BEGIN ph_moe_gateup(p, 0, lds, bid, nb); PH_END
    GRID_BAR();
    PH_BEGIN ph_moe_down(p, 0, lds, bid, nb); PH_END
    GRID_BAR();
    PH_BEGIN ph_combine_ln(p, tid_, 0, bid, nb); PH_END
    GRID_BAR();
    PH_BEGIN ph_inproj1(p, lds, bid, nb); PH_END
    GRID_BAR();
    PH_BEGIN ph_gla_pass<0>(p, tid_, lds, bid, nb); PH_END
    GRID_BAR();
    PH_BEGIN eng_scan<128>((const float*)(p.ws + WS_ST), (float*)(p.ws + WS_SIN), (const float*)(p.ws + WS_LG), 32, bid * 512 + tid_, nb * 512); PH_END
    GRID_BAR();
    PH_BEGIN ph_gla_pass<1>(p, tid_, lds, bid, nb); PH_END
    GRID_BAR();
    PH_BEGIN ph_hg_norm(p, tid_, bid, nb); PH_END
    GRID_BAR();
    PH_BEGIN ph_outproj<1>(p, lds, bid, nb); PH_END
    GRID_BAR();
    PH_BEGIN prologue_moe(p, 1, scrw, gw, ngw, lane); ph_ln_router(p, tid_, 1, (LAS int*)lds, bid, nb); PH_END
    GRID_BAR();
    PH_BEGIN ph_slots(p, tid_, 1, (LAS int*)lds, bid, nb); PH_END
    GRID_BAR();
    PH_BEGIN ph_moe_gateup(p, 1, lds, bid, nb); PH_END
    GRID_BAR();
    PH_BEGIN ph_moe_down(p, 1, lds, bid, nb); PH_END
    GRID_BAR();
    PH_BEGIN ph_combine_ln(p, tid_, 1, bid, nb); PH_END
}

extern "C" void kernel_launch(void* const* d_in, const int* in_sizes, int n_in, void* d_out, int out_size, void* d_ws, size_t ws_size, hipStream_t stream) {
    static int grid = 0;
    if (grid == 0) {
        if (n_in != 18 || in_sizes[0] != T * D || out_size != T * D || ws_size < WS_END) { fprintf(stderr, "kernel_launch: unexpected shapes (n_in %d, in0 %d, out %d, ws %zu)\n", n_in, n_in > 0 ? in_sizes[0] : -1, out_size, ws_size); grid = -1; return; }
        int dev = 0, cus = 0, per_cu = 0;
        if (hipGetDevice(&dev) != hipSuccess || hipDeviceGetAttribute(&cus, hipDeviceAttributeMultiprocessorCount, dev) != hipSuccess) { grid = -1; return; }
        if (hipFuncSetAttribute((const void*)mega_fwd, hipFuncAttributeMaxDynamicSharedMemorySize, LDS_BYTES) != hipSuccess) { fprintf(stderr, "kernel_launch: hipFuncSetAttribute failed\n"); grid = -1; return; }
        if (hipOccupancyMaxActiveBlocksPerMultiprocessor(&per_cu, (const void*)mega_fwd, 512, LDS_BYTES) != hipSuccess || per_cu < 1) { fprintf(stderr, "kernel_launch: occupancy query says %d workgroups per CU\n", per_cu); }
        (void)hipGetLastError();
        grid = cus > 0 ? cus : 256;
    }
    if (grid < 0) return;
    Params p{};
    p.x = (const float*)d_in[0]; p.w_in_even = (const float*)d_in[1]; p.w_out_even = (const float*)d_in[2]; p.conv_w = (const float*)d_in[3]; p.conv_b = (const float*)d_in[4];
    p.gate_w = (const float*)d_in[5]; p.gate_b = (const float*)d_in[6]; p.lam = (const float*)d_in[7]; p.w_in_odd = (const float*)d_in[8]; p.w_out_odd = (const float*)d_in[9];
    p.lower_bounds = (const float*)d_in[10]; p.norm_w = (const float*)d_in[11]; p.ln_w = (const float*)d_in[12]; p.ln_b = (const float*)d_in[13]; p.router_w = (const float*)d_in[14];
    p.moe_gate = (const float*)d_in[15]; p.moe_up = (const float*)d_in[16]; p.moe_down = (const float*)d_in[17];
    p.out = (float*)d_out; p.ws = (unsigned char*)d_ws;
    if (hipMemsetAsync((char*)d_ws + WS_CTL, 0, CTL_BYTES, stream) != hipSuccess) return;
    hipLaunchKernelGGL(mega_fwd, dim3(grid), dim3(512), LDS_BYTES, stream, p);
}
```
